# Optimizing an MI355X kernel written in HIP

```python
import jax, jax.numpy as jnp
from jax import lax
import numpy as np

D_MODEL = 1024
BATCH = 8
SEQ = 4096
DEPTH = 1

A_HEADS = 8
A_HEAD_DIM = 64
A_WIDTH = A_HEADS * A_HEAD_DIM
MOBA_BLOCK = 256
MOBA_TOPK = 3
MOBA_QCHUNK = 32
ROPE_THETA = 10000.0
B_HEADS = 4
B_HEAD_DIM = 128
B_WIDTH = B_HEADS * B_HEAD_DIM
MLSTM_CHUNK = 64
CONV_WIDTH = 4
D_FF = ((8 * D_MODEL + 3 * 256 - 1) // (3 * 256)) * 256
NORM_EPS = 1e-6

IN_SIZES = [A_WIDTH, A_WIDTH, A_WIDTH,
            2 * B_WIDTH,
            B_WIDTH, B_WIDTH,
            B_HEADS, B_HEADS,
            D_MODEL, D_MODEL]
IN_WIDTH = sum(IN_SIZES)
IN_SPLITS = [int(s) for s in np.cumsum(IN_SIZES)[:-1]]

kernel_name = "moba_mlstm_gated_hybrid"


def rms_norm(x, g):
    xf = x.astype(jnp.float32)
    y = xf * lax.rsqrt(jnp.mean(xf * xf, axis=-1, keepdims=True) + NORM_EPS)
    return (y * g.astype(jnp.float32)).astype(x.dtype)


def rope(x, pos):
    half = x.shape[-1] // 2
    inv = ROPE_THETA ** (-jnp.arange(half, dtype=jnp.float32) / half)
    ang = pos.astype(jnp.float32)[:, None] * inv[None, :]
    cos, sin = jnp.cos(ang), jnp.sin(ang)
    xf = x.astype(jnp.float32)
    x1, x2 = xf[..., :half], xf[..., half:]
    return jnp.concatenate([x1 * cos - x2 * sin, x2 * cos + x1 * sin], axis=-1).astype(x.dtype)


def causal_depthwise_conv(x, w):
    width, chans = w.shape
    return lax.conv_general_dilated(
        x, w[:, None, :].astype(x.dtype), window_strides=(1,),
        padding=((width - 1, 0),), dimension_numbers=('NWC', 'WIO', 'NWC'),
        feature_group_count=chans)


def moba_attention(q, k, v):
    bn, nh, s, dh = q.shape
    nb = -(-s // MOBA_BLOCK)
    sp = nb * MOBA_BLOCK
    pad = ((0, 0), (0, 0), (0, sp - s), (0, 0))
    q, k, v = jnp.pad(q, pad), jnp.pad(k, pad), jnp.pad(v, pad)
    kb = k.reshape(bn, nh, nb, MOBA_BLOCK, dh)
    vb = v.reshape(bn, nh, nb, MOBA_BLOCK, dh)
    scale = dh ** -0.5
    topk = min(MOBA_TOPK, nb - 1)
    nq = sp // MOBA_QCHUNK
    qc = jnp.moveaxis(q.reshape(bn, nh, nq, MOBA_QCHUNK, dh), 2, 0)
    starts = jnp.arange(nq) * MOBA_QCHUNK
    if topk > 0:
        kmean = kb.astype(jnp.float32).mean(axis=3)
        gate = jnp.einsum('bhsd,bhnd->bhsn', q.astype(jnp.float32), kmean)
        q_blk = jnp.arange(sp) // MOBA_BLOCK
        past = jnp.arange(nb)[None, :] < q_blk[:, None]
        gate = jnp.where(past, gate, -jnp.inf)
        top_val, top_idx = lax.top_k(gate, topk)
        valid = jnp.isfinite(top_val)
        idx_c = jnp.moveaxis(top_idx.reshape(bn, nh, nq, MOBA_QCHUNK, topk), 2, 0)
        val_c = jnp.moveaxis(valid.reshape(bn, nh, nq, MOBA_QCHUNK, topk), 2, 0)
        xs = (qc, starts, idx_c, val_c)
    else:
        xs = (qc, starts)
    bi = jnp.arange(bn)[:, None, None, None]
    hi = jnp.arange(nh)[None, :, None, None]

    def attend_chunk(args):
        qi, start = args[0], args[1]
        blk = start // MOBA_BLOCK
        k_own = lax.dynamic_index_in_dim(kb, blk, axis=2, keepdims=False)
        v_own = lax.dynamic_index_in_dim(vb, blk, axis=2, keepdims=False)
        qpos = start + jnp.arange(MOBA_QCHUNK)
        kpos = blk * MOBA_BLOCK + jnp.arange(MOBA_BLOCK)
        causal = kpos[None, :] <= qpos[:, None]
        s_own = jnp.einsum('bhqd,bhkd->bhqk', qi, k_own).astype(jnp.float32) * scale
        s_own = jnp.where(causal, s_own, -jnp.inf)
        if topk > 0:
            idx_i, valid_i = args[2], args[3]
            k_sel = kb[bi, hi, idx_i]
            v_sel = vb[bi, hi, idx_i]
            s_sel = jnp.einsum('bhqd,bhqrkd->bhqrk', qi, k_sel).astype(jnp.float32) * scale
            s_sel = jnp.where(valid_i[..., None], s_sel, -jnp.inf)
            s_sel = s_sel.reshape(bn, nh, MOBA_QCHUNK, topk * MOBA_BLOCK)
            p = jax.nn.softmax(jnp.concatenate([s_sel, s_own], axis=-1), axis=-1).astype(v.dtype)
            p_sel = p[..., :topk * MOBA_BLOCK].reshape(bn, nh, MOBA_QCHUNK, topk, MOBA_BLOCK)
            return (jnp.einsum('bhqrk,bhqrkd->bhqd', p_sel, v_sel)
                    + jnp.einsum('bhqk,bhkd->bhqd', p[..., topk * MOBA_BLOCK:], v_own))
        p = jax.nn.softmax(s_own, axis=-1).astype(v.dtype)
        return jnp.einsum('bhqk,bhkd->bhqd', p, v_own)

    out = lax.map(attend_chunk, xs)
    return jnp.moveaxis(out, 0, 2).reshape(bn, nh, sp, dh)[:, :, :s]


def mlstm_chunkwise(q, k, v, i_pre, f_pre):
    bn, nh, s, d = q.shape
    L = MLSTM_CHUNK
    nc = s // L
    f32 = jnp.float32
    q = q.astype(f32)
    k = k.astype(f32) * (d ** -0.5)
    v = v.astype(f32)
    log_f = jax.nn.log_sigmoid(f_pre.astype(f32))
    log_i = i_pre.astype(f32)

    def chunks(a):
        return jnp.moveaxis(a.reshape(bn, nh, nc, L, *a.shape[3:]), 2, 0)

    tri = jnp.tril(jnp.ones((L, L), dtype=bool))

    def step(carry, xs):
        C, n, m = carry
        qc, kc, vc, ic, fc = xs
        b = jnp.cumsum(fc, axis=-1)
        dmat = jnp.where(tri, b[..., :, None] - b[..., None, :] + ic[..., None, :], -jnp.inf)
        m_inter = b + m[..., None]
        m_t = jnp.maximum(m_inter, dmat.max(axis=-1))
        sc = jnp.einsum('bhtd,bhsd->bhts', qc, kc) * jnp.exp(dmat - m_t[..., None])
        w_inter = jnp.exp(m_inter - m_t)
        num = (jnp.einsum('bhts,bhse->bhte', sc, vc)
               + w_inter[..., None] * jnp.einsum('bhtd,bhde->bhte', qc, C))
        den = sc.sum(axis=-1) + w_inter * jnp.einsum('bhtd,bhd->bht', qc, n)
        h = num / jnp.maximum(jnp.abs(den), jnp.exp(-m_t))[..., None]
        b_tot = b[..., -1]
        g = b_tot[..., None] - b + ic
        m_new = jnp.maximum(b_tot + m, g.max(axis=-1))
        w_c = jnp.exp(b_tot + m - m_new)
        w_s = jnp.exp(g - m_new[..., None])
        C = w_c[..., None, None] * C + jnp.einsum('bhs,bhsd,bhse->bhde', w_s, kc, vc)
        n = w_c[..., None] * n + jnp.einsum('bhs,bhsd->bhd', w_s, kc)
        return (C, n, m_new), h

    init = (jnp.zeros((bn, nh, d, d), f32), jnp.zeros((bn, nh, d), f32), jnp.zeros((bn, nh), f32))
    _, hs = lax.scan(step, init, (chunks(q), chunks(k), chunks(v), chunks(log_i), chunks(log_f)))
    return jnp.moveaxis(hs, 0, 2).reshape(bn, nh, s, d)


def setup_inputs(seed: int = 0) -> dict:
    key = jax.random.key(seed)
    ks = jax.random.split(key, 16)
    nrm = jax.random.normal
    f32 = jnp.float32
    return {
        "x": nrm(ks[0], (BATCH, SEQ, D_MODEL), f32),
        "norm_mix_g": 1.0 + 0.02 * nrm(ks[1], (DEPTH, D_MODEL), f32),
        "w_in": nrm(ks[2], (DEPTH, D_MODEL, IN_WIDTH), f32) * D_MODEL ** -0.5,
        "conv_w": nrm(ks[3], (DEPTH, CONV_WIDTH, 2 * B_WIDTH), f32) * CONV_WIDTH ** -0.5,
        "b_igate": 0.1 * nrm(ks[4], (DEPTH, B_HEADS), f32),
        "b_fgate": jnp.linspace(3.0, 6.0, B_HEADS, dtype=f32)[None, :] + 0.1 * nrm(ks[5], (DEPTH, B_HEADS), f32),
        "mlstm_norm_g": 1.0 + 0.02 * nrm(ks[6], (DEPTH, B_WIDTH), f32),
        "w_proj_a": nrm(ks[7], (DEPTH, A_WIDTH, D_MODEL), f32) * A_WIDTH ** -0.5,
        "w_proj_b": nrm(ks[8], (DEPTH, B_WIDTH, D_MODEL), f32) * B_WIDTH ** -0.5,
        "w_out": nrm(ks[9], (DEPTH, D_MODEL, D_MODEL), f32) * D_MODEL ** -0.5,
        "norm_ffn_g": 1.0 + 0.02 * nrm(ks[10], (DEPTH, D_MODEL), f32),
        "w_gate_up": nrm(ks[11], (DEPTH, D_MODEL, 2 * D_FF), f32) * D_MODEL ** -0.5,
        "w_down": nrm(ks[12], (DEPTH, D_FF, D_MODEL), f32) * D_FF ** -0.5,
        "norm_final_g": 1.0 + 0.02 * nrm(ks[13], (D_MODEL,), f32),
    }


def reference(x, norm_mix_g, w_in, conv_w, b_igate, b_fgate, mlstm_norm_g, w_proj_a, w_proj_b,
              w_out, norm_ffn_g, w_gate_up, w_down, norm_final_g):
    bn, s, _ = x.shape
    pos = jnp.arange(s)

    def to_heads(t, nh):
        return t.reshape(bn, s, nh, -1).transpose(0, 2, 1, 3)

    h = x
    for l in range(DEPTH):
        u = rms_norm(h, norm_mix_g[l])
        z = u @ w_in[l]
        qa, ka, va, qk_b, vb, ob, ib, fb, ga, gb = jnp.split(z, IN_SPLITS, axis=-1)

        qa = rope(to_heads(qa, A_HEADS), pos)
        ka = rope(to_heads(ka, A_HEADS), pos)
        ya = moba_attention(qa, ka, to_heads(va, A_HEADS))
        ya = ya.transpose(0, 2, 1, 3).reshape(bn, s, A_WIDTH)

        qk_b = jax.nn.silu(causal_depthwise_conv(qk_b, conv_w[l]))
        qb, kb_ = jnp.split(qk_b, 2, axis=-1)
        i_pre = (ib + b_igate[l].astype(ib.dtype)).transpose(0, 2, 1)
        f_pre = (fb + b_fgate[l].astype(fb.dtype)).transpose(0, 2, 1)
        hb = mlstm_chunkwise(to_heads(qb, B_HEADS), to_heads(kb_, B_HEADS), to_heads(vb, B_HEADS),
                             i_pre, f_pre)
        hb = hb * lax.rsqrt(jnp.mean(hb * hb, axis=-1, keepdims=True) + NORM_EPS)
        hb = hb.transpose(0, 2, 1, 3).reshape(bn, s, B_WIDTH) * mlstm_norm_g[l].astype(jnp.float32)
        yb = (jax.nn.sigmoid(ob.astype(jnp.float32)) * hb).astype(u.dtype)

        merged = (jax.nn.sigmoid(ga) * (ya @ w_proj_a[l])
                  + jax.nn.sigmoid(gb) * (yb @ w_proj_b[l]))
        h = h + merged @ w_out[l]

        u = rms_norm(h, norm_ffn_g[l])
        g, up = jnp.split(u @ w_gate_up[l], 2, axis=-1)
        h = h + (jax.nn.silu(g) * up) @ w_down[l]

    return rms_norm(h, norm_final_g)
```

```cpp
#include <hip/hip_runtime.h>
#include <hip/hip_cooperative_groups.h>
#include <hip/hip_bf16.h>
#include <cstdio>
#include <cstdint>
#include <cmath>
namespace cg = cooperative_groups;
namespace pg8 {
#define PG8_LAS __attribute__((address_space(3)))
typedef unsigned short bf16_t;
typedef short bf16x8 __attribute__((ext_vector_type(8)));
typedef float f32x4 __attribute__((ext_vector_type(4)));
typedef unsigned u32x4 __attribute__((ext_vector_type(4)));
constexpr int BM = 256, BK = 64, HALF = 128, HTB = HALF * BK * 2  , STAGE_BYTES = 8 * HTB, NXCD = 8, WGM = 8;

__host__ __device__ __forceinline__ int lds_byte(int r, int c) { const int st = (r >> 4) * 2 + (c >> 5), rr = r & 15, cc = c & 31, ob = rr * 64 + cc * 2; return st * 1024 + (ob ^ (((ob >> 9) & 1) << 5)); }
__host__ __device__ __forceinline__ void stage_rc(int b, int& R, int& C) { const int st = b / 1024, sb = b % 1024, swz = sb ^ (((sb >> 9) & 1) << 5); R = (st >> 1) * 16 + swz / 64; C = (st & 1) * 32 + (swz % 64) / 2; }
__host__ __device__ __forceinline__ int perm32(int rho) { const int n = rho >> 4, i = rho & 15; return 8 * (i >> 2) + 4 * n + (i & 3); }

struct Unit { int pm, pn; };
struct Gemm { const bf16_t* A; const bf16_t* Bt; int M, N, K; };

struct StaticOrder {
    int nM, nN, nwg, G, c;
    __host__ __device__ void init(int M, int N, int G_, int c_) { nM = M / BM; nN = N / BM; nwg = nM * nN; G = G_; c = c_; }
    __host__ __device__ bool next(int i, Unit& u) const {
        const long L = (long)i * G + c; if (L >= nwg) return false;
        int wgid = (int)L; { const int q = nwg / NXCD, r = nwg % NXCD, xcd = wgid % NXCD, off = wgid / NXCD; wgid = (xcd < r ? xcd * (q + 1) : r * (q + 1) + (xcd - r) * q) + off; }
        const int nig = WGM * nN, gid = wgid / nig, fm = gid * WGM, gsz = (nM - fm) < WGM ? (nM - fm) : WGM;
        u.pm = fm + ((wgid % nig) % gsz); u.pn = (wgid % nig) / gsz; return true;
    }
    __device__ __forceinline__ void a_ready(const Unit&) const {}
    __device__ __forceinline__ void done(const Unit&) const {}
};
__device__ __forceinline__ unsigned cvt_pk_bf16(float lo, float hi) { unsigned r; asm volatile("v_cvt_pk_bf16_f32 %0, %1, %2" : "=v"(r) : "v"(lo), "v"(hi)); return r; }
typedef float f32x2 __attribute__((ext_vector_type(2)));
template <class Epi, class Sched, bool ALIGN_EPI = false, bool SP2 = false>
__device__ __forceinline__ void gemm_phase(PG8_LAS unsigned char* lds, const Gemm g, const Sched& S, const Epi& E) {
    int tid_ = threadIdx.x; asm volatile("" : "+v"(tid_));
    const int tid = tid_, wid = __builtin_amdgcn_readfirstlane(tid >> 6), lane = tid & 63, wr = wid >> 2, wc = wid & 3, fr = lane & 15, fq = lane >> 4;
    const int K = g.K, nt = K / BK;
    unsigned voffA[2], voffB[2];
#pragma unroll
    for (int i = 0; i < 2; ++i) { int R, C; stage_rc(tid * 16 + i * 8192, R, C); const int Rb = Epi::PERM ? ((R & ~31) + perm32(R & 31)) : R;
        voffA[i] = (unsigned)(R * K + C) * 2u; voffB[i] = (unsigned)(Rb * K + C) * 2u; }
    const size_t kstep = (size_t)(BK * 2);
    const size_t hstep = (size_t)HALF * K * 2;
    const size_t tstep = 2 * hstep;
    const unsigned ldsw = (unsigned)wid * 1024u;
    const int aoff = lds_byte(wr * 64 + fr, fq * 8), boff = lds_byte(wc * 32 + fr, fq * 8);
#define PG8_SA(b, h) (((b) * 2 + (h)) * HTB)
#define PG8_SB(b, h) ((4 + (b) * 2 + (h)) * HTB)
#define PG8_STAGE(bufoff, gbase, voff) do { _Pragma("unroll") for (int _i = 0; _i < 2; ++_i) \
        __builtin_amdgcn_global_load_lds((const unsigned*)((const char*)(gbase) + (voff)[_i]), (PG8_LAS unsigned*)(lds + (bufoff) + ldsw + _i * 8192), 16, 0, 0); } while (0)
#define PG8_LDA(dst, b, h) do { _Pragma("unroll") for (int m = 0; m < 4; ++m) _Pragma("unroll") for (int k = 0; k < 2; ++k) dst[m][k] = *(const PG8_LAS bf16x8*)(lds + PG8_SA(b, h) + aoff + m * 2048 + k * 1024); } while (0)
#define PG8_LDB(dst, b, h) do { _Pragma("unroll") for (int n = 0; n < 2; ++n) _Pragma("unroll") for (int k = 0; k < 2; ++k) dst[n][k] = *(const PG8_LAS bf16x8*)(lds + PG8_SB(b, h) + boff + n * 2048 + k * 1024); } while (0)
#define PG8_MMA(ai, bj, At, Bt) do { __builtin_amdgcn_s_setprio(1); _Pragma("unroll") for (int m = 0; m < 4; ++m) _Pragma("unroll") for (int n = 0; n < 2; ++n) _Pragma("unroll") for (int k = 0; k < 2; ++k) \
        acc[ai][bj][m][n] = __builtin_amdgcn_mfma_f32_16x16x32_bf16(Bt[n][k], At[m][k], acc[ai][bj][m][n], 0, 0, 0); __builtin_amdgcn_s_setprio(0); } while (0)
#define PG8_WAIT_V(n) asm volatile("s_waitcnt vmcnt(" #n ")" ::: "memory")
#define PG8_WAIT_L(n) asm volatile("s_waitcnt lgkmcnt(" #n ")" ::: "memory")
#define PG8_BAR __builtin_amdgcn_s_barrier()
#define PG8_SCHED __builtin_amdgcn_sched_barrier(0)
    Unit cur, nxt; int ui = 0;
    if (!S.next(0, cur)) return;
    f32x4 acc[2][2][4][2];
#pragma unroll
    for (int a = 0; a < 2; ++a)
#pragma unroll
        for (int b = 0; b < 2; ++b)
#pragma unroll
            for (int m = 0; m < 4; ++m)
#pragma unroll
                for (int n = 0; n < 2; ++n) acc[a][b][m][n] = (f32x4){0.f, 0.f, 0.f, 0.f};
    bf16x8 At[4][2], B0[2][2], B1[2][2];
    const char* cA = (const char*)g.A + (size_t)cur.pm * tstep; const char* cB = (const char*)g.Bt + (size_t)cur.pn * tstep;
    S.a_ready(cur);
    if constexpr (SP2) {
        PG8_STAGE(PG8_SB(0, 0), cB, voffB); PG8_STAGE(PG8_SB(0, 1), cB + hstep, voffB); PG8_STAGE(PG8_SA(0, 0), cA, voffA); PG8_STAGE(PG8_SA(0, 1), cA + hstep, voffA);
        if (wr == 1) PG8_BAR;
        PG8_WAIT_V(2); PG8_BAR;
        PG8_STAGE(PG8_SB(1, 0), cB + kstep, voffB); PG8_STAGE(PG8_SA(1, 0), cA + kstep, voffA); PG8_STAGE(PG8_SB(1, 1), cB + hstep + kstep, voffB);
        PG8_WAIT_V(6); PG8_BAR;
    } else {
        PG8_STAGE(PG8_SB(0, 0), cB, voffB); PG8_STAGE(PG8_SA(0, 0), cA, voffA); PG8_STAGE(PG8_SB(0, 1), cB + hstep, voffB); PG8_STAGE(PG8_SA(0, 1), cA + hstep, voffA);
        if (wr == 1) PG8_BAR;
        PG8_WAIT_V(4); PG8_BAR;
        PG8_STAGE(PG8_SB(1, 0), cB + kstep, voffB); PG8_STAGE(PG8_SA(1, 0), cA + kstep, voffA); PG8_STAGE(PG8_SB(1, 1), cB + hstep + kstep, voffB);
        PG8_WAIT_V(6); PG8_BAR;
    }
    for (;;) {
        const bool has_next = S.next(ui + 1, nxt);
        const char* nA = has_next ? (const char*)g.A + (size_t)nxt.pm * tstep : cA; const char* nB = has_next ? (const char*)g.Bt + (size_t)nxt.pn * tstep : cB;
        for (int t = 0; t < nt; t += 2) {
            const bool last = (t == nt - 2);
            if constexpr (Epi::MID) { if (t == (nt >> 1)) E.mid(acc, cur, wr, wc, fr, fq); }
            const char* a1 = cA + (size_t)(t + 1) * kstep;
            const char* a2 = last ? nA : cA + (size_t)(t + 2) * kstep; const char* b2 = last ? nB : cB + (size_t)(t + 2) * kstep;
            const char* a3 = a2 + kstep; const char* b3 = b2 + kstep;
            if (last && has_next) S.a_ready(nxt);
            if constexpr (SP2) {
            PG8_LDB(B0, 0, 0); PG8_LDB(B1, 0, 1); PG8_SCHED; PG8_LDA(At, 0, 0); PG8_STAGE(PG8_SA(1, 1), a1 + hstep, voffA);
            PG8_WAIT_V(8); PG8_WAIT_L(0); PG8_BAR; PG8_MMA(0, 0, At, B0); PG8_MMA(0, 1, At, B1); PG8_BAR; PG8_SCHED;
            PG8_LDA(At, 0, 1); PG8_STAGE(PG8_SB(0, 0), b2, voffB); PG8_STAGE(PG8_SB(0, 1), b2 + hstep, voffB); PG8_STAGE(PG8_SA(0, 0), a2, voffA);
            PG8_WAIT_V(8); PG8_WAIT_L(0); PG8_BAR; PG8_MMA(1, 0, At, B0); PG8_MMA(1, 1, At, B1); PG8_BAR; PG8_SCHED;
            PG8_LDB(B0, 1, 0); PG8_LDB(B1, 1, 1); PG8_SCHED; PG8_LDA(At, 1, 0); PG8_STAGE(PG8_SA(0, 1), a2 + hstep, voffA);
            PG8_WAIT_V(8); PG8_WAIT_L(0); PG8_BAR; PG8_MMA(0, 0, At, B0); PG8_MMA(0, 1, At, B1); PG8_BAR; PG8_SCHED;
            PG8_LDA(At, 1, 1); PG8_STAGE(PG8_SB(1, 0), b3, voffB); PG8_STAGE(PG8_SB(1, 1), b3 + hstep, voffB); PG8_STAGE(PG8_SA(1, 0), a3, voffA);
            PG8_WAIT_V(8); PG8_WAIT_L(0); PG8_BAR; PG8_MMA(1, 0, At, B0); PG8_MMA(1, 1, At, B1); PG8_BAR; PG8_SCHED;
            } else {
            PG8_LDB(B0, 0, 0); PG8_SCHED; PG8_LDA(At, 0, 0); PG8_STAGE(PG8_SA(1, 1), a1 + hstep, voffA);
            PG8_WAIT_L(8); PG8_BAR; PG8_WAIT_L(0); PG8_MMA(0, 0, At, B0); PG8_BAR; PG8_SCHED;
            PG8_LDB(B1, 0, 1); PG8_STAGE(PG8_SB(0, 0), b2, voffB);
            PG8_BAR; PG8_WAIT_L(0); PG8_MMA(0, 1, At, B1); PG8_BAR;
            PG8_LDA(At, 0, 1); PG8_STAGE(PG8_SA(0, 0), a2, voffA);
            PG8_BAR; PG8_WAIT_L(0); PG8_MMA(1, 0, At, B0); PG8_BAR; PG8_SCHED;
            PG8_STAGE(PG8_SB(0, 1), b2 + hstep, voffB);
            PG8_WAIT_V(6); PG8_BAR; PG8_MMA(1, 1, At, B1); PG8_BAR;
            PG8_LDB(B0, 1, 0); PG8_SCHED; PG8_LDA(At, 1, 0); PG8_STAGE(PG8_SA(0, 1), a2 + hstep, voffA);
            PG8_WAIT_L(8); PG8_BAR; PG8_WAIT_L(0); PG8_MMA(0, 0, At, B0); PG8_BAR; PG8_SCHED;
            PG8_LDB(B1, 1, 1); PG8_STAGE(PG8_SB(1, 0), b3, voffB);
            PG8_BAR; PG8_WAIT_L(0); PG8_MMA(0, 1, At, B1); PG8_BAR;
            PG8_LDA(At, 1, 1); PG8_STAGE(PG8_SA(1, 0), a3, voffA);
            PG8_BAR; PG8_WAIT_L(0); PG8_MMA(1, 0, At, B0); PG8_BAR; PG8_SCHED;
            PG8_STAGE(PG8_SB(1, 1), b3 + hstep, voffB);
            PG8_WAIT_V(6); PG8_BAR; PG8_MMA(1, 1, At, B1); PG8_BAR;
            }
        }
        if constexpr (ALIGN_EPI) { if (wr == 0) PG8_BAR; }
        if constexpr (!Epi::AFTER_DRAIN) { E(acc, cur, wr, wc, fr, fq); S.done(cur); }
        if (!has_next) break;
#pragma unroll
        for (int a = 0; a < 2; ++a)
#pragma unroll
            for (int b = 0; b < 2; ++b)
#pragma unroll
                for (int m = 0; m < 4; ++m)
#pragma unroll
                    for (int n = 0; n < 2; ++n) acc[a][b][m][n] = (f32x4){0.f, 0.f, 0.f, 0.f};
        cur = nxt; cA = nA; cB = nB; ++ui;
        if constexpr (ALIGN_EPI) { if (wr == 1) PG8_BAR; }
    }
    PG8_WAIT_V(0);
    if constexpr (!ALIGN_EPI) { if (wr == 0) PG8_BAR; }
    PG8_BAR;
    if constexpr (Epi::AFTER_DRAIN) { E.fused(acc, cur, wr, wc, fr, fq, lds, wid, lane); S.done(cur); }
#undef PG8_SA
#undef PG8_SB
#undef PG8_STAGE
#undef PG8_LDA
#undef PG8_LDB
#undef PG8_MMA
#undef PG8_WAIT_V
#undef PG8_WAIT_L
#undef PG8_BAR
#undef PG8_SCHED
}
}
namespace attn_body {
using bf16=__hip_bfloat16;
using bf16x8=__attribute__((ext_vector_type(8)))short;
using s16x4=__attribute__((ext_vector_type(4)))short;
using f32x16=__attribute__((ext_vector_type(16)))float;
using u32x4=__attribute__((ext_vector_type(4)))unsigned;
constexpr int BATCH=8,NHEAD=8,SEQ=4096,D=64,DM=5632,OPITCH=1024;
constexpr int NW=8,QBLK=32,QB=QBLK*NW,KVBLK=64,NQB=SEQ/QB;
constexpr int ATTN_PITCH=DM, ATTN_UNIT_ROWS=QB;
__device__ __forceinline__ int crow(int r,int hi){return (r&3)+8*(r>>2)+4*hi;}
#define SBAR() __builtin_amdgcn_sched_barrier(0)
__device__ __forceinline__ void cmask(f32x16&p0,f32x16&p1,int jb,int qrel,int hi){
  const float NEG=-INFINITY; const int lim=qrel-(64*jb+4*hi);
  #pragma unroll
  for(int r=0;r<16;++r){const int cr=(r&3)+8*(r>>2); if(cr>lim)p0[r]=NEG; if(cr+32>lim)p1[r]=NEG;}
}

__device__ __forceinline__ void smask(f32x16&p0,f32x16&p1,unsigned seladdr,int blk){
  const unsigned sel=*(const __attribute__((address_space(3))) unsigned*)(uintptr_t)seladdr;
  if(!((sel>>blk)&1u)){
  #pragma unroll
  for(int r=0;r<16;++r){p0[r]=-INFINITY;p1[r]=-INFINITY;}}
}
constexpr int NSLOT=3, SLOTB=8192;
constexpr int LDS_K=0, LDS_V=NSLOT*SLOTB, LDS_WS=2*NSLOT*SLOTB, LDS_OST=LDS_WS+NW*64*4, LDS_BYTES=LDS_OST+NW*4096;
constexpr float C2=0.125f*1.4426950408889634f;
__device__ __forceinline__ void glds16(const void*gsrc,unsigned lds_dst){unsigned keep;
  asm volatile("s_mov_b32 %0, m0\n\ts_mov_b32 m0, %2\n\ts_nop 0\n\tglobal_load_lds_dwordx4 %1, off\n\ts_mov_b32 m0, %0":"=&s"(keep):"v"(gsrc),"s"(lds_dst):"memory");}
__device__ __forceinline__ float max3f(float a,float b,float c){float r;asm("v_max3_f32 %0, %1, %2, %3":"=v"(r):"v"(a),"v"(b),"v"(c));return r;}
__device__ __forceinline__ float max2f(float a,float b){float r;asm("v_max_f32_e32 %0, %1, %2":"=v"(r):"v"(a),"v"(b));return r;}
__device__ __forceinline__ float fadd_s(float a,float b){float r;asm("v_add_f32_e32 %0, %1, %2":"=v"(r):"v"(a),"v"(b));return r;}
__device__ __forceinline__ float fsub_s(float a,float b){float r;asm("v_sub_f32_e32 %0, %1, %2":"=v"(r):"v"(a),"v"(b));return r;}
typedef float f32x2_t __attribute__((ext_vector_type(2))); typedef __bf16 bf16x2_t __attribute__((ext_vector_type(2)));
__device__ __forceinline__ unsigned cvtpk_s(float lo,float hi){f32x2_t v={lo,hi};bf16x2_t b=__builtin_convertvector(v,bf16x2_t);return __builtin_bit_cast(unsigned,b);}
#define WAIT_BAR(N) asm volatile("s_waitcnt vmcnt(" #N ") lgkmcnt(0)\n\ts_barrier":::"memory")

__device__ __forceinline__ void qkt(f32x16&p0,f32x16&p1,const char*Kslot,const bf16x8*qr,const f32x16&negm,int r32,int hi){
  const char*kb=Kslot+hi*1024+r32*16;
  #pragma unroll
  for(int d0=0;d0<4;++d0){
    const bf16x8 b0=*reinterpret_cast<const bf16x8*>(kb+d0*2048);
    const bf16x8 b1=*reinterpret_cast<const bf16x8*>(kb+d0*2048+512);
    if(d0==0){p0=__builtin_amdgcn_mfma_f32_32x32x16_bf16(b0,qr[0],negm,0,0,0);p1=__builtin_amdgcn_mfma_f32_32x32x16_bf16(b1,qr[0],negm,0,0,0);}
    else{p0=__builtin_amdgcn_mfma_f32_32x32x16_bf16(b0,qr[d0],p0,0,0,0);p1=__builtin_amdgcn_mfma_f32_32x32x16_bf16(b1,qr[d0],p1,0,0,0);}}
}
typedef __attribute__((address_space(3))) const char* lds_cptr;
typedef short v4i16_t __attribute__((ext_vector_type(4)));
__device__ __forceinline__ void kload8(bf16x8*kf,lds_cptr kp){
  kf[0]=*(const __attribute__((address_space(3))) bf16x8*)(kp);      kf[1]=*(const __attribute__((address_space(3))) bf16x8*)(kp+512);
  kf[2]=*(const __attribute__((address_space(3))) bf16x8*)(kp+2048); kf[3]=*(const __attribute__((address_space(3))) bf16x8*)(kp+2560);
  kf[4]=*(const __attribute__((address_space(3))) bf16x8*)(kp+4096); kf[5]=*(const __attribute__((address_space(3))) bf16x8*)(kp+4608);
  kf[6]=*(const __attribute__((address_space(3))) bf16x8*)(kp+6144); kf[7]=*(const __attribute__((address_space(3))) bf16x8*)(kp+6656);
}
__device__ __forceinline__ void kload2(bf16x8*kf,lds_cptr kp,int j){ kf[2*j]=*(const __attribute__((address_space(3))) bf16x8*)(kp+j*2048); kf[2*j+1]=*(const __attribute__((address_space(3))) bf16x8*)(kp+j*2048+512); }
__device__ __forceinline__ s16x4 vtr(lds_cptr p){ return __builtin_bit_cast(s16x4,__builtin_amdgcn_ds_read_tr16_b64_v4i16((__attribute__((address_space(3))) v4i16_t*)p)); }
__device__ __forceinline__ float rowmax(const f32x16&p0,const f32x16&p1){
  float a=max3f(p0[0],p0[1],p1[0]),b=max3f(p0[2],p0[3],p1[1]);a=max3f(a,p1[2],p1[3]);
  #pragma unroll
  for(int r=4;r<16;r+=4){a=max3f(a,p0[r],p0[r+1]);b=max3f(b,p0[r+2],p0[r+3]);a=max3f(a,p1[r],p1[r+1]);b=max3f(b,p1[r+2],p1[r+3]);}
  const float m=max2f(a,b);
  auto rr=__builtin_amdgcn_permlane32_swap(__float_as_uint(m),__float_as_uint(m),false,false);
  return max2f(__uint_as_float(rr[0]),__uint_as_float(rr[1]));
}
__device__ __forceinline__ void pv(f32x16*o,int vb,bf16x8 pa0,bf16x8 pa1,bf16x8 pa2,bf16x8 pa3){
  #pragma unroll
  for(int d0=0;d0<2;++d0){s16x4 lo[4],hi[4];
    #pragma unroll
    for(int ks=0;ks<4;++ks){
      asm volatile("ds_read_b64_tr_b16 %0,%1 offset:%c2":"=&v"(lo[ks]):"v"(vb),"i"(d0*4096+ks*1024):"memory");
      asm volatile("ds_read_b64_tr_b16 %0,%1 offset:%c2":"=&v"(hi[ks]):"v"(vb),"i"(d0*4096+ks*1024+512):"memory");}
    asm volatile("s_waitcnt lgkmcnt(0)":::"memory");SBAR();
    #define PK(k) (bf16x8){lo[k][0],lo[k][1],lo[k][2],lo[k][3],hi[k][0],hi[k][1],hi[k][2],hi[k][3]}
    o[d0]=__builtin_amdgcn_mfma_f32_32x32x16_bf16(pa0,PK(0),o[d0],0,0,0);
    o[d0]=__builtin_amdgcn_mfma_f32_32x32x16_bf16(pa1,PK(1),o[d0],0,0,0);
    o[d0]=__builtin_amdgcn_mfma_f32_32x32x16_bf16(pa2,PK(2),o[d0],0,0,0);
    o[d0]=__builtin_amdgcn_mfma_f32_32x32x16_bf16(pa3,PK(3),o[d0],0,0,0);
    #undef PK
  }
}

#ifndef ATTN_STORE16
#define ATTN_STORE16(p,v) (*(u32x4*)(p)=(v))
#endif
template<int THRL> __device__ __forceinline__ void attn_unit(int b,int h,int qb,unsigned selbase,const bf16*Q,const bf16*__restrict__ K,const bf16*__restrict__ V,bf16*O,char*shm){
  int tid_=threadIdx.x; asm volatile("":"+v"(tid_));
  const int tid=tid_,lane=tid&63,r32=lane&31,hi=lane>>5; const int wid=__builtin_amdgcn_readfirstlane(tid>>6);
  const long rowbase=(long)b*SEQ; const int q0=qb*QB;
  const bf16*Qw=Q+(rowbase+q0+wid*QBLK)*DM+h*D;
  const bf16*Kh=K+rowbase*DM+h*D,*Vh=V+rowbase*DM+h*D;
  const unsigned lds0=(unsigned)(uintptr_t)shm;
  float*wsf=(float*)(shm+LDS_WS)+wid*64;
  const bf16*ksrc=Kh+(long)lane*DM+wid*8;
  const bf16*vsrc=Vh+(long)(16*(wid&3)+(lane>>2))*DM+(wid>>2)*32+(lane&3)*8;
  const unsigned kdst=lds0+LDS_K+wid*1024, vdst=lds0+LDS_V+wid*1024;
  #define DMA_K(t,slot) glds16(ksrc+(long)(t)*KVBLK*DM,(unsigned)__builtin_amdgcn_readfirstlane(kdst+(slot)))
  #define DMA_V(t,slot) glds16(vsrc+(long)(t)*KVBLK*DM,(unsigned)__builtin_amdgcn_readfirstlane(vdst+(slot)))
  const int vb0=(int)(lds0+LDS_V)+((lane>>4)&1)*32+(lane&3)*8+(4*hi+((lane&15)>>2))*64;
  const char*Kbase=shm+LDS_K; bf16x8 kf[8];
  const lds_cptr shm3=(lds_cptr)shm; const lds_cptr kp0=shm3+LDS_K+hi*1024+r32*16; const lds_cptr vp0=shm3+LDS_V+((lane>>4)&1)*32+(lane&3)*8+(4*hi+((lane&15)>>2))*64;
  const int NT=(q0+QB)/KVBLK;
  DMA_K(0,0);DMA_V(0,0);DMA_K(1,SLOTB);
  bf16x8 qr[4];
  #pragma unroll
  for(int d0=0;d0<4;++d0)qr[d0]=*reinterpret_cast<const bf16x8*>(&Qw[(long)r32*DM+d0*16+hi*8]);
  float mhat=0.f,l_reg=0.f;f32x16 o[2];o[0]=f32x16{};o[1]=f32x16{};
  const int qrel=wid*QBLK+r32;
  #define SELBITS() (*(const volatile __attribute__((address_space(3))) unsigned*)(uintptr_t)(selbase+4u*(unsigned)qrel))
  #define CMASK(P0,P1,t) do{int jb_=(t)-(NT-4); if(jb_>=0)cmask(P0,P1,jb_,qrel,hi);}while(0)
  bool resc=false;
  #define START(P0,P1) do{ const float rm=rowmax(P0,P1); resc=false; \
    { const float dl=(rm==-INFINITY)?0.f:rm; mhat=fadd_s(mhat,dl); \
      _Pragma("unroll") for(int r=0;r<16;++r){P0[r]=fsub_s(P0[r],dl);P1[r]=fsub_s(P1[r],dl);} \
      } \
    _Pragma("unroll") for(int r=0;r<16;++r)P0[r]=__builtin_amdgcn_exp2f(P0[r]); }while(0)
  #define RESC() do{ if(resc){ asm volatile("s_waitcnt lgkmcnt(0)":::"memory"); \
      _Pragma("unroll") for(int d_=0;d_<2;++d_) _Pragma("unroll") for(int r=0;r<16;++r)o[d_][r]*=wsf[crow(r,hi)]; } }while(0)
  f32x16 pA0,pA1,pB0,pB1;
  int sl_prev=0,sl_cur=0,sl_next=SLOTB;
  #define ROT() do{sl_prev=sl_cur;sl_cur=sl_next;sl_next=(sl_next==(NSLOT-1)*SLOTB)?0:sl_next+SLOTB;}while(0)
  DMA_K(2,2*SLOTB);
  WAIT_BAR(3);
  qkt(pA0,pA1,Kbase,qr,f32x16{},r32,hi);asm volatile("s_nop 15\n\ts_nop 7":"+v"(pA0),"+v"(pA1));CMASK(pA0,pA1,0);
  if(NT>4&&!(SELBITS()&1u)){
  #pragma unroll
  for(int r=0;r<16;++r){pA0[r]=-INFINITY;pA1[r]=-INFINITY;}}
  START(pA0,pA1);
  _Pragma("unroll") for(int r=0;r<16;++r)pA1[r]=__builtin_amdgcn_exp2f(pA1[r]);
  WAIT_BAR(0);
  DMA_K(3,0);DMA_V(1,SLOTB);
  ROT();
  kload8(kf,kp0+sl_cur);
  WAIT_BAR(2);
  s16x4 vlo[8],vhi[8]; u32x4 pw0,pw1,pw2,pw3;
  #define PKW(P,B) cvtpk_s(P[B],P[B+1])
  #define PAF(k) __builtin_bit_cast(bf16x8,pw##k)
  #define VFR(i) (bf16x8){vlo[i][0],vlo[i][1],vlo[i][2],vlo[i][3],vhi[i][0],vhi[i][1],vhi[i][2],vhi[i][3]}
  #define PIN(x) asm volatile("":"+v"(x))
  #define MX3(a,b,c) __builtin_fmaxf(__builtin_fmaxf((a),(b)),(c))
  #define GAPA(MF,A0,A1,A2,A3,W0,W1,PW) do{ MF; sacc+=A0; sacc+=A1; sacc+=A2; sacc+=A3; PIN(sacc); W0; W1; PIN(PW); SBAR(); }while(0)
  #define EX(v) __builtin_amdgcn_exp2f(v)
  #define GAPB(MF,X,B) do{ MF; X[B]=EX(X[B]); X[B+1]=EX(X[B+1]); X[B+2]=EX(X[B+2]); X[B+3]=EX(X[B+3]); PIN(X); SBAR(); }while(0)
  #define VRD(i) do{ vlo[i]=vtr(vp_+(((i)>>2)*4096+((i)&3)*1024)); vhi[i]=vtr(vp_+(((i)>>2)*4096+((i)&3)*1024+512)); }while(0)
  #define KRD(G,j) do{ if(G){ kload2(kf,kp0+sl_next,j); SBAR(); } }while(0)
  #define STEP(C0,C1,P0,P1,t,GK,GV,GL) do{ SBAR(); \
    const lds_cptr vp_=vp0+sl_prev; \
    VRD(0); SBAR(); float sacc=(P0[0]+P0[1]); \
    GAPA(C0=__builtin_amdgcn_mfma_f32_32x32x16_bf16(kf[0],qr[0],f32x16{},0,0,0), P0[2],P0[3],P0[4],P0[5],     pw0[0]=PKW(P0,0), pw0[1]=PKW(P0,2), pw0); \
    VRD(4); SBAR(); GAPA(C1=__builtin_amdgcn_mfma_f32_32x32x16_bf16(kf[1],qr[0],f32x16{},0,0,0), P0[6],P0[7],P0[8],P0[9],     pw0[2]=PKW(P0,4), pw0[3]=PKW(P0,6), pw0); \
    VRD(1); SBAR(); GAPA(C0=__builtin_amdgcn_mfma_f32_32x32x16_bf16(kf[2],qr[1],C0,0,0,0),   P0[10],P0[11],P0[12],P0[13], pw1[0]=PKW(P0,8), pw1[1]=PKW(P0,10), pw1); \
    VRD(5); SBAR(); GAPA(C1=__builtin_amdgcn_mfma_f32_32x32x16_bf16(kf[3],qr[1],C1,0,0,0),   P0[14],P0[15],P1[0],P1[1],   pw1[2]=PKW(P0,12),pw1[3]=PKW(P0,14), pw1); \
    VRD(2); SBAR(); GAPA(C0=__builtin_amdgcn_mfma_f32_32x32x16_bf16(kf[4],qr[2],C0,0,0,0),   P1[2],P1[3],P1[4],P1[5],     pw2[0]=PKW(P1,0), pw2[1]=PKW(P1,2), pw2); \
    VRD(6); SBAR(); GAPA(C1=__builtin_amdgcn_mfma_f32_32x32x16_bf16(kf[5],qr[2],C1,0,0,0),   P1[6],P1[7],P1[8],P1[9],     pw2[2]=PKW(P1,4), pw2[3]=PKW(P1,6), pw2); \
    VRD(3); SBAR(); GAPA(C0=__builtin_amdgcn_mfma_f32_32x32x16_bf16(kf[6],qr[3],C0,0,0,0),   P1[10],P1[11],P1[12],P1[13], pw3[0]=PKW(P1,8), pw3[1]=PKW(P1,10), pw3); \
    VRD(7); SBAR(); GAPA(C1=__builtin_amdgcn_mfma_f32_32x32x16_bf16(kf[7],qr[3],C1,0,0,0),   P1[14],P1[15],0.f,0.f,       pw3[2]=PKW(P1,12),pw3[3]=PKW(P1,14), pw3); \
    l_reg+=sacc; \
    if(GK){DMA_K((t)+3,sl_cur);} if(GV){DMA_V((t)+1,sl_next);} \
    { float bias_=-mhat; if((t)<NT-4&&!((SELBITS()>>((t)>>2))&1u))bias_=-INFINITY; _Pragma("unroll") for(int r=0;r<16;++r){C0[r]+=bias_;C1[r]+=bias_;} } \
    CMASK(C0,C1,t); \
    { float a=MX3(C0[0],C0[1],C1[0]),b=MX3(C0[2],C0[3],C1[1]); a=MX3(a,C1[2],C1[3]); \
      _Pragma("unroll") for(int r=4;r<16;r+=4){a=MX3(a,C0[r],C0[r+1]);b=MX3(b,C0[r+2],C0[r+3]);a=MX3(a,C1[r],C1[r+1]);b=MX3(b,C1[r+2],C1[r+3]);} \
      float rm=__builtin_fmaxf(a,b); { auto rr=__builtin_amdgcn_permlane32_swap(__float_as_uint(rm),__float_as_uint(rm),false,false); rm=__builtin_fmaxf(__uint_as_float(rr[0]),__uint_as_float(rr[1])); } \
      resc=false; \
      if(__builtin_expect(__any(rm>(float)THRL),0)){ const float dl=__builtin_fmaxf(rm,0.f); mhat+=dl; \
        _Pragma("unroll") for(int r=0;r<16;++r){C0[r]-=dl;C1[r]-=dl;} \
        const float f=__builtin_amdgcn_exp2f(-dl); l_reg*=f; if(hi==0)wsf[r32]=f; resc=true; } } \
    SBAR(); \
    GAPB(o[0]=__builtin_amdgcn_mfma_f32_32x32x16_bf16(PAF(0),VFR(0),o[0],0,0,0), C0,0); \
    GAPB(o[1]=__builtin_amdgcn_mfma_f32_32x32x16_bf16(PAF(0),VFR(4),o[1],0,0,0), C0,4); \
    KRD(GL,0); GAPB(o[0]=__builtin_amdgcn_mfma_f32_32x32x16_bf16(PAF(1),VFR(1),o[0],0,0,0), C0,8); \
    KRD(GL,1); GAPB(o[1]=__builtin_amdgcn_mfma_f32_32x32x16_bf16(PAF(1),VFR(5),o[1],0,0,0), C0,12); \
    KRD(GL,2); GAPB(o[0]=__builtin_amdgcn_mfma_f32_32x32x16_bf16(PAF(2),VFR(2),o[0],0,0,0), C1,0); \
    KRD(GL,3); GAPB(o[1]=__builtin_amdgcn_mfma_f32_32x32x16_bf16(PAF(2),VFR(6),o[1],0,0,0), C1,4); \
    GAPB(o[0]=__builtin_amdgcn_mfma_f32_32x32x16_bf16(PAF(3),VFR(3),o[0],0,0,0), C1,8); \
    GAPB(o[1]=__builtin_amdgcn_mfma_f32_32x32x16_bf16(PAF(3),VFR(7),o[1],0,0,0), C1,12); \
    }while(0)
  int t=1;
  #undef CMASK
  #define CMASK(P0,P1,t) do{}while(0)
  for(;t+5<NT;t+=2){
    STEP(pB0,pB1,pA0,pA1,t,true,true,true);     WAIT_BAR(2); RESC(); ROT();
    STEP(pA0,pA1,pB0,pB1,t+1,true,true,true);   WAIT_BAR(2); RESC(); ROT();
  }
  #undef CMASK
  #define CMASK(P0,P1,t) do{int jb_=(t)-(NT-4); if(jb_>=0)cmask(P0,P1,jb_,qrel,hi);}while(0)
  #define ENDW(tt) do{ if((tt)+3<NT){WAIT_BAR(2);} else if((tt)+2<NT){WAIT_BAR(1);} else {WAIT_BAR(0);} }while(0)
  for(;t+1<NT;t+=2){
    STEP(pB0,pB1,pA0,pA1,t,(t+3<NT),(t+1<NT),(t+1<NT));       ENDW(t);   RESC(); ROT();
    STEP(pA0,pA1,pB0,pB1,t+1,(t+4<NT),(t+2<NT),(t+2<NT));     ENDW(t+1); RESC(); ROT();
  }
  STEP(pB0,pB1,pA0,pA1,NT-1,false,false,false); RESC();
  { float sacc=pB0[0]+pB0[1]; _Pragma("unroll") for(int r=2;r<16;++r)sacc+=pB0[r]; _Pragma("unroll") for(int r=0;r<16;++r)sacc+=pB1[r]; l_reg+=sacc;
    pw0=(u32x4){PKW(pB0,0),PKW(pB0,2),PKW(pB0,4),PKW(pB0,6)};pw1=(u32x4){PKW(pB0,8),PKW(pB0,10),PKW(pB0,12),PKW(pB0,14)};pw2=(u32x4){PKW(pB1,0),PKW(pB1,2),PKW(pB1,4),PKW(pB1,6)};pw3=(u32x4){PKW(pB1,8),PKW(pB1,10),PKW(pB1,12),PKW(pB1,14)};
    SBAR(); pv(o,vb0+sl_cur,PAF(0),PAF(1),PAF(2),PAF(3)); }
  #undef PKW
  #undef PAF
  #undef VFR
  #undef PIN
  #undef MX3
  #undef GAPA
  #undef GAPB
  #undef EX
  #undef VRD
  #undef KRD
  #undef STEP
  #undef ENDW
  {auto rr=__builtin_amdgcn_permlane32_swap(__float_as_uint(l_reg),__float_as_uint(l_reg),false,false);l_reg=__uint_as_float(rr[0])+__uint_as_float(rr[1]);}
  if(hi==0)wsf[32+r32]=l_reg;asm volatile("s_waitcnt lgkmcnt(0)":::"memory");
  float rli[16];
  #pragma unroll
  for(int r=0;r<16;++r)rli[r]=__builtin_amdgcn_rcpf(wsf[32+crow(r,hi)]);
  bf16*Ow=O+(rowbase+q0+wid*QBLK)*OPITCH+h*D;
  { bf16*stg=(bf16*)(shm+LDS_OST)+wid*2048;
    #pragma unroll
    for(int r=0;r<16;++r){const int orow=crow(r,hi);
      #pragma unroll
      for(int d0=0;d0<2;++d0)stg[orow*64+d0*32+r32]=__float2bfloat16(o[d0][r]*rli[r]);}
    asm volatile("s_waitcnt lgkmcnt(0)":::"memory");
    #pragma unroll
    for(int i=0;i<4;++i){const int row=i*8+(lane>>3),ch=lane&7; const u32x4 v=*(const u32x4*)(stg+row*64+ch*8); ATTN_STORE16(Ow+(long)row*OPITCH+ch*8,v);} }
  asm volatile("s_waitcnt lgkmcnt(0)\n\ts_barrier":::"memory");
  #undef DMA_K
  #undef DMA_V
  #undef CMASK
  #undef START
  #undef RESC
  #undef ROT
}
constexpr int ATTN_LDS_BYTES=LDS_BYTES;
constexpr int GATE_KM_OFF=86016, GATE_SEL_OFF=GATE_KM_OFF+4096, GATE_MAXU=16, ATTN_LDS_TOTAL=GATE_SEL_OFF+GATE_MAXU*1024;
__device__ __forceinline__ void moba_gate(int b,int h,int qb,const bf16*Q,const float*KM,char*shm,int slot){
  int tid_=threadIdx.x; asm volatile("":"+v"(tid_)); const int tid=tid_;
  float*kmS=(float*)(shm+GATE_KM_OFF); unsigned*selS=(unsigned*)(shm+GATE_SEL_OFF)+slot*QB;
  if(qb>3){
    for(int i=tid;i<qb*64;i+=512)kmS[i]=KM[(size_t)((b*16+(i>>6))*512)+h*64+(i&63)];
    __syncthreads();
    const int row=tid>>1,half=tid&1;
    const bf16*qp=Q+((long)b*SEQ+qb*QB+row)*DM+h*D+half*32;
    float qv[32];
    #pragma unroll
    for(int c=0;c<4;++c){const u32x4 w=*reinterpret_cast<const u32x4*>(qp+c*8);
      #pragma unroll
      for(int e=0;e<4;++e){qv[c*8+2*e]=__uint_as_float(w[e]<<16);qv[c*8+2*e+1]=__uint_as_float(w[e]&0xffff0000u);}}
    float v0=-INFINITY,v1=-INFINITY,v2=-INFINITY;int i0=0,i1=0,i2=0;
    for(int n=0;n<qb;++n){const float*kr=kmS+n*64+half*32;float d=0.f;
      #pragma unroll
      for(int e=0;e<32;++e)d+=qv[e]*kr[e];
      d+=__shfl_xor(d,1);
      if(d>v0){v2=v1;i2=i1;v1=v0;i1=i0;v0=d;i0=n;}else if(d>v1){v2=v1;i2=i1;v1=d;i1=n;}else if(d>v2){v2=d;i2=n;}}
    if(half==0)selS[row]=(1u<<i0)|(1u<<i1)|(1u<<i2);
  }else{ if(tid<QB)selS[tid]=(1u<<qb)-1u; }
  __syncthreads();
}
struct AttnTensors { const bf16* Q; const bf16* K; const bf16* V; bf16* O; const float* KM; };
__device__ __forceinline__ void unit_of(int idx,int&b,int&h,int&qb){
  const int v=idx&255,i=idx>>8; const int bh=v>>2,s0=(v&3)*2; qb=(i==0)?s0:(i==1)?15-s0:(i==2)?s0+1:14-s0; b=bh/NHEAD; h=bh%NHEAD;
}
template<int THRL=8> __device__ __forceinline__ void attn_phase(char*lds,const AttnTensors&T,int G,int block){
  const int vcu=(G%8==0)?(block%8)*(G/8)+block/8:block;
  { int slot=0; for(int idx=vcu;idx<BATCH*NHEAD*NQB&&slot<GATE_MAXU;idx+=G,++slot){ int b,h,qb; unit_of(idx,b,h,qb); moba_gate(b,h,qb,T.Q,T.KM,lds,slot); } }
  const unsigned selS0=(unsigned)(uintptr_t)(lds+GATE_SEL_OFF);
  int slot=0;
  for(int idx=vcu;idx<BATCH*NHEAD*NQB;idx+=G,++slot){
    int b,h,qb; unit_of(idx,b,h,qb);
    attn_unit<THRL>(b,h,qb,selS0+(unsigned)slot*(QB*4),T.Q,T.K,T.V,T.O,lds);
  }
}
#undef SBAR
#undef WAIT_BAR
}
namespace mk {
using pg8::bf16_t; using pg8::bf16x8; using pg8::f32x4; using pg8::u32x4; using pg8::Unit; using pg8::cvt_pk_bf16;
typedef unsigned u32x2 __attribute__((ext_vector_type(2)));
constexpr int NB = 8, SEQ = 4096, DMODEL = 1024, T = NB * SEQ, FF = 2816, NIN = 5632, INW = 5640;
constexpr int ZP = 5632;
constexpr int ZC_Q = 0, ZC_K = 512, ZC_V = 1024, ZC_QKB = 1536, ZC_VB = 2560, ZC_OB = 3072, ZC_GA = 3584, ZC_GB = 4608;
constexpr float EPS = 1e-6f;
constexpr float C2 = 0.125f * 1.4426950408889634f;
constexpr size_t MiB = 1u << 20;
constexpr size_t WS_BAR = 0;
constexpr size_t WS_WIN = 2 * MiB, WS_WPA = 13 * MiB, WS_WPB = 14 * MiB, WS_WOUT = 15 * MiB;
constexpr size_t WS_R1 = 17 * MiB, WS_KMEAN = 17 * MiB + 128 * 1024, WS_MST = 17 * MiB + 384 * 1024, WS_MC = 17 * MiB + 400 * 1024;
constexpr size_t WS_ROPE = 18 * MiB, WS_GATES = 19 * MiB, WS_SS = 20 * MiB, WS_DN = 22 * MiB, WS_NST = 23 * MiB;
constexpr size_t WS_XB = 24 * MiB;
constexpr size_t WS_YA = 88 * MiB, WS_YB = 120 * MiB;
constexpr size_t WS_Z = 152 * MiB;
constexpr size_t WS_WGU = 328 * MiB + 152 * MiB - 152 * MiB, WS_WDN = 340 * MiB, WS_END = 504 * MiB;
static_assert(WS_Z + (size_t)T * ZP * 2 <= WS_END && WS_Z + (size_t)T * FF * 2 <= WS_WGU && WS_WGU + (size_t)NIN * 1024 * 2 <= WS_WDN && WS_WDN + (size_t)1024 * FF * 2 <= WS_END, "ws map");

struct Params {
    const float* x; const float* g_mix; const float* w_in; const float* conv_w; const float* b_i; const float* b_f; const float* g_ml;
    const float* w_pa; const float* w_pb; const float* w_out; const float* g_ffn; const float* w_gu; const float* w_dn; const float* g_fin;
    float* out; unsigned char* ws;
};

__device__ __forceinline__ float bf2f(unsigned short b) { return __uint_as_float(((unsigned)b) << 16); }
__device__ __forceinline__ unsigned short f2bf(float f) { unsigned u = __float_as_uint(f); return (unsigned short)((u + 0x7fffu + ((u >> 16) & 1u)) >> 16); }
typedef float f32x2_t __attribute__((ext_vector_type(2))); typedef __bf16 bf16x2_t __attribute__((ext_vector_type(2)));
__device__ __forceinline__ unsigned cvtpk_safe(float lo, float hi) { f32x2_t v = {lo, hi}; bf16x2_t b = __builtin_convertvector(v, bf16x2_t); return __builtin_bit_cast(unsigned, b); }
__device__ __forceinline__ float wave_sum(float v) {
#pragma unroll
    for (int o = 1; o < 64; o <<= 1) v += __shfl_xor(v, o);
    return v;
}
template <int CTRL> __device__ __forceinline__ float dpp_mov(float v) { return __int_as_float(__builtin_amdgcn_update_dpp(0, __float_as_int(v), CTRL, 0xf, 0xf, false)); }
__device__ __forceinline__ float row_sum16(float v) { v += dpp_mov<0x128>(v); v += dpp_mov<0x124>(v); v += dpp_mov<0x122>(v); v += dpp_mov<0x121>(v); return v; }
__device__ __forceinline__ float wave_max(float v) {
#pragma unroll
    for (int o = 1; o < 64; o <<= 1) v = fmaxf(v, __shfl_xor(v, o));
    return v;
}
__device__ __forceinline__ float sigmoidf_(float v) { return __builtin_amdgcn_rcpf(1.f + __expf(-v)); }
__device__ __forceinline__ float siluf_(float v) { return v * __builtin_amdgcn_rcpf(1.f + __expf(-v)); }
__device__ __forceinline__ float logsigmoidf_(float v) { return fminf(v, 0.f) - log1pf(__expf(-fabsf(v))); }
__device__ __forceinline__ void unpack8(const u32x4 w, float (&f)[8]) {
#pragma unroll
    for (int e = 0; e < 4; ++e) { f[2 * e] = __uint_as_float(w[e] << 16); f[2 * e + 1] = __uint_as_float(w[e] & 0xffff0000u); }
}

struct EpiInProj {
    static constexpr bool PERM = true, AFTER_DRAIN = false, MID = false;
    bf16_t* Z; const float* r1; const float* rope; float* kmean;
    __device__ __forceinline__ void operator()(const f32x4 (&acc)[2][2][4][2], const Unit& u, int wr, int wc, int fr, int fq) const {
        const int row0 = u.pm * 256 + wr * 64 + fr, pn = u.pn, col0 = pn * 256 + wc * 32 + 8 * fq;
        if (pn < 4) {
            const bool isK = pn >= 2; const float sc = isK ? 1.f : C2; const int jj = 4 * (wc & 1) + fq;
            f32x4 cs[2][2];
#pragma unroll
            for (int a = 0; a < 2; ++a)
#pragma unroll
                for (int b = 0; b < 2; ++b) cs[a][b] = (f32x4){0.f, 0.f, 0.f, 0.f};
#pragma unroll
            for (int ai = 0; ai < 2; ++ai)
#pragma unroll
                for (int m = 0; m < 4; ++m) {
                    const int row = row0 + ai * 128 + m * 16; const float rs = sc; const int pos = row & (SEQ - 1);
                    const f32x4 c4 = *(const f32x4*)(rope + (size_t)(pos * 8 + jj) * 8), s4 = *(const f32x4*)(rope + (size_t)(pos * 8 + jj) * 8 + 4);
                    bf16_t* rowp = Z + (size_t)row * ZP + col0;
#pragma unroll
                    for (int bj = 0; bj < 2; ++bj) {
                        const f32x4 v0 = acc[ai][bj][m][0] * rs, v1 = acc[ai][bj][m][1] * rs;
                        const f32x4 o0 = v0 * c4 - v1 * s4, o1 = v1 * c4 + v0 * s4;
                        cs[bj][0] += o0; cs[bj][1] += o1;
                        u32x4 w; w.x = cvt_pk_bf16(o0[0], o0[1]); w.y = cvt_pk_bf16(o0[2], o0[3]); w.z = cvt_pk_bf16(o1[0], o1[1]); w.w = cvt_pk_bf16(o1[2], o1[3]);
                        *(u32x4*)(rowp + bj * 128) = w;
                    }
                }
            if (isK) {
#pragma unroll
                for (int bj = 0; bj < 2; ++bj)
#pragma unroll
                    for (int n = 0; n < 2; ++n)
#pragma unroll
                        for (int i = 0; i < 4; ++i) {
                            float v = cs[bj][n][i];
                            v = row_sum16(v);
                            if (fr == 0) atomicAdd(kmean + (size_t)u.pm * 512 + (pn - 2) * 256 + bj * 128 + wc * 32 + 8 * fq + 4 * n + i, v);
                        }
            }
        } else if (pn < 14) {
            const bool sig = pn >= 12;
#pragma unroll
            for (int ai = 0; ai < 2; ++ai)
#pragma unroll
                for (int m = 0; m < 4; ++m) {
                    const int row = row0 + ai * 128 + m * 16;
                    bf16_t* rowp = Z + (size_t)row * ZP + col0;
#pragma unroll
                    for (int bj = 0; bj < 2; ++bj) {
                        f32x4 v0 = acc[ai][bj][m][0], v1 = acc[ai][bj][m][1];
                        if (sig) {
#pragma unroll
                            for (int i = 0; i < 4; ++i) { v0[i] = sigmoidf_(v0[i]); v1[i] = sigmoidf_(v1[i]); }
                        }
                        u32x4 w; w.x = cvt_pk_bf16(v0[0], v0[1]); w.y = cvt_pk_bf16(v0[2], v0[3]); w.z = cvt_pk_bf16(v1[0], v1[1]); w.w = cvt_pk_bf16(v1[2], v1[3]);
                        *(u32x4*)(rowp + bj * 128) = w;
                    }
                }
        } else {
            const int oc0 = 128 * (pn - 14) + 32 * wc + 8 * fq;
#pragma unroll
            for (int ai = 0; ai < 2; ++ai)
#pragma unroll
                for (int m = 0; m < 4; ++m) {
                    const int row = row0 + ai * 128 + m * 16; float r[8], sb[8];
#pragma unroll
                    for (int bj = 0; bj < 2; ++bj) { const f32x4 v0 = acc[ai][bj][m][0], v1 = acc[ai][bj][m][1];
#pragma unroll
                        for (int i = 0; i < 4; ++i) { const float ea = 1.f + __expf(-v0[i]), eb = 1.f + __expf(-v1[i]); sb[4 * bj + i] = __builtin_amdgcn_rcpf(eb); r[4 * bj + i] = eb * __builtin_amdgcn_rcpf(ea); } }
                    bf16_t* gp = Z + (size_t)row * ZP + ZC_GA + 2 * oc0;
                    u32x4 w0, w1; w0.x = cvt_pk_bf16(r[0], r[1]); w0.y = cvt_pk_bf16(r[2], r[3]); w0.z = cvt_pk_bf16(r[4], r[5]); w0.w = cvt_pk_bf16(r[6], r[7]);
                    w1.x = cvt_pk_bf16(sb[0], sb[1]); w1.y = cvt_pk_bf16(sb[2], sb[3]); w1.z = cvt_pk_bf16(sb[4], sb[5]); w1.w = cvt_pk_bf16(sb[6], sb[7]);
                    *(u32x4*)gp = w0; *(u32x4*)(gp + 8) = w1;
                }
        }
    }
};
struct EpiMerge {
    static constexpr bool PERM = true, AFTER_DRAIN = false, MID = true;
    const bf16_t* Zg; bf16_t* O;
    __device__ __forceinline__ void mid(f32x4 (&acc)[2][2][4][2], const Unit& u, int wr, int wc, int fr, int fq) const {
        int row0 = u.pm * 256 + wr * 64 + fr; asm volatile("" : "+v"(row0)); const int col0 = u.pn * 256 + wc * 32 + 8 * fq;
#pragma unroll
        for (int ai = 0; ai < 2; ++ai)
#pragma unroll
            for (int m = 0; m < 4; ++m) {
                const int row = row0 + ai * 128 + m * 16;
#pragma unroll
                for (int bj = 0; bj < 2; ++bj) {
                    float r[8]; unpack8(*(const u32x4*)(Zg + (size_t)row * ZP + 2 * (col0 + bj * 128)), r);
#pragma unroll
                    for (int i = 0; i < 4; ++i) { acc[ai][bj][m][0][i] *= r[i]; acc[ai][bj][m][1][i] *= r[4 + i]; }
                }
            }
    }
    __device__ __forceinline__ void operator()(const f32x4 (&acc)[2][2][4][2], const Unit& u, int wr, int wc, int fr, int fq) const {
        const int row0 = u.pm * 256 + wr * 64 + fr, col0 = u.pn * 256 + wc * 32 + 8 * fq;
#pragma unroll
        for (int ai = 0; ai < 2; ++ai)
#pragma unroll
            for (int m = 0; m < 4; ++m) {
                const int row = row0 + ai * 128 + m * 16;
#pragma unroll
                for (int bj = 0; bj < 2; ++bj) {
                    float gb[8]; unpack8(*(const u32x4*)(Zg + (size_t)row * ZP + 2 * (col0 + bj * 128) + 8), gb);
                    const f32x4 v0 = acc[ai][bj][m][0], v1 = acc[ai][bj][m][1];
                    u32x4 w; w.x = cvt_pk_bf16(v0[0] * gb[0], v0[1] * gb[1]); w.y = cvt_pk_bf16(v0[2] * gb[2], v0[3] * gb[3]); w.z = cvt_pk_bf16(v1[0] * gb[4], v1[1] * gb[5]); w.w = cvt_pk_bf16(v1[2] * gb[6], v1[3] * gb[7]);
                    *(u32x4*)(O + (size_t)row * 1024 + col0 + bj * 128) = w;
                }
            }
    }
};
struct EpiOut {
    static constexpr bool PERM = true, AFTER_DRAIN = false, MID = false;
    const float* x; bf16_t* h1b; float* ss;
    __device__ __forceinline__ void operator()(const f32x4 (&acc)[2][2][4][2], const Unit& u, int wr, int wc, int fr, int fq) const {
        const int row0 = u.pm * 256 + wr * 64 + fr, col0 = u.pn * 256 + wc * 32 + 8 * fq;
#pragma unroll
        for (int ai = 0; ai < 2; ++ai)
#pragma unroll
            for (int m = 0; m < 4; ++m) {
                const int row = row0 + ai * 128 + m * 16; float s = 0.f;
#pragma unroll
                for (int bj = 0; bj < 2; ++bj) {
                    const size_t off = (size_t)row * 1024 + col0 + bj * 128;
                    const f32x4 a0 = *(const f32x4*)(x + off) + acc[ai][bj][m][0], a1 = *(const f32x4*)(x + off + 4) + acc[ai][bj][m][1];
                    s += (a0[0] * a0[0] + a0[1] * a0[1]) + (a0[2] * a0[2] + a0[3] * a0[3]) + (a1[0] * a1[0] + a1[1] * a1[1]) + (a1[2] * a1[2] + a1[3] * a1[3]);
                    u32x4 w; w.x = cvt_pk_bf16(a0[0], a0[1]); w.y = cvt_pk_bf16(a0[2], a0[3]); w.z = cvt_pk_bf16(a1[0], a1[1]); w.w = cvt_pk_bf16(a1[2], a1[3]);
                    *(u32x4*)(h1b + off) = w;
                }
                s += __shfl_xor(s, 16); s += __shfl_xor(s, 32);
                if (fq == 0) atomicAdd(ss + row, s);
            }
    }
};
struct EpiGateUp {
    static constexpr bool PERM = true, AFTER_DRAIN = false, MID = false;
    const float* ss; bf16_t* act;
    __device__ __forceinline__ void operator()(const f32x4 (&acc)[2][2][4][2], const Unit& u, int wr, int wc, int fr, int fq) const {
        const int row0 = u.pm * 256 + wr * 64 + fr, col0 = u.pn * 128 + wc * 32 + 8 * fq;
#pragma unroll
        for (int ai = 0; ai < 2; ++ai)
#pragma unroll
            for (int m = 0; m < 4; ++m) {
                const int row = row0 + ai * 128 + m * 16;
                const float rs = rsqrtf(ss[row] * (1.f / 1024.f) + EPS);
                float o[8];
#pragma unroll
                for (int bj = 0; bj < 2; ++bj) {
                    const f32x4 g = acc[ai][bj][m][0] * rs, up = acc[ai][bj][m][1] * rs;
#pragma unroll
                    for (int i = 0; i < 4; ++i) o[4 * bj + i] = siluf_(g[i]) * up[i];
                }
                u32x4 w; w.x = cvt_pk_bf16(o[0], o[1]); w.y = cvt_pk_bf16(o[2], o[3]); w.z = cvt_pk_bf16(o[4], o[5]); w.w = cvt_pk_bf16(o[6], o[7]);
                *(u32x4*)(act + (size_t)row * FF + col0) = w;
            }
    }
};
struct EpiDown {
    static constexpr bool PERM = true, AFTER_DRAIN = false, MID = false;
    const bf16_t* h1b; bf16_t* h2b;
    __device__ __forceinline__ void operator()(const f32x4 (&acc)[2][2][4][2], const Unit& u, int wr, int wc, int fr, int fq) const {
        const int row0 = u.pm * 256 + wr * 64 + fr, col0 = u.pn * 256 + wc * 32 + 8 * fq;
#pragma unroll
        for (int ai = 0; ai < 2; ++ai)
#pragma unroll
            for (int m = 0; m < 4; ++m) {
                const int row = row0 + ai * 128 + m * 16;
#pragma unroll
                for (int bj = 0; bj < 2; ++bj) {
                    const size_t off = (size_t)row * 1024 + col0 + bj * 128;
                    float r[8]; unpack8(*(const u32x4*)(h1b + off), r);
                    const f32x4 a0 = acc[ai][bj][m][0], a1 = acc[ai][bj][m][1];
                    u32x4 w; w.x = cvt_pk_bf16(r[0] + a0[0], r[1] + a0[1]); w.y = cvt_pk_bf16(r[2] + a0[2], r[3] + a0[3]); w.z = cvt_pk_bf16(r[4] + a1[0], r[5] + a1[1]); w.w = cvt_pk_bf16(r[6] + a1[2], r[7] + a1[3]);
                    *(u32x4*)(h2b + off) = w;
                }
            }
    }
};
}
namespace mk {
#define LAS __attribute__((address_space(3)))
constexpr int NTHR = 512, RING_BYTES = 131072, LDS_BYTES = 147456;

__device__ __forceinline__ int srccol_in(int n) {
    if (n < 1024) { const int hd = n >> 6, p = n & 63, j = p >> 3, i = p & 7; return (hd << 6) + ((i < 4) ? 4 * j + i : 32 + 4 * j + (i - 4)); }
    if (n < 3584) return n;
    { const int q = n - 3584, t = q >> 8, bj = (q >> 7) & 1, wc = (q >> 5) & 3, fq = (q >> 3) & 3, nn = (q >> 2) & 1, i = q & 3; const int oc = 128 * t + 32 * wc + 8 * fq + 4 * bj + i; return nn ? 4616 + oc : 3592 + oc; }
}
__device__ __forceinline__ int srccol_gu(int n) { const int pn = n >> 8, bj = (n >> 7) & 1, wc = (n >> 5) & 3, fq = (n >> 3) & 3, nn = (n >> 2) & 1, i = n & 3; const int oc = 128 * pn + 32 * wc + 8 * fq + 4 * bj + i; return nn ? FF + oc : oc; }
template <int MODE> __device__ __forceinline__ void tr_item(const float* W, int K, int Nsrc, int Ndst, const float* gain, bf16_t* WT, float* scr, int item, int lane, int Kp = 0, int koff = 0) {
    if (Kp == 0) Kp = K;
    const int nblk = Ndst / 32, kb = item / nblk, nb = item % nblk, k0 = 64 * kb, n0 = 32 * nb;
    const int nd = n0 + (lane & 31); const int sc = MODE == 1 ? srccol_in(nd) : MODE == 2 ? srccol_gu(nd) : nd;
#pragma unroll
    for (int i = 0; i < 32; ++i) { const int kk = 2 * i + (lane >> 5); float v = W[(size_t)(k0 + kk) * Nsrc + sc]; if (gain) v *= gain[k0 + kk]; scr[kk * 33 + (lane & 31)] = v; }
    asm volatile("s_waitcnt lgkmcnt(0)" ::: "memory");
    const int c = lane & 7;
#pragma unroll
    for (int j = 0; j < 4; ++j) { const int n = (lane >> 3) + 8 * j; const float* s = scr + (8 * c) * 33 + n;
        u32x4 o; o.x = cvt_pk_bf16(s[0 * 33], s[1 * 33]); o.y = cvt_pk_bf16(s[2 * 33], s[3 * 33]); o.z = cvt_pk_bf16(s[4 * 33], s[5 * 33]); o.w = cvt_pk_bf16(s[6 * 33], s[7 * 33]);
        *(u32x4*)(WT + (size_t)(n0 + n) * Kp + koff + k0 + 8 * c) = o; }
    asm volatile("s_waitcnt lgkmcnt(0)" ::: "memory");
}

__device__ __forceinline__ void p0_prologue(const Params& p, unsigned char* lds, int G) {
    int tid_ = threadIdx.x; asm volatile("" : "+v"(tid_));
    const int tid = tid_, lane = tid & 63, wave = tid >> 6;
    const int gw = blockIdx.x * 8 + wave, NGW = G * 8, gt = blockIdx.x * NTHR + tid, NGT = G * NTHR;
    unsigned char* ws = p.ws;
    float* scr = (float*)(lds + wave * 8704);
    float* GW = (float*)(lds + 73728);
    for (int i = tid; i < 8192; i += NTHR) { const int k = i >> 3, c = i & 7; const int slot = (((k >> 8) * 4 + (k & 3)) * 64 + ((k >> 2) & 63)); GW[slot * 8 + c] = p.w_in[(size_t)k * INW + 3584 + c] * p.g_mix[k]; }
    { float* km = (float*)(ws + WS_KMEAN); for (int i = gt; i < NB * 16 * 512; i += NGT) km[i] = 0.f; }
    { float* r2 = (float*)(ws + WS_R1); for (int i = gt; i < T; i += NGT) r2[i] = 0.f; }
    { float* rt = (float*)(ws + WS_ROPE);
      for (int i = gt; i < SEQ * 32; i += NGT) { const int pos = i >> 5, d = i & 31; const float inv = powf(10000.f, -(float)d / 32.f); const float ang = (float)pos * inv; float s, c; sincosf(ang, &s, &c);
          const int j = d >> 2, ii = d & 3; rt[(size_t)(pos * 8 + j) * 8 + ii] = c; rt[(size_t)(pos * 8 + j) * 8 + 4 + ii] = s; } }
    { constexpr int I_IN = 16 * (NIN / 32), I_PA = 8 * 32, I_PB = 8 * 32, I_OUT = 16 * 32; constexpr int NITEMS = I_IN + I_PA + I_PB + I_OUT;
      for (int it = gw; it < NITEMS; it += NGW) { int r = it;
          if (r < I_IN) { tr_item<1>(p.w_in, 1024, INW, NIN, p.g_mix, (bf16_t*)(ws + WS_WIN), scr, r, lane); continue; } r -= I_IN;
          if (r < I_PA) { tr_item<0>(p.w_pa, 512, 1024, 1024, nullptr, (bf16_t*)(ws + WS_WPA), scr, r, lane, 1024, 0); continue; } r -= I_PA;
          if (r < I_PB) { tr_item<0>(p.w_pb, 512, 1024, 1024, nullptr, (bf16_t*)(ws + WS_WPA), scr, r, lane, 1024, 512); continue; } r -= I_PB;
          tr_item<0>(p.w_out, 1024, 1024, 1024, nullptr, (bf16_t*)(ws + WS_WOUT), scr, r, lane); } }
    __syncthreads();
    { bf16_t* XB = (bf16_t*)(ws + WS_XB); float* R1 = (float*)(ws + WS_R1); float* GT = (float*)(ws + WS_GATES);
      const int qsel = (lane >> 1) & 31, csel = qsel & 7; const float bias = csel < 4 ? p.b_i[csel] : p.b_f[csel - 4];
      for (int rb = gw * 16; rb < T; rb += NGW * 16) {
        for (int r4 = 0; r4 < 16; r4 += 4) {
          const int row = rb + r4;
          f32x4 v[4][4]; float ssq[4];
#pragma unroll
          for (int r = 0; r < 4; ++r) { const f32x4* xr = (const f32x4*)(p.x + (size_t)(row + r) * 1024) + lane;
#pragma unroll
              for (int j = 0; j < 4; ++j) v[r][j] = xr[64 * j]; }
          float acc[32];
#pragma unroll
          for (int q = 0; q < 32; ++q) acc[q] = 0.f;
#pragma unroll
          for (int r = 0; r < 4; ++r) { float s = 0.f;
#pragma unroll
              for (int j = 0; j < 4; ++j) s += (v[r][j][0] * v[r][j][0] + v[r][j][1] * v[r][j][1]) + (v[r][j][2] * v[r][j][2] + v[r][j][3] * v[r][j][3]);
              ssq[r] = s; }
#pragma unroll
          for (int j = 0; j < 4; ++j)
#pragma unroll
              for (int i = 0; i < 4; ++i) { const f32x4* gwp = (const f32x4*)(GW + (size_t)((j * 4 + i) * 64 + lane) * 8); const f32x4 g0 = gwp[0], g1 = gwp[1];
#pragma unroll
                  for (int r = 0; r < 4; ++r) { const float xv = v[r][j][i];
#pragma unroll
                      for (int c = 0; c < 4; ++c) { acc[r * 8 + c] += g0[c] * xv; acc[r * 8 + 4 + c] += g1[c] * xv; } } }
#pragma unroll
          for (int r = 0; r < 4; ++r) { ssq[r] = wave_sum(ssq[r]); const float rs = rsqrtf(ssq[r] * (1.f / 1024.f) + EPS); u32x2* o8 = (u32x2*)(XB + (size_t)(row + r) * 1024) + lane;
#pragma unroll
              for (int j = 0; j < 4; ++j) { const f32x4 xs = v[r][j] * rs; u32x2 w; w.x = cvt_pk_bf16(xs[0], xs[1]); w.y = cvt_pk_bf16(xs[2], xs[3]); o8[64 * j] = w; } }
#pragma unroll
          for (int st = 0; st < 5; ++st) { const int M = 32 >> st, n2 = 16 >> st; const bool up = (lane & M) != 0;
#pragma unroll
              for (int i = 0; i < n2; ++i) { const float lo = acc[i], hi = acc[i + n2]; const float send = up ? lo : hi, keep = up ? hi : lo; acc[i] = keep + __shfl_xor(send, M); } }
          const float tot = acc[0] + __shfl_xor(acc[0], 1);
          const int rsel = qsel >> 3; const float ss = rsel == 0 ? ssq[0] : rsel == 1 ? ssq[1] : rsel == 2 ? ssq[2] : ssq[3];
          const float rstd = rsqrtf(ss * (1.f / 1024.f) + EPS);
          if ((lane & 1) == 0) GT[(size_t)(row + rsel) * 8 + csel] = tot * rstd + bias;
        } } }
}
__device__ __forceinline__ void p4_weights(const Params& p, unsigned char* lds, int G) {
    int tid_ = threadIdx.x; asm volatile("" : "+v"(tid_));
    const int tid = tid_, lane = tid & 63, wave = tid >> 6; const int gw = blockIdx.x * 8 + wave, NGW = G * 8;
    float* scr = (float*)(lds + wave * 8704);
    constexpr int I_GU = 16 * (NIN / 32), I_DN = (FF / 64) * 32;
    for (int it = gw; it < I_GU + I_DN; it += NGW) {
        if (it < I_GU) tr_item<2>(p.w_gu, 1024, 2 * FF, NIN, p.g_ffn, (bf16_t*)(p.ws + WS_WGU), scr, it, lane);
        else tr_item<0>(p.w_dn, FF, 1024, 1024, nullptr, (bf16_t*)(p.ws + WS_WDN), scr, it - I_GU, lane);
    }
    __syncthreads();
}

template <int CTRL, int RMASK> __device__ __forceinline__ float dpp_or(float oldv, float v) { return __int_as_float(__builtin_amdgcn_update_dpp(__float_as_int(oldv), __float_as_int(v), CTRL, RMASK, 0xf, false)); }
__device__ __forceinline__ float wave_incl_sum(float v, int) {
    v += dpp_or<0x111, 0xf>(0.f, v); v += dpp_or<0x112, 0xf>(0.f, v); v += dpp_or<0x114, 0xf>(0.f, v); v += dpp_or<0x118, 0xf>(0.f, v);
    v += dpp_or<0x142, 0xa>(0.f, v); v += dpp_or<0x143, 0xc>(0.f, v);
    return v;
}
__device__ __forceinline__ float wave_incl_max(float v, int) {
    const float ninf = -INFINITY;
    v = fmaxf(v, dpp_or<0x111, 0xf>(ninf, v)); v = fmaxf(v, dpp_or<0x112, 0xf>(ninf, v)); v = fmaxf(v, dpp_or<0x114, 0xf>(ninf, v)); v = fmaxf(v, dpp_or<0x118, 0xf>(ninf, v));
    v = fmaxf(v, dpp_or<0x142, 0xa>(ninf, v)); v = fmaxf(v, dpp_or<0x143, 0xc>(ninf, v));
    return v;
}
__device__ __forceinline__ void conv2x8r(const u32x4 (&xr)[5], const float* cw, float (&y)[2][8]) {
#pragma unroll
    for (int hf = 0; hf < 2; ++hf) {
        f32x4 wj[4];
#pragma unroll
        for (int j = 0; j < 4; ++j) wj[j] = *(const f32x4*)(cw + j * 1024 + 4 * hf);
        f32x4 x[5];
#pragma unroll
        for (int i = 0; i < 5; ++i) { const unsigned a = xr[i][2 * hf], b = xr[i][2 * hf + 1]; x[i] = (f32x4){__uint_as_float(a << 16), __uint_as_float(a & 0xffff0000u), __uint_as_float(b << 16), __uint_as_float(b & 0xffff0000u)}; }
#pragma unroll
        for (int r = 0; r < 2; ++r) { const f32x4 z = wj[0] * x[r] + wj[1] * x[r + 1] + wj[2] * x[r + 2] + wj[3] * x[r + 3];
#pragma unroll
            for (int i = 0; i < 4; ++i) y[r][4 * hf + i] = siluf_(z[i]); }
    }
}
__device__ __forceinline__ void load5(const bf16_t* src, int c, int t, u32x4 (&xr)[5]) {
#pragma unroll
    for (int i = 0; i < 5; ++i) { const int tt = t - 3 + i; const bool ok = (c > 0) | (tt >= 0); const u32x4 w = *(const u32x4*)(src + (long)(ok ? tt : 0) * ZP); xr[i] = ok ? w : (u32x4){0u, 0u, 0u, 0u}; }
}
constexpr float KSCALE = 0.08838834764831845f;

struct M1Pre { u32x4 k[5], v[2]; float li, fp; };
__device__ __forceinline__ void m1_issue(const Params& p, int u, int tid, M1Pre& q) {
    const int lane = tid & 63, bh = u >> 6, c = u & 63, b = bh >> 2, h = bh & 3; const size_t row0 = (size_t)b * SEQ + c * 64;
    const bf16_t* Z = (const bf16_t*)(p.ws + WS_Z); const int d0 = (tid & 15) * 8, t = 2 * (tid >> 4);
    load5(Z + row0 * ZP + ZC_QKB + 512 + h * 128 + d0, c, t, q.k);
    const bf16_t* vs = Z + row0 * ZP + ZC_VB + h * 128 + d0; q.v[0] = *(const u32x4*)(vs + (long)t * ZP); q.v[1] = *(const u32x4*)(vs + (long)(t + 1) * ZP);
    const float* gp = (const float*)(p.ws + WS_GATES) + (row0 + lane) * 8; q.li = gp[h]; q.fp = gp[4 + h];
}
__device__ __forceinline__ void m1_compute(const Params& p, unsigned char* lds, int u, int tid_in, const M1Pre& q) {
    int tid = tid_in; asm volatile("" : "+v"(tid));
    const int lane = tid & 63, wid = tid >> 6;
    const int bh = u >> 6, h = bh & 3;
    bf16_t* KT = (bf16_t*)lds; bf16_t* VT = KT + 128 * 72; float* wS = (float*)(VT + 128 * 72); float* dnp = wS + 64;
    if (wid == 0) {
        const float li = q.li, lf = logsigmoidf_(q.fp);
        const float bcs = wave_incl_sum(lf, lane), btot = __shfl(bcs, 63);
        const float g = btot - bcs + li, gm = wave_max(g);
        wS[lane] = __expf(g - gm);
        if (lane == 0) { float* mst = (float*)(p.ws + WS_MST); mst[u * 2] = btot; mst[u * 2 + 1] = gm; }
    }
    const int d0 = (tid & 15) * 8, rg = tid >> 4, t = 2 * rg;
    float y[2][8];
    conv2x8r(q.k, (const float*)(lds + 65536) + 512 + h * 128 + d0, y);
    float vv[2][8]; unpack8(q.v[0], vv[0]); unpack8(q.v[1], vv[1]);
    __syncthreads();
    { const float w0 = KSCALE * wS[t], w1 = KSCALE * wS[t + 1];
#pragma unroll
      for (int i = 0; i < 8; ++i) { const float a = y[0][i] * w0, bq = y[1][i] * w1;
          *(unsigned*)(KT + (d0 + i) * 72 + t) = cvt_pk_bf16(a, bq); dnp[rg * 128 + d0 + i] = a + bq;
          *(unsigned*)(VT + (d0 + i) * 72 + t) = cvt_pk_bf16(vv[0][i], vv[1][i]); } }
    __syncthreads();
    if (tid < 128) { float s = 0.f;
#pragma unroll
        for (int r = 0; r < 32; ++r) s += dnp[r * 128 + tid];
        ((float*)(p.ws + WS_DN))[(size_t)u * 128 + tid] = s; }
    bf16_t* DT = (bf16_t*)(lds + 81920);
    { const int fr = lane & 15, fq = lane >> 4;
      const bf16x8 a0 = *(const bf16x8*)(KT + (16 * wid + fr) * 72 + fq * 8), a1 = *(const bf16x8*)(KT + (16 * wid + fr) * 72 + 32 + fq * 8);
#pragma unroll
      for (int et = 0; et < 8; ++et) {
          const bf16x8 b0 = *(const bf16x8*)(VT + (16 * et + fr) * 72 + fq * 8), b1 = *(const bf16x8*)(VT + (16 * et + fr) * 72 + 32 + fq * 8);
          f32x4 acc = (f32x4){0.f, 0.f, 0.f, 0.f};
          acc = __builtin_amdgcn_mfma_f32_16x16x32_bf16(a0, b0, acc, 0, 0, 0); acc = __builtin_amdgcn_mfma_f32_16x16x32_bf16(a1, b1, acc, 0, 0, 0);
          u32x2 w; w.x = cvtpk_safe(acc[0], acc[1]); w.y = cvtpk_safe(acc[2], acc[3]);
          *(u32x2*)(DT + (16 * et + fr) * 136 + 16 * wid + fq * 4) = w;
      } }
    __syncthreads();
    { bf16_t* DC = (bf16_t*)p.out + (size_t)u * 16384;
#pragma unroll
      for (int i = 0; i < 4; ++i) { const int ch = tid + NTHR * i, e = ch >> 4, part = ch & 15; *(u32x4*)(DC + e * 128 + part * 8) = *(const u32x4*)(DT + e * 136 + part * 8); } }
}
__device__ __forceinline__ void m1_phase(const Params& p, unsigned char* lds, int G) {
    int tid_ = threadIdx.x; asm volatile("" : "+v"(tid_)); const int tid = tid_;
    int u = blockIdx.x; if (u >= 2048) return;
    { float* cwS = (float*)(lds + 65536); for (int i = tid; i < 1024; i += NTHR) *(f32x4*)(cwS + 4 * i) = *(const f32x4*)(p.conv_w + 4 * i); }
    M1Pre cur; m1_issue(p, u, tid, cur);
    __syncthreads();
    for (;;) {
        const int un = u + G; const bool more = un < 2048; M1Pre nxt = cur;
        if (more) m1_issue(p, un, tid, nxt);
        __builtin_amdgcn_sched_barrier(0);
        m1_compute(p, lds, u, tid, cur);
        if (!more) break;
        cur = nxt; u = un;
    }
}
__device__ __forceinline__ void m2_scan(const Params& p, int G) {
    const int gt = blockIdx.x * NTHR + threadIdx.x, NGT = G * NTHR;
    const float* mst = (const float*)(p.ws + WS_MST); float* MC = (float*)(p.ws + WS_MC);
    const bf16_t* DC = (const bf16_t*)p.out; const float* DN = (const float*)(p.ws + WS_DN); float* NST = (float*)(p.ws + WS_NST); bf16_t* CST = (bf16_t*)(p.ws + WS_XB);
    for (int item = gt; item < 32 * 4128; item += NGT) {
        const int bh = item / 4128, vi = item % 4128; const bool isn = vi >= 4096;
        float m = 0.f; f32x4 S = (f32x4){0.f, 0.f, 0.f, 0.f};
        for (int c0 = 0; c0 < 64; c0 += 8) {
            f32x4 dv[8]; float bt[8], gmv[8];
#pragma unroll
            for (int k = 0; k < 8; ++k) { const int u = bh * 64 + c0 + k;
                if (isn) dv[k] = *(const f32x4*)(DN + (size_t)u * 128 + (vi - 4096) * 4);
                else { const u32x2 w = *(const u32x2*)(DC + (size_t)u * 16384 + vi * 4); dv[k] = (f32x4){__uint_as_float(w.x << 16), __uint_as_float(w.x & 0xffff0000u), __uint_as_float(w.y << 16), __uint_as_float(w.y & 0xffff0000u)}; }
                bt[k] = mst[u * 2]; gmv[k] = mst[u * 2 + 1]; }
#pragma unroll
            for (int k = 0; k < 8; ++k) { const int u = bh * 64 + c0 + k;
                if (isn) *(f32x4*)(NST + (size_t)u * 128 + (vi - 4096) * 4) = S;
                else { u32x2 w; w.x = cvt_pk_bf16(S[0], S[1]); w.y = cvt_pk_bf16(S[2], S[3]); *(u32x2*)(CST + (size_t)u * 16384 + vi * 4) = w; }
                if (vi == 0) MC[u] = m;
                const float mn = fmaxf(bt[k] + m, gmv[k]), a = __expf(bt[k] + m - mn), dd = __expf(gmv[k] - mn);
                S = S * a + dv[k] * dd; m = mn; }
        }
    }
}
struct M3Pre { u32x4 q[5], k[5]; float li, fp, mc, nv; };
__device__ __forceinline__ void m3_issue(const Params& p, int u, int tid, M3Pre& q) {
    const int lane = tid & 63, bh = u >> 6, c = u & 63, b = bh >> 2, h = bh & 3; const size_t row0 = (size_t)b * SEQ + c * 64;
    const bf16_t* Z = (const bf16_t*)(p.ws + WS_Z); const int d0 = (tid & 15) * 8, t = 2 * (tid >> 4);
    load5(Z + row0 * ZP + ZC_QKB + h * 128 + d0, c, t, q.q);
    load5(Z + row0 * ZP + ZC_QKB + 512 + h * 128 + d0, c, t, q.k);
    const float* gp = (const float*)(p.ws + WS_GATES) + (row0 + lane) * 8; q.li = gp[h]; q.fp = gp[4 + h];
    q.mc = ((const float*)(p.ws + WS_MC))[u]; q.nv = ((const float*)(p.ws + WS_NST))[(size_t)u * 128 + (tid & 127)];
}
__device__ __forceinline__ void m3_compute(const Params& p, unsigned char* lds, int u, int tid_in, const M3Pre& pre, const u32x4 (&vin)[2], const u32x4 (&cin)[4], float gn) {
    int tid = tid_in; asm volatile("" : "+v"(tid));
    const int lane = tid & 63, wid = tid >> 6, fr = lane & 15, fq = lane >> 4;
    const int bh = u >> 6, c = u & 63, b = bh >> 2, h = bh & 3; const size_t row0 = (size_t)b * SEQ + c * 64;
    bf16_t* QS = (bf16_t*)lds; bf16_t* KS = (bf16_t*)(lds + 17408); bf16_t* VT = (bf16_t*)(lds + 34816); bf16_t* CT = (bf16_t*)(lds + 53248); bf16_t* SC = (bf16_t*)(lds + 88064);
    float* fb = (float*)(lds + 97280); float* bS = fb; float* aS = fb + 64; float* mT = fb + 128; float* wI = fb + 192; float* qn = fb + 256; float* denP = fb + 320; float* nS = fb + 576; float* hsq = fb + 704;
    if (wid == 0) {
        const float li = pre.li, lf = logsigmoidf_(pre.fp);
        const float bcs = wave_incl_sum(lf, lane); const float a = li - bcs; const float pm = wave_incl_max(a, lane);
        const float mc = pre.mc; const float mt = bcs + fmaxf(mc, pm);
        bS[lane] = bcs; aS[lane] = a; mT[lane] = mt; wI[lane] = __expf(bcs + mc - mt);
    }
    { const int d0 = (tid & 15) * 8, rg = tid >> 4, t = 2 * rg; float y[2][8];
      conv2x8r(pre.q, (const float*)(lds + 102400) + h * 128 + d0, y);
#pragma unroll
      for (int r = 0; r < 2; ++r) { u32x4 w; w.x = cvt_pk_bf16(y[r][0], y[r][1]); w.y = cvt_pk_bf16(y[r][2], y[r][3]); w.z = cvt_pk_bf16(y[r][4], y[r][5]); w.w = cvt_pk_bf16(y[r][6], y[r][7]); *(u32x4*)(QS + (t + r) * 136 + d0) = w; }
      conv2x8r(pre.k, (const float*)(lds + 102400) + 512 + h * 128 + d0, y);
#pragma unroll
      for (int r = 0; r < 2; ++r) { u32x4 w; w.x = cvt_pk_bf16(y[r][0] * KSCALE, y[r][1] * KSCALE); w.y = cvt_pk_bf16(y[r][2] * KSCALE, y[r][3] * KSCALE); w.z = cvt_pk_bf16(y[r][4] * KSCALE, y[r][5] * KSCALE); w.w = cvt_pk_bf16(y[r][6] * KSCALE, y[r][7] * KSCALE); *(u32x4*)(KS + (t + r) * 136 + d0) = w; }
      if (tid < 128) nS[tid] = pre.nv; }
    __syncthreads();
    { const int tr = wid >> 1;
#pragma unroll
      for (int tci = 0; tci < 2; ++tci) { const int tc = 2 * (wid & 1) + tci;
          f32x4 acc = (f32x4){0.f, 0.f, 0.f, 0.f};
          if (tc <= tr) {
#pragma unroll
              for (int ks = 0; ks < 4; ++ks) { const bf16x8 a = *(const bf16x8*)(QS + (16 * tr + fr) * 136 + ks * 32 + fq * 8), bb = *(const bf16x8*)(KS + (16 * tc + fr) * 136 + ks * 32 + fq * 8);
                  acc = __builtin_amdgcn_mfma_f32_16x16x32_bf16(a, bb, acc, 0, 0, 0); } }
          const int s = 16 * tc + fr; const float as = aS[s]; const int t0 = 16 * tr + fq * 4;
          const f32x4 bt4 = *(const f32x4*)(bS + t0), mt4 = *(const f32x4*)(mT + t0);
          float val[4];
#pragma unroll
          for (int j = 0; j < 4; ++j) { const float e = __expf(fminf(bt4[j] + as - mt4[j], 0.f)); const float x = acc[j] * e; val[j] = (tc <= tr && s <= t0 + j) ? x : 0.f; }
#pragma unroll
          for (int j = 0; j < 4; ++j) SC[(t0 + j) * 72 + s] = f2bf(val[j]);
#pragma unroll
          for (int j = 0; j < 4; ++j) val[j] = row_sum16(val[j]);
          if (fr == 0) {
#pragma unroll
              for (int j = 0; j < 4; ++j) denP[(t0 + j) * 4 + tc] = val[j]; } }
      { const int t = tid >> 3, part = tid & 7; float dot = 0.f;
#pragma unroll
        for (int i = 0; i < 16; ++i) dot += bf2f(QS[t * 136 + 16 * part + i]) * nS[16 * part + i];
        dot += __shfl_xor(dot, 1); dot += __shfl_xor(dot, 2); dot += __shfl_xor(dot, 4);
        if (part == 0) qn[t] = dot; }
      { const int d0 = (tid & 15) * 8, t = 2 * (tid >> 4); const u32x4 va = vin[0], vb = vin[1];
#pragma unroll
        for (int i = 0; i < 4; ++i) { *(unsigned*)(VT + (d0 + 2 * i) * 72 + t) = (va[i] & 0xffffu) | (vb[i] << 16); *(unsigned*)(VT + (d0 + 2 * i + 1) * 72 + t) = (va[i] >> 16) | (vb[i] & 0xffff0000u); }
#pragma unroll
        for (int i = 0; i < 4; ++i) { const int ch = tid + NTHR * i, e = ch >> 4, part = ch & 15; *(u32x4*)(CT + e * 136 + part * 8) = cin[i]; } } }
    u32x4 sob[2];
    { const bf16_t* Zo = (const bf16_t*)(p.ws + WS_Z) + ZC_OB + h * 128;
#pragma unroll
      for (int i = 0; i < 2; ++i) { const int id = tid + NTHR * i; sob[i] = *(const u32x4*)(Zo + (row0 + (id >> 4)) * ZP + (id & 15) * 8); } }
    __syncthreads();
    f32x4 hv[4];
    { f32x4 acc1[4], acc2[4];
#pragma unroll
      for (int tt = 0; tt < 4; ++tt) { acc1[tt] = (f32x4){0.f, 0.f, 0.f, 0.f}; acc2[tt] = (f32x4){0.f, 0.f, 0.f, 0.f}; }
#pragma unroll
      for (int ks = 0; ks < 2; ++ks) { const bf16x8 bv = *(const bf16x8*)(VT + (16 * wid + fr) * 72 + ks * 32 + fq * 8);
#pragma unroll
          for (int tt = 0; tt < 4; ++tt) { const bf16x8 a = *(const bf16x8*)(SC + (16 * tt + fr) * 72 + ks * 32 + fq * 8); acc1[tt] = __builtin_amdgcn_mfma_f32_16x16x32_bf16(a, bv, acc1[tt], 0, 0, 0); } }
#pragma unroll
      for (int ks = 0; ks < 4; ++ks) { const bf16x8 bc = *(const bf16x8*)(CT + (16 * wid + fr) * 136 + ks * 32 + fq * 8);
#pragma unroll
          for (int tt = 0; tt < 4; ++tt) { const bf16x8 a = *(const bf16x8*)(QS + (16 * tt + fr) * 136 + ks * 32 + fq * 8); acc2[tt] = __builtin_amdgcn_mfma_f32_16x16x32_bf16(a, bc, acc2[tt], 0, 0, 0); } }
#pragma unroll
      for (int tt = 0; tt < 4; ++tt) { const int t0 = 16 * tt + fq * 4;
          const f32x4 wi4 = *(const f32x4*)(wI + t0), qn4 = *(const f32x4*)(qn + t0), mt4 = *(const f32x4*)(mT + t0);
          f32x4 sq4;
#pragma unroll
          for (int j = 0; j < 4; ++j) { const f32x4 d4 = *(const f32x4*)(denP + (t0 + j) * 4);
              const float num = acc1[tt][j] + wi4[j] * acc2[tt][j];
              const float den = (d4[0] + d4[1]) + (d4[2] + d4[3]) + wi4[j] * qn4[j];
              const float hval = num * __builtin_amdgcn_rcpf(fmaxf(fabsf(den), __expf(-mt4[j]))); hv[tt][j] = hval;
              sq4[j] = row_sum16(hval * hval); }
          if (fr == 0) {
#pragma unroll
              for (int j = 0; j < 4; ++j) hsq[(t0 + j) * 8 + wid] = sq4[j]; } } }
    __syncthreads();
    { float* OT = (float*)(lds + 53248);
#pragma unroll
      for (int tt = 0; tt < 4; ++tt)
#pragma unroll
          for (int j = 0; j < 4; ++j) { const int t = 16 * tt + fq * 4 + j; const f32x4* hp = (const f32x4*)(hsq + t * 8); const f32x4 s4 = hp[0] + hp[1];
              const float rstd = rsqrtf(((s4[0] + s4[1]) + (s4[2] + s4[3])) * (1.f / 128.f) + EPS);
              OT[t * 132 + 16 * wid + fr] = hv[tt][j] * rstd; } }
    __syncthreads();
    { const float* OT = (const float*)(lds + 53248); bf16_t* YB = (bf16_t*)(p.ws + WS_YA) + 512 + h * 128;
#pragma unroll
      for (int i = 0; i < 2; ++i) { const int id = tid + NTHR * i, t = id >> 4, e0 = (id & 15) * 8;
          const f32x4 h0 = *(const f32x4*)(OT + t * 132 + e0), h1 = *(const f32x4*)(OT + t * 132 + e0 + 4);
          const f32x4 g0 = *(const f32x4*)(p.g_ml + h * 128 + e0), g1 = *(const f32x4*)(p.g_ml + h * 128 + e0 + 4);
          float so[8]; unpack8(sob[i], so);
          u32x4 w; w.x = cvt_pk_bf16(h0[0] * g0[0] * so[0], h0[1] * g0[1] * so[1]); w.y = cvt_pk_bf16(h0[2] * g0[2] * so[2], h0[3] * g0[3] * so[3]);
          w.z = cvt_pk_bf16(h1[0] * g1[0] * so[4], h1[1] * g1[1] * so[5]); w.w = cvt_pk_bf16(h1[2] * g1[2] * so[6], h1[3] * g1[3] * so[7]);
          *(u32x4*)(YB + (row0 + t) * 1024 + e0) = w; } }
}
__device__ __forceinline__ void m3_phase(const Params& p, unsigned char* lds, int G) {
    int tid_ = threadIdx.x; asm volatile("" : "+v"(tid_)); const int tid = tid_;
    const int lane = tid & 63, wid = tid >> 6, fr = lane & 15, fq = lane >> 4;
    int u = blockIdx.x; if (u >= 2048) return;
    const bf16_t* Z = (const bf16_t*)(p.ws + WS_Z);
    { float* cwS = (float*)(lds + 102400); for (int i = tid; i < 1024; i += NTHR) *(f32x4*)(cwS + 4 * i) = *(const f32x4*)(p.conv_w + 4 * i); }
    M3Pre cur; m3_issue(p, u, tid, cur);
    __syncthreads();
    for (;;) {
        const int bh = u >> 6, c = u & 63, b = bh >> 2, h = bh & 3; const size_t row0 = (size_t)b * SEQ + c * 64;
        u32x4 vin[2], cin[4];
        { const int d0 = (tid & 15) * 8, t = 2 * (tid >> 4); const bf16_t* vs = Z + row0 * ZP + ZC_VB + h * 128 + d0; vin[0] = *(const u32x4*)(vs + (long)t * ZP); vin[1] = *(const u32x4*)(vs + (long)(t + 1) * ZP);
          const bf16_t* CST = (const bf16_t*)(p.ws + WS_XB) + (size_t)u * 16384;
#pragma unroll
          for (int i = 0; i < 4; ++i) { const int ch = tid + NTHR * i, e = ch >> 4, part = ch & 15; cin[i] = *(const u32x4*)(CST + e * 128 + part * 8); } }
        const float gn = p.g_ml[h * 128 + 16 * wid + fr];
        const int un = u + G; const bool more = un < 2048; M3Pre nxt = cur;
        if (more) m3_issue(p, un, tid, nxt);
        __builtin_amdgcn_sched_barrier(0);
        m3_compute(p, lds, u, tid, cur, vin, cin, gn);
        if (!more) break;
        cur = nxt; u = un;
    }
}
__device__ __forceinline__ void p7_final(const Params& p, int G) {
    const int lane = threadIdx.x & 63, gw = blockIdx.x * 8 + (threadIdx.x >> 6), NGW = G * 8;
    const bf16_t* H2B = (const bf16_t*)(p.ws + WS_XB);
    f32x4 g4[4];
#pragma unroll
    for (int j = 0; j < 2; ++j) { g4[2 * j] = *(const f32x4*)(p.g_fin + 512 * j + 8 * lane); g4[2 * j + 1] = *(const f32x4*)(p.g_fin + 512 * j + 8 * lane + 4); }
    for (int rb = gw * 16; rb < T; rb += NGW * 16)
        for (int r4 = 0; r4 < 16; r4 += 4) {
            u32x4 w[4][2];
#pragma unroll
            for (int r = 0; r < 4; ++r)
#pragma unroll
                for (int j = 0; j < 2; ++j) w[r][j] = *(const u32x4*)(H2B + (size_t)(rb + r4 + r) * 1024 + 512 * j + 8 * lane);
#pragma unroll
            for (int r = 0; r < 4; ++r) { float v[2][8]; unpack8(w[r][0], v[0]); unpack8(w[r][1], v[1]); float s = 0.f;
#pragma unroll
                for (int j = 0; j < 2; ++j)
#pragma unroll
                    for (int i = 0; i < 8; ++i) s += v[j][i] * v[j][i];
                const float rstd = rsqrtf(wave_sum(s) * (1.f / 1024.f) + EPS); float* xo = p.out + (size_t)(rb + r4 + r) * 1024 + 8 * lane;
#pragma unroll
                for (int j = 0; j < 2; ++j) { const f32x4 o0 = (f32x4){v[j][0], v[j][1], v[j][2], v[j][3]} * rstd * g4[2 * j], o1 = (f32x4){v[j][4], v[j][5], v[j][6], v[j][7]} * rstd * g4[2 * j + 1];
                    *(f32x4*)(xo + 512 * j) = o0; *(f32x4*)(xo + 512 * j + 4) = o1; } }
        }
}

#define XB_TMO      128
#define XB_XCNT(j)  (256  + 64 * (j))
#define XB_XSUB(j)  (1280 + 64 * (j))
#define XB_XGEN(j)  (2304 + 64 * (j))
#define XB_TOP      3328
#define XB_TOPGEN   3392
#define XCD_BAR_WORDS 3456
#define XB_SPIN_CAP (1u << 18)

__device__ __forceinline__ unsigned xb_ld(unsigned* p)              { return __hip_atomic_load(p, __ATOMIC_RELAXED, __HIP_MEMORY_SCOPE_AGENT); }
__device__ __forceinline__ unsigned xb_add(unsigned* p, unsigned v) { return __hip_atomic_fetch_add(p, v, __ATOMIC_RELAXED, __HIP_MEMORY_SCOPE_AGENT); }
__device__ __forceinline__ unsigned xb_xcc_id() { return (unsigned)__builtin_amdgcn_s_getreg((3 << 11) | 20) & 0xFu; }
#define XB_SPIN(cond, bar) do { unsigned _sp = 0; while (cond) { __builtin_amdgcn_s_sleep(1); \
    if ((++_sp & 255u) == 0u) { if (xb_ld(&(bar)[XB_TMO])) break; if (_sp > XB_SPIN_CAP) { atomicAdd(&(bar)[XB_TMO], 1u); break; } } } } while (0)

struct XcdBarrier {
    unsigned* bar; unsigned x;
    volatile LAS unsigned* st;
};

__device__ __forceinline__ XcdBarrier xcd_barrier_post(unsigned* bar, volatile LAS unsigned* st) {
    XcdBarrier b; b.bar = bar; b.x = xb_xcc_id(); b.st = st;
    if (threadIdx.x == 0) (void)xb_add(&bar[XB_XCNT(b.x)], 1u);
    return b;
}
__device__ __forceinline__ void xcd_barrier_complete(unsigned* bar, unsigned x, unsigned& nloc, unsigned& nx) {
    const unsigned G = gridDim.x * gridDim.y * gridDim.z;
    unsigned sum, cnt, mine, sp = 0u;
    for (;;) {
        sum = 0u; cnt = 0u; mine = 0u;
#pragma unroll
        for (unsigned j = 0; j < 16; ++j) { const unsigned c = xb_ld(&bar[XB_XCNT(j)]); sum += c; cnt += (c > 0u) ? 1u : 0u; mine = (j == x) ? c : mine; }
        if (sum == G) break;
        __builtin_amdgcn_s_sleep(1);
        if ((++sp & 255u) == 0u) { if (xb_ld(&bar[XB_TMO])) break; if (sp > XB_SPIN_CAP) { atomicAdd(&bar[XB_TMO], 1u); break; } }
    }
    nloc = mine > 0u ? mine : 1u; nx = cnt > 0u ? cnt : 1u;
}

__device__ __forceinline__ void xcd_barrier(const XcdBarrier& b) {
    asm volatile("s_waitcnt vmcnt(0)" ::: "memory");
    __syncthreads();
    if (threadIdx.x == 0) {
        unsigned* bar = b.bar;
        __builtin_amdgcn_s_waitcnt(0);
        unsigned nloc = b.st[0], nx = b.st[1];
        if (nloc == 0u) { xcd_barrier_complete(bar, b.x, nloc, nx); b.st[0] = nloc; b.st[1] = nx; }
        const unsigned old = xb_add(&bar[XB_XSUB(b.x)], 1u);
        const unsigned gen = old / nloc;
        if (old + 1u == (gen + 1u) * nloc) {
            __builtin_amdgcn_fence(__ATOMIC_RELEASE, "agent");
            asm volatile("s_waitcnt vmcnt(0)" ::: "memory");
            const unsigned og = xb_add(&bar[XB_TOP], 1u);
            const unsigned tg = og / nx;
            if (og + 1u == (tg + 1u) * nx) xb_add(&bar[XB_TOPGEN], 1u);
            else XB_SPIN(xb_ld(&bar[XB_TOPGEN]) == tg, bar);
            __builtin_amdgcn_fence(__ATOMIC_ACQUIRE, "agent");
            xb_add(&bar[XB_XGEN(b.x)], 1u);
            asm volatile("s_waitcnt vmcnt(0)" ::: "memory");
        } else {
            XB_SPIN(xb_ld(&bar[XB_XGEN(b.x)]) == gen, bar);
            __builtin_amdgcn_fence(__ATOMIC_ACQUIRE, "agent");
            asm volatile("s_waitcnt vmcnt(0)" ::: "memory");
        }
    }
    __syncthreads();
}

__global__ void __launch_bounds__(NTHR, 2) fwd_megakernel(Params p) {
    extern __shared__ __attribute__((aligned(16))) unsigned char lds[];
    cg::grid_group grid = cg::this_grid();
    const int G = gridDim.x;
    unsigned char* ws = p.ws;
    PG8_LAS unsigned char* ldsl = (PG8_LAS unsigned char*)lds;
    bf16_t* Z = (bf16_t*)(ws + WS_Z);

    volatile LAS unsigned* bst = (volatile LAS unsigned*)((LAS unsigned char*)lds + LDS_BYTES - 64);
    if (threadIdx.x == 0) { bst[0] = 0u; bst[1] = 0u; }
    __syncthreads();
    const XcdBarrier xb = xcd_barrier_post((unsigned*)(ws + WS_BAR) + 4096, bst);
    if (p.ws == nullptr) grid.sync();
    p0_prologue(p, lds, G);
    xcd_barrier(xb);
    {
        pg8::Gemm g{(const bf16_t*)(ws + WS_XB), (const bf16_t*)(ws + WS_WIN), T, NIN, 1024}; pg8::StaticOrder S; S.init(T, NIN, G, (int)blockIdx.x);
        EpiInProj E{Z, (const float*)(ws + WS_R1), (const float*)(ws + WS_ROPE), (float*)(ws + WS_KMEAN)};
        pg8::gemm_phase<EpiInProj, pg8::StaticOrder, true, true>(ldsl, g, S, E);
    }
    xcd_barrier(xb);
    m1_phase(p, lds, G);
    xcd_barrier(xb);
    m2_scan(p, G);
    {
        const attn_body::AttnTensors AT{(const attn_body::bf16*)(Z + ZC_Q), (const attn_body::bf16*)(Z + ZC_K), (const attn_body::bf16*)(Z + ZC_V), (attn_body::bf16*)(ws + WS_YA), (const float*)(ws + WS_KMEAN)};
        attn_body::attn_phase<8>((char*)lds, AT, G, (int)blockIdx.x);
    }
    xcd_barrier(xb);
    m3_phase(p, lds, G);
    xcd_barrier(xb);
    {
        pg8::StaticOrder S; S.init(T, 1024, G, (int)blockIdx.x);
        pg8::Gemm g{(const bf16_t*)(ws + WS_YA), (const bf16_t*)(ws + WS_WPA), T, 1024, 1024};
        EpiMerge E{Z + ZC_GA, (bf16_t*)(ws + WS_XB)};
        pg8::gemm_phase<EpiMerge, pg8::StaticOrder, true, true>(ldsl, g, S, E);
    }
    xcd_barrier(xb);
    {
        p4_weights(p, lds, G);
        pg8::Gemm g{(const bf16_t*)(ws + WS_XB), (const bf16_t*)(ws + WS_WOUT), T, 1024, 1024}; pg8::StaticOrder S; S.init(T, 1024, G, (int)blockIdx.x);
        EpiOut E{p.x, (bf16_t*)(ws + WS_YA), (float*)(ws + WS_R1)};
        pg8::gemm_phase<EpiOut, pg8::StaticOrder, true, true>(ldsl, g, S, E);
    }
    xcd_barrier(xb);
    {
        pg8::Gemm g{(const bf16_t*)(ws + WS_YA), (const bf16_t*)(ws + WS_WGU), T, NIN, 1024}; pg8::StaticOrder S; S.init(T, NIN, G, (int)blockIdx.x);
        EpiGateUp E{(const float*)(ws + WS_R1), Z};
        pg8::gemm_phase<EpiGateUp, pg8::StaticOrder, true, true>(ldsl, g, S, E);
    }
    xcd_barrier(xb);
    {
        pg8::Gemm g{(const bf16_t*)Z, (const bf16_t*)(ws + WS_WDN), T, 1024, FF}; pg8::StaticOrder S; S.init(T, 1024, G, (int)blockIdx.x);
        EpiDown E{(const bf16_t*)(ws + WS_YA), (bf16_t*)(ws + WS_XB)};
        pg8::gemm_phase<EpiDown, pg8::StaticOrder, true, true>(ldsl, g, S, E);
    }
    xcd_barrier(xb);
    p7_final(p, G);
}
}

extern "C" void kernel_launch(void* const* d_in, const int* in_sizes, int n_in, void* d_out, int out_size, void* d_ws, size_t ws_size, hipStream_t stream) {
    static int grid = 0;
    if (grid == 0) {
        if (n_in != 14 || in_sizes[0] != mk::T * 1024 || out_size != mk::T * 1024 || ws_size < mk::WS_END) { fprintf(stderr, "kernel_launch: unexpected shapes (n_in %d, in0 %d, out %d, ws %zu)\n", n_in, n_in > 0 ? in_sizes[0] : -1, out_size, ws_size); grid = -1; return; }
        int dev = 0, cus = 0, per_cu = 0;
        hipGetDevice(&dev); hipDeviceGetAttribute(&cus, hipDeviceAttributeMultiprocessorCount, dev);
        if (hipFuncSetAttribute((const void*)mk::fwd_megakernel, hipFuncAttributeMaxDynamicSharedMemorySize, mk::LDS_BYTES) != hipSuccess) { fprintf(stderr, "kernel_launch: hipFuncSetAttribute failed\n"); grid = -1; return; }
        if (hipOccupancyMaxActiveBlocksPerMultiprocessor(&per_cu, (const void*)mk::fwd_megakernel, mk::NTHR, mk::LDS_BYTES) != hipSuccess || per_cu < 1) { fprintf(stderr, "kernel_launch: occupancy query says %d blocks per CU\n", per_cu); per_cu = 1; }
        (void)hipGetLastError();
        grid = cus;
    }
    if (grid < 0) return;
    mk::Params p{};
    p.x = (const float*)d_in[0]; p.g_mix = (const float*)d_in[1]; p.w_in = (const float*)d_in[2]; p.conv_w = (const float*)d_in[3]; p.b_i = (const float*)d_in[4]; p.b_f = (const float*)d_in[5];
    p.g_ml = (const float*)d_in[6]; p.w_pa = (const float*)d_in[7]; p.w_pb = (const float*)d_in[8]; p.w_out = (const float*)d_in[9]; p.g_ffn = (const float*)d_in[10]; p.w_gu = (const float*)d_in[11];
    p.w_dn = (const float*)d_in[12]; p.g_fin = (const float*)d_in[13]; p.out = (float*)d_out; p.ws = (unsigned char*)d_ws;
    if (hipMemsetAsync((char*)d_ws + mk::WS_BAR, 0, 32768, stream) != hipSuccess) { fprintf(stderr, "kernel_launch: hipMemsetAsync of the barrier words failed\n"); return; }
    void* args[] = {&p};
    hipError_t e = hipLaunchCooperativeKernel((const void*)mk::fwd_megakernel, dim3(grid), dim3(mk::NTHR), args, mk::LDS_BYTES, stream);
    if (e != hipSuccess) fprintf(stderr, "kernel_launch: cooperative launch failed: %s (grid %d)\n", hipGetErrorString(e), grid);
}
```

```cpp
#include <hip/hip_runtime.h>
#include <hip/hip_cooperative_groups.h>
#include <hip/hip_bf16.h>
#include <cstdio>
#include <cstdint>
#include <cmath>
namespace cg = cooperative_groups;
namespace pg8 {
#define PG8_LAS __attribute__((address_space(3)))
typedef unsigned short bf16_t;
typedef short bf16x8 __attribute__((ext_vector_type(8)));
typedef float f32x4 __attribute__((ext_vector_type(4)));
typedef unsigned u32x4 __attribute__((ext_vector_type(4)));
constexpr int BM = 256, BK = 64, HALF = 128, HTB = HALF * BK * 2  , STAGE_BYTES = 8 * HTB, NXCD = 8, WGM = 8;

__host__ __device__ __forceinline__ int lds_byte(int r, int c) { const int st = (r >> 4) * 2 + (c >> 5), rr = r & 15, cc = c & 31, ob = rr * 64 + cc * 2; return st * 1024 + (ob ^ (((ob >> 9) & 1) << 5)); }
__host__ __device__ __forceinline__ void stage_rc(int b, int& R, int& C) { const int st = b / 1024, sb = b % 1024, swz = sb ^ (((sb >> 9) & 1) << 5); R = (st >> 1) * 16 + swz / 64; C = (st & 1) * 32 + (swz % 64) / 2; }
__host__ __device__ __forceinline__ int perm32(int rho) { const int n = rho >> 4, i = rho & 15; return 8 * (i >> 2) + 4 * n + (i & 3); }

struct Unit { int pm, pn; };
struct Gemm { const bf16_t* A; const bf16_t* Bt; int M, N, K; };

struct StaticOrder {
    int nM, nN, nwg, G, c;
    __host__ __device__ void init(int M, int N, int G_, int c_) { nM = M / BM; nN = N / BM; nwg = nM * nN; G = G_; c = c_; }
    __host__ __device__ bool next(int i, Unit& u) const {
        const long L = (long)i * G + c; if (L >= nwg) return false;
        int wgid = (int)L; { const int q = nwg / NXCD, r = nwg % NXCD, xcd = wgid % NXCD, off = wgid / NXCD; wgid = (xcd < r ? xcd * (q + 1) : r * (q + 1) + (xcd - r) * q) + off; }
        const int nig = WGM * nN, gid = wgid / nig, fm = gid * WGM, gsz = (nM - fm) < WGM ? (nM - fm) : WGM;
        u.pm = fm + ((wgid % nig) % gsz); u.pn = (wgid % nig) / gsz; return true;
    }
    __device__ __forceinline__ void a_ready(const Unit&) const {}
    __device__ __forceinline__ void done(const Unit&) const {}
};
__device__ __forceinline__ unsigned cvt_pk_bf16(float lo, float hi) { unsigned r; asm volatile("v_cvt_pk_bf16_f32 %0, %1, %2" : "=v"(r) : "v"(lo), "v"(hi)); return r; }
typedef float f32x2 __attribute__((ext_vector_type(2)));
template <class Epi, class Sched, bool ALIGN_EPI = false, bool SP2 = false>
__device__ __forceinline__ void gemm_phase(PG8_LAS unsigned char* lds, const Gemm g, const Sched& S, const Epi& E) {
    int tid_ = threadIdx.x; asm volatile("" : "+v"(tid_));
    const int tid = tid_, wid = __builtin_amdgcn_readfirstlane(tid >> 6), lane = tid & 63, wr = wid >> 2, wc = wid & 3, fr = lane & 15, fq = lane >> 4;
    const int K = g.K, nt = K / BK;
    unsigned voffA[2], voffB[2];
#pragma unroll
    for (int i = 0; i < 2; ++i) { int R, C; stage_rc(tid * 16 + i * 8192, R, C); const int Rb = Epi::PERM ? ((R & ~31) + perm32(R & 31)) : R;
        voffA[i] = (unsigned)(R * K + C) * 2u; voffB[i] = (unsigned)(Rb * K + C) * 2u; }
    const size_t kstep = (size_t)(BK * 2);
    const size_t hstep = (size_t)HALF * K * 2;
    const size_t tstep = 2 * hstep;
    const unsigned ldsw = (unsigned)wid * 1024u;
    const int aoff = lds_byte(wr * 64 + fr, fq * 8), boff = lds_byte(wc * 32 + fr, fq * 8);
#define PG8_SA(b, h) (((b) * 2 + (h)) * HTB)
#define PG8_SB(b, h) ((4 + (b) * 2 + (h)) * HTB)
#define PG8_STAGE(bufoff, gbase, voff) do { _Pragma("unroll") for (int _i = 0; _i < 2; ++_i) \
        __builtin_amdgcn_global_load_lds((const unsigned*)((const char*)(gbase) + (voff)[_i]), (PG8_LAS unsigned*)(lds + (bufoff) + ldsw + _i * 8192), 16, 0, 0); } while (0)
#define PG8_LDA(dst, b, h) do { _Pragma("unroll") for (int m = 0; m < 4; ++m) _Pragma("unroll") for (int k = 0; k < 2; ++k) dst[m][k] = *(const PG8_LAS bf16x8*)(lds + PG8_SA(b, h) + aoff + m * 2048 + k * 1024); } while (0)
#define PG8_LDB(dst, b, h) do { _Pragma("unroll") for (int n = 0; n < 2; ++n) _Pragma("unroll") for (int k = 0; k < 2; ++k) dst[n][k] = *(const PG8_LAS bf16x8*)(lds + PG8_SB(b, h) + boff + n * 2048 + k * 1024); } while (0)
#define PG8_MMA(ai, bj, At, Bt) do { __builtin_amdgcn_s_setprio(1); _Pragma("unroll") for (int m = 0; m < 4; ++m) _Pragma("unroll") for (int n = 0; n < 2; ++n) _Pragma("unroll") for (int k = 0; k < 2; ++k) \
        acc[ai][bj][m][n] = __builtin_amdgcn_mfma_f32_16x16x32_bf16(Bt[n][k], At[m][k], acc[ai][bj][m][n], 0, 0, 0); __builtin_amdgcn_s_setprio(0); } while (0)
#define PG8_WAIT_V(n) asm volatile("s_waitcnt vmcnt(" #n ")" ::: "memory")
#define PG8_WAIT_L(n) asm volatile("s_waitcnt lgkmcnt(" #n ")" ::: "memory")
#define PG8_BAR __builtin_amdgcn_s_barrier()
#define PG8_SCHED __builtin_amdgcn_sched_barrier(0)
    Unit cur, nxt; int ui = 0;
    if (!S.next(0, cur)) return;
    f32x4 acc[2][2][4][2];
#pragma unroll
    for (int a = 0; a < 2; ++a)
#pragma unroll
        for (int b = 0; b < 2; ++b)
#pragma unroll
            for (int m = 0; m < 4; ++m)
#pragma unroll
                for (int n = 0; n < 2; ++n) acc[a][b][m][n] = (f32x4){0.f, 0.f, 0.f, 0.f};
    bf16x8 At[4][2], B0[2][2], B1[2][2];
    const char* cA = (const char*)g.A + (size_t)cur.pm * tstep; const char* cB = (const char*)g.Bt + (size_t)cur.pn * tstep;
    S.a_ready(cur);
    if constexpr (SP2) {
        PG8_STAGE(PG8_SB(0, 0), cB, voffB); PG8_STAGE(PG8_SB(0, 1), cB + hstep, voffB); PG8_STAGE(PG8_SA(0, 0), cA, voffA); PG8_STAGE(PG8_SA(0, 1), cA + hstep, voffA);
        if (wr == 1) PG8_BAR;
        PG8_WAIT_V(2); PG8_BAR;
        PG8_STAGE(PG8_SB(1, 0), cB + kstep, voffB); PG8_STAGE(PG8_SA(1, 0), cA + kstep, voffA); PG8_STAGE(PG8_SB(1, 1), cB + hstep + kstep, voffB);
        PG8_WAIT_V(6); PG8_BAR;
    } else {
        PG8_STAGE(PG8_SB(0, 0), cB, voffB); PG8_STAGE(PG8_SA(0, 0), cA, voffA); PG8_STAGE(PG8_SB(0, 1), cB + hstep, voffB); PG8_STAGE(PG8_SA(0, 1), cA + hstep, voffA);
        if (wr == 1) PG8_BAR;
        PG8_WAIT_V(4); PG8_BAR;
        PG8_STAGE(PG8_SB(1, 0), cB + kstep, voffB); PG8_STAGE(PG8_SA(1, 0), cA + kstep, voffA); PG8_STAGE(PG8_SB(1, 1), cB + hstep + kstep, voffB);
        PG8_WAIT_V(6); PG8_BAR;
    }
    for (;;) {
        const bool has_next = S.next(ui + 1, nxt);
        const char* nA = has_next ? (const char*)g.A + (size_t)nxt.pm * tstep : cA; const char* nB = has_next ? (const char*)g.Bt + (size_t)nxt.pn * tstep : cB;
        for (int t = 0; t < nt; t += 2) {
            const bool last = (t == nt - 2);
            if constexpr (Epi::MID) { if (t == (nt >> 1)) E.mid(acc, cur, wr, wc, fr, fq); }
            const char* a1 = cA + (size_t)(t + 1) * kstep;
            const char* a2 = last ? nA : cA + (size_t)(t + 2) * kstep; const char* b2 = last ? nB : cB + (size_t)(t + 2) * kstep;
            const char* a3 = a2 + kstep; const char* b3 = b2 + kstep;
            if (last && has_next) S.a_ready(nxt);
            if constexpr (SP2) {
            PG8_LDB(B0, 0, 0); PG8_LDB(B1, 0, 1); PG8_SCHED; PG8_LDA(At, 0, 0); PG8_STAGE(PG8_SA(1, 1), a1 + hstep, voffA);
            PG8_WAIT_V(8); PG8_WAIT_L(0); PG8_BAR; PG8_MMA(0, 0, At, B0); PG8_MMA(0, 1, At, B1); PG8_BAR; PG8_SCHED;
            PG8_LDA(At, 0, 1); PG8_STAGE(PG8_SB(0, 0), b2, voffB); PG8_STAGE(PG8_SB(0, 1), b2 + hstep, voffB); PG8_STAGE(PG8_SA(0, 0), a2, voffA);
            PG8_WAIT_V(8); PG8_WAIT_L(0); PG8_BAR; PG8_MMA(1, 0, At, B0); PG8_MMA(1, 1, At, B1); PG8_BAR; PG8_SCHED;
            PG8_LDB(B0, 1, 0); PG8_LDB(B1, 1, 1); PG8_SCHED; PG8_LDA(At, 1, 0); PG8_STAGE(PG8_SA(0, 1), a2 + hstep, voffA);
            PG8_WAIT_V(8); PG8_WAIT_L(0); PG8_BAR; PG8_MMA(0, 0, At, B0); PG8_MMA(0, 1, At, B1); PG8_BAR; PG8_SCHED;
            PG8_LDA(At, 1, 1); PG8_STAGE(PG8_SB(1, 0), b3, voffB); PG8_STAGE(PG8_SB(1, 1), b3 + hstep, voffB); PG8_STAGE(PG8_SA(1, 0), a3, voffA);
            PG8_WAIT_V(8); PG8_WAIT_L(0); PG8_BAR; PG8_MMA(1, 0, At, B0); PG8_MMA(1, 1, At, B1); PG8_BAR; PG8_SCHED;
            } else {
            PG8_LDB(B0, 0, 0); PG8_SCHED; PG8_LDA(At, 0, 0); PG8_STAGE(PG8_SA(1, 1), a1 + hstep, voffA);
            PG8_WAIT_L(8); PG8_BAR; PG8_WAIT_L(0); PG8_MMA(0, 0, At, B0); PG8_BAR; PG8_SCHED;
            PG8_LDB(B1, 0, 1); PG8_STAGE(PG8_SB(0, 0), b2, voffB);
            PG8_BAR; PG8_WAIT_L(0); PG8_MMA(0, 1, At, B1); PG8_BAR;
            PG8_LDA(At, 0, 1); PG8_STAGE(PG8_SA(0, 0), a2, voffA);
            PG8_BAR; PG8_WAIT_L(0); PG8_MMA(1, 0, At, B0); PG8_BAR; PG8_SCHED;
            PG8_STAGE(PG8_SB(0, 1), b2 + hstep, voffB);
            PG8_WAIT_V(6); PG8_BAR; PG8_MMA(1, 1, At, B1); PG8_BAR;
            PG8_LDB(B0, 1, 0); PG8_SCHED; PG8_LDA(At, 1, 0); PG8_STAGE(PG8_SA(0, 1), a2 + hstep, voffA);
            PG8_WAIT_L(8); PG8_BAR; PG8_WAIT_L(0); PG8_MMA(0, 0, At, B0); PG8_BAR; PG8_SCHED;
            PG8_LDB(B1, 1, 1); PG8_STAGE(PG8_SB(1, 0), b3, voffB);
            PG8_BAR; PG8_WAIT_L(0); PG8_MMA(0, 1, At, B1); PG8_BAR;
            PG8_LDA(At, 1, 1); PG8_STAGE(PG8_SA(1, 0), a3, voffA);
            PG8_BAR; PG8_WAIT_L(0); PG8_MMA(1, 0, At, B0); PG8_BAR; PG8_SCHED;
            PG8_STAGE(PG8_SB(1, 1), b3 + hstep, voffB);
            PG8_WAIT_V(6); PG8_BAR; PG8_MMA(1, 1, At, B1); PG8_BAR;
            }
        }
        if constexpr (ALIGN_EPI) { if (wr == 0) PG8_BAR; }
        if constexpr (!Epi::AFTER_DRAIN) { E(acc, cur, wr, wc, fr, fq); S.done(cur); }
        if (!has_next) break;
#pragma unroll
        for (int a = 0; a < 2; ++a)
#pragma unroll
            for (int b = 0; b < 2; ++b)
#pragma unroll
                for (int m = 0; m < 4; ++m)
#pragma unroll
                    for (int n = 0; n < 2; ++n) acc[a][b][m][n] = (f32x4){0.f, 0.f, 0.f, 0.f};
        cur = nxt; cA = nA; cB = nB; ++ui;
        if constexpr (ALIGN_EPI) { if (wr == 1) PG8_BAR; }
    }
    PG8_WAIT_V(0);
    if constexpr (!ALIGN_EPI) { if (wr == 0) PG8_BAR; }
    PG8_BAR;
    if constexpr (Epi::AFTER_DRAIN) { E.fused(acc, cur, wr, wc, fr, fq, lds, wid, lane); S.done(cur); }
#undef PG8_SA
#undef PG8_SB
#undef PG8_STAGE
#undef PG8_LDA
#undef PG8_LDB
#undef PG8_MMA
#undef PG8_WAIT_V
#undef PG8_WAIT_L
#undef PG8_BAR
#undef PG8_SCHED
}
}
namespace attn_body {
using bf16=__hip_bfloat16;
using bf16x8=__attribute__((ext_vector_type(8)))short;
using s16x4=__attribute__((ext_vector_type(4)))short;
using f32x16=__attribute__((ext_vector_type(16)))float;
using u32x4=__attribute__((ext_vector_type(4)))unsigned;
constexpr int BATCH=8,NHEAD=8,SEQ=4096,D=64,DM=5632,OPITCH=1024;
constexpr int NW=8,QBLK=32,QB=QBLK*NW,KVBLK=64,NQB=SEQ/QB;
constexpr int ATTN_PITCH=DM, ATTN_UNIT_ROWS=QB;
__device__ __forceinline__ int crow(int r,int hi){return (r&3)+8*(r>>2)+4*hi;}
#define SBAR() __builtin_amdgcn_sched_barrier(0)
__device__ __forceinline__ void cmask(f32x16&p0,f32x16&p1,int jb,int qrel,int hi){
  const float NEG=-INFINITY; const int lim=qrel-(64*jb+4*hi);
  #pragma unroll
  for(int r=0;r<16;++r){const int cr=(r&3)+8*(r>>2); if(cr>lim)p0[r]=NEG; if(cr+32>lim)p1[r]=NEG;}
}

__device__ __forceinline__ void smask(f32x16&p0,f32x16&p1,unsigned seladdr,int blk){
  const unsigned sel=*(const __attribute__((address_space(3))) unsigned*)(uintptr_t)seladdr;
  if(!((sel>>blk)&1u)){
  #pragma unroll
  for(int r=0;r<16;++r){p0[r]=-INFINITY;p1[r]=-INFINITY;}}
}
constexpr int NSLOT=3, SLOTB=8192;
constexpr int LDS_K=0, LDS_V=NSLOT*SLOTB, LDS_WS=2*NSLOT*SLOTB, LDS_OST=LDS_WS+NW*64*4, LDS_BYTES=LDS_OST+NW*4096;
constexpr float C2=0.125f*1.4426950408889634f;
__device__ __forceinline__ void glds16(const void*gsrc,unsigned lds_dst){unsigned keep;
  asm volatile("s_mov_b32 %0, m0\n\ts_mov_b32 m0, %2\n\ts_nop 0\n\tglobal_load_lds_dwordx4 %1, off\n\ts_mov_b32 m0, %0":"=&s"(keep):"v"(gsrc),"s"(lds_dst):"memory");}
__device__ __forceinline__ float max3f(float a,float b,float c){float r;asm("v_max3_f32 %0, %1, %2, %3":"=v"(r):"v"(a),"v"(b),"v"(c));return r;}
__device__ __forceinline__ float max2f(float a,float b){float r;asm("v_max_f32_e32 %0, %1, %2":"=v"(r):"v"(a),"v"(b));return r;}
__device__ __forceinline__ float fadd_s(float a,float b){float r;asm("v_add_f32_e32 %0, %1, %2":"=v"(r):"v"(a),"v"(b));return r;}
__device__ __forceinline__ float fsub_s(float a,float b){float r;asm("v_sub_f32_e32 %0, %1, %2":"=v"(r):"v"(a),"v"(b));return r;}
typedef float f32x2_t __attribute__((ext_vector_type(2))); typedef __bf16 bf16x2_t __attribute__((ext_vector_type(2)));
__device__ __forceinline__ unsigned cvtpk_s(float lo,float hi){f32x2_t v={lo,hi};bf16x2_t b=__builtin_convertvector(v,bf16x2_t);return __builtin_bit_cast(unsigned,b);}
#define WAIT_BAR(N) asm volatile("s_waitcnt vmcnt(" #N ") lgkmcnt(0)\n\ts_barrier":::"memory")

__device__ __forceinline__ void qkt(f32x16&p0,f32x16&p1,const char*Kslot,const bf16x8*qr,const f32x16&negm,int r32,int hi){
  const char*kb=Kslot+hi*1024+r32*16;
  #pragma unroll
  for(int d0=0;d0<4;++d0){
    const bf16x8 b0=*reinterpret_cast<const bf16x8*>(kb+d0*2048);
    const bf16x8 b1=*reinterpret_cast<const bf16x8*>(kb+d0*2048+512);
    if(d0==0){p0=__builtin_amdgcn_mfma_f32_32x32x16_bf16(b0,qr[0],negm,0,0,0);p1=__builtin_amdgcn_mfma_f32_32x32x16_bf16(b1,qr[0],negm,0,0,0);}
    else{p0=__builtin_amdgcn_mfma_f32_32x32x16_bf16(b0,qr[d0],p0,0,0,0);p1=__builtin_amdgcn_mfma_f32_32x32x16_bf16(b1,qr[d0],p1,0,0,0);}}
}
typedef __attribute__((address_space(3))) const char* lds_cptr;
typedef short v4i16_t __attribute__((ext_vector_type(4)));
__device__ __forceinline__ void kload8(bf16x8*kf,lds_cptr kp){
  kf[0]=*(const __attribute__((address_space(3))) bf16x8*)(kp);      kf[1]=*(const __attribute__((address_space(3))) bf16x8*)(kp+512);
  kf[2]=*(const __attribute__((address_space(3))) bf16x8*)(kp+2048); kf[3]=*(const __attribute__((address_space(3))) bf16x8*)(kp+2560);
  kf[4]=*(const __attribute__((address_space(3))) bf16x8*)(kp+4096); kf[5]=*(const __attribute__((address_space(3))) bf16x8*)(kp+4608);
  kf[6]=*(const __attribute__((address_space(3))) bf16x8*)(kp+6144); kf[7]=*(const __attribute__((address_space(3))) bf16x8*)(kp+6656);
}
__device__ __forceinline__ void kload2(bf16x8*kf,lds_cptr kp,int j){ kf[2*j]=*(const __attribute__((address_space(3))) bf16x8*)(kp+j*2048); kf[2*j+1]=*(const __attribute__((address_space(3))) bf16x8*)(kp+j*2048+512); }
__device__ __forceinline__ s16x4 vtr(lds_cptr p){ return __builtin_bit_cast(s16x4,__builtin_amdgcn_ds_read_tr16_b64_v4i16((__attribute__((address_space(3))) v4i16_t*)p)); }
__device__ __forceinline__ float rowmax(const f32x16&p0,const f32x16&p1){
  float a=max3f(p0[0],p0[1],p1[0]),b=max3f(p0[2],p0[3],p1[1]);a=max3f(a,p1[2],p1[3]);
  #pragma unroll
  for(int r=4;r<16;r+=4){a=max3f(a,p0[r],p0[r+1]);b=max3f(b,p0[r+2],p0[r+3]);a=max3f(a,p1[r],p1[r+1]);b=max3f(b,p1[r+2],p1[r+3]);}
  const float m=max2f(a,b);
  auto rr=__builtin_amdgcn_permlane32_swap(__float_as_uint(m),__float_as_uint(m),false,false);
  return max2f(__uint_as_float(rr[0]),__uint_as_float(rr[1]));
}
__device__ __forceinline__ void pv(f32x16*o,int vb,bf16x8 pa0,bf16x8 pa1,bf16x8 pa2,bf16x8 pa3){
  #pragma unroll
  for(int d0=0;d0<2;++d0){s16x4 lo[4],hi[4];
    #pragma unroll
    for(int ks=0;ks<4;++ks){
      asm volatile("ds_read_b64_tr_b16 %0,%1 offset:%c2":"=&v"(lo[ks]):"v"(vb),"i"(d0*4096+ks*1024):"memory");
      asm volatile("ds_read_b64_tr_b16 %0,%1 offset:%c2":"=&v"(hi[ks]):"v"(vb),"i"(d0*4096+ks*1024+512):"memory");}
    asm volatile("s_waitcnt lgkmcnt(0)":::"memory");SBAR();
    #define PK(k) (bf16x8){lo[k][0],lo[k][1],lo[k][2],lo[k][3],hi[k][0],hi[k][1],hi[k][2],hi[k][3]}
    o[d0]=__builtin_amdgcn_mfma_f32_32x32x16_bf16(pa0,PK(0),o[d0],0,0,0);
    o[d0]=__builtin_amdgcn_mfma_f32_32x32x16_bf16(pa1,PK(1),o[d0],0,0,0);
    o[d0]=__builtin_amdgcn_mfma_f32_32x32x16_bf16(pa2,PK(2),o[d0],0,0,0);
    o[d0]=__builtin_amdgcn_mfma_f32_32x32x16_bf16(pa3,PK(3),o[d0],0,0,0);
    #undef PK
  }
}

#ifndef ATTN_STORE16
#define ATTN_STORE16(p,v) (*(u32x4*)(p)=(v))
#endif
template<int THRL> __device__ __forceinline__ void attn_unit(int b,int h,int qb,unsigned selbase,const bf16*Q,const bf16*__restrict__ K,const bf16*__restrict__ V,bf16*O,char*shm){
  int tid_=threadIdx.x; asm volatile("":"+v"(tid_));
  const int tid=tid_,lane=tid&63,r32=lane&31,hi=lane>>5; const int wid=__builtin_amdgcn_readfirstlane(tid>>6);
  const long rowbase=(long)b*SEQ; const int q0=qb*QB;
  const bf16*Qw=Q+(rowbase+q0+wid*QBLK)*DM+h*D;
  const bf16*Kh=K+rowbase*DM+h*D,*Vh=V+rowbase*DM+h*D;
  const unsigned lds0=(unsigned)(uintptr_t)shm;
  float*wsf=(float*)(shm+LDS_WS)+wid*64;
  const bf16*ksrc=Kh+(long)lane*DM+wid*8;
  const bf16*vsrc=Vh+(long)(16*(wid&3)+(lane>>2))*DM+(wid>>2)*32+(lane&3)*8;
  const unsigned kdst=lds0+LDS_K+wid*1024, vdst=lds0+LDS_V+wid*1024;
  #define DMA_K(t,slot) glds16(ksrc+(long)(t)*KVBLK*DM,(unsigned)__builtin_amdgcn_readfirstlane(kdst+(slot)))
  #define DMA_V(t,slot) glds16(vsrc+(long)(t)*KVBLK*DM,(unsigned)__builtin_amdgcn_readfirstlane(vdst+(slot)))
  const int vb0=(int)(lds0+LDS_V)+((lane>>4)&1)*32+(lane&3)*8+(4*hi+((lane&15)>>2))*64;
  const char*Kbase=shm+LDS_K; bf16x8 kf[8];
  const lds_cptr shm3=(lds_cptr)shm; const lds_cptr kp0=shm3+LDS_K+hi*1024+r32*16; const lds_cptr vp0=shm3+LDS_V+((lane>>4)&1)*32+(lane&3)*8+(4*hi+((lane&15)>>2))*64;
  const int NT=(q0+QB)/KVBLK;
  DMA_K(0,0);DMA_V(0,0);DMA_K(1,SLOTB);
  bf16x8 qr[4];
  #pragma unroll
  for(int d0=0;d0<4;++d0)qr[d0]=*reinterpret_cast<const bf16x8*>(&Qw[(long)r32*DM+d0*16+hi*8]);
  float mhat=0.f,l_reg=0.f;f32x16 o[2];o[0]=f32x16{};o[1]=f32x16{};
  const int qrel=wid*QBLK+r32;
  #define SELBITS() (*(const volatile __attribute__((address_space(3))) unsigned*)(uintptr_t)(selbase+4u*(unsigned)qrel))
  #define CMASK(P0,P1,t) do{int jb_=(t)-(NT-4); if(jb_>=0)cmask(P0,P1,jb_,qrel,hi);}while(0)
  bool resc=false;
  #define START(P0,P1) do{ const float rm=rowmax(P0,P1); resc=false; \
    { const float dl=(rm==-INFINITY)?0.f:rm; mhat=fadd_s(mhat,dl); \
      _Pragma("unroll") for(int r=0;r<16;++r){P0[r]=fsub_s(P0[r],dl);P1[r]=fsub_s(P1[r],dl);} \
      } \
    _Pragma("unroll") for(int r=0;r<16;++r)P0[r]=__builtin_amdgcn_exp2f(P0[r]); }while(0)
  #define RESC() do{ if(resc){ asm volatile("s_waitcnt lgkmcnt(0)":::"memory"); \
      _Pragma("unroll") for(int d_=0;d_<2;++d_) _Pragma("unroll") for(int r=0;r<16;++r)o[d_][r]*=wsf[crow(r,hi)]; } }while(0)
  f32x16 pA0,pA1,pB0,pB1;
  int sl_prev=0,sl_cur=0,sl_next=SLOTB;
  #define ROT() do{sl_prev=sl_cur;sl_cur=sl_next;sl_next=(sl_next==(NSLOT-1)*SLOTB)?0:sl_next+SLOTB;}while(0)
  DMA_K(2,2*SLOTB);
  WAIT_BAR(3);
  qkt(pA0,pA1,Kbase,qr,f32x16{},r32,hi);asm volatile("s_nop 15\n\ts_nop 7":"+v"(pA0),"+v"(pA1));CMASK(pA0,pA1,0);
  if(NT>4&&!(SELBITS()&1u)){
  #pragma unroll
  for(int r=0;r<16;++r){pA0[r]=-INFINITY;pA1[r]=-INFINITY;}}
  START(pA0,pA1);
  _Pragma("unroll") for(int r=0;r<16;++r)pA1[r]=__builtin_amdgcn_exp2f(pA1[r]);
  WAIT_BAR(0);
  DMA_K(3,0);DMA_V(1,SLOTB);
  ROT();
  kload8(kf,kp0+sl_cur);
  WAIT_BAR(2);
  s16x4 vlo[8],vhi[8]; u32x4 pw0,pw1,pw2,pw3;
  #define PKW(P,B) cvtpk_s(P[B],P[B+1])
  #define PAF(k) __builtin_bit_cast(bf16x8,pw##k)
  #define VFR(i) (bf16x8){vlo[i][0],vlo[i][1],vlo[i][2],vlo[i][3],vhi[i][0],vhi[i][1],vhi[i][2],vhi[i][3]}
  #define PIN(x) asm volatile("":"+v"(x))
  #define MX3(a,b,c) __builtin_fmaxf(__builtin_fmaxf((a),(b)),(c))
  #define GAPA(MF,A0,A1,A2,A3,W0,W1,PW) do{ MF; sacc+=A0; sacc+=A1; sacc+=A2; sacc+=A3; PIN(sacc); W0; W1; PIN(PW); SBAR(); }while(0)
  #define EX(v) __builtin_amdgcn_exp2f(v)
  #define GAPB(MF,X,B) do{ MF; X[B]=EX(X[B]); X[B+1]=EX(X[B+1]); X[B+2]=EX(X[B+2]); X[B+3]=EX(X[B+3]); PIN(X); SBAR(); }while(0)
  #define VRD(i) do{ vlo[i]=vtr(vp_+(((i)>>2)*4096+((i)&3)*1024)); vhi[i]=vtr(vp_+(((i)>>2)*4096+((i)&3)*1024+512)); }while(0)
  #define KRD(G,j) do{ if(G){ kload2(kf,kp0+sl_next,j); SBAR(); } }while(0)
  #define STEP(C0,C1,P0,P1,t,GK,GV,GL) do{ SBAR(); \
    const lds_cptr vp_=vp0+sl_prev; \
    VRD(0); SBAR(); float sacc=(P0[0]+P0[1]); \
    GAPA(C0=__builtin_amdgcn_mfma_f32_32x32x16_bf16(kf[0],qr[0],f32x16{},0,0,0), P0[2],P0[3],P0[4],P0[5],     pw0[0]=PKW(P0,0), pw0[1]=PKW(P0,2), pw0); \
    VRD(4); SBAR(); GAPA(C1=__builtin_amdgcn_mfma_f32_32x32x16_bf16(kf[1],qr[0],f32x16{},0,0,0), P0[6],P0[7],P0[8],P0[9],     pw0[2]=PKW(P0,4), pw0[3]=PKW(P0,6), pw0); \
    VRD(1); SBAR(); GAPA(C0=__builtin_amdgcn_mfma_f32_32x32x16_bf16(kf[2],qr[1],C0,0,0,0),   P0[10],P0[11],P0[12],P0[13], pw1[0]=PKW(P0,8), pw1[1]=PKW(P0,10), pw1); \
    VRD(5); SBAR(); GAPA(C1=__builtin_amdgcn_mfma_f32_32x32x16_bf16(kf[3],qr[1],C1,0,0,0),   P0[14],P0[15],P1[0],P1[1],   pw1[2]=PKW(P0,12),pw1[3]=PKW(P0,14), pw1); \
    VRD(2); SBAR(); GAPA(C0=__builtin_amdgcn_mfma_f32_32x32x16_bf16(kf[4],qr[2],C0,0,0,0),   P1[2],P1[3],P1[4],P1[5],     pw2[0]=PKW(P1,0), pw2[1]=PKW(P1,2), pw2); \
    VRD(6); SBAR(); GAPA(C1=__builtin_amdgcn_mfma_f32_32x32x16_bf16(kf[5],qr[2],C1,0,0,0),   P1[6],P1[7],P1[8],P1[9],     pw2[2]=PKW(P1,4), pw2[3]=PKW(P1,6), pw2); \
    VRD(3); SBAR(); GAPA(C0=__builtin_amdgcn_mfma_f32_32x32x16_bf16(kf[6],qr[3],C0,0,0,0),   P1[10],P1[11],P1[12],P1[13], pw3[0]=PKW(P1,8), pw3[1]=PKW(P1,10), pw3); \
    VRD(7); SBAR(); GAPA(C1=__builtin_amdgcn_mfma_f32_32x32x16_bf16(kf[7],qr[3],C1,0,0,0),   P1[14],P1[15],0.f,0.f,       pw3[2]=PKW(P1,12),pw3[3]=PKW(P1,14), pw3); \
    l_reg+=sacc; \
    if(GK){DMA_K((t)+3,sl_cur);} if(GV){DMA_V((t)+1,sl_next);} \
    { float bias_=-mhat; if((t)<NT-4&&!((SELBITS()>>((t)>>2))&1u))bias_=-INFINITY; _Pragma("unroll") for(int r=0;r<16;++r){C0[r]+=bias_;C1[r]+=bias_;} } \
    CMASK(C0,C1,t); \
    { float a=MX3(C0[0],C0[1],C1[0]),b=MX3(C0[2],C0[3],C1[1]); a=MX3(a,C1[2],C1[3]); \
      _Pragma("unroll") for(int r=4;r<16;r+=4){a=MX3(a,C0[r],C0[r+1]);b=MX3(b,C0[r+2],C0[r+3]);a=MX3(a,C1[r],C1[r+1]);b=MX3(b,C1[r+2],C1[r+3]);} \
      float rm=__builtin_fmaxf(a,b); { auto rr=__builtin_amdgcn_permlane32_swap(__float_as_uint(rm),__float_as_uint(rm),false,false); rm=__builtin_fmaxf(__uint_as_float(rr[0]),__uint_as_float(rr[1])); } \
      resc=false; \
      if(__builtin_expect(__any(rm>(float)THRL),0)){ const float dl=__builtin_fmaxf(rm,0.f); mhat+=dl; \
        _Pragma("unroll") for(int r=0;r<16;++r){C0[r]-=dl;C1[r]-=dl;} \
        const float f=__builtin_amdgcn_exp2f(-dl); l_reg*=f; if(hi==0)wsf[r32]=f; resc=true; } } \
    SBAR(); \
    GAPB(o[0]=__builtin_amdgcn_mfma_f32_32x32x16_bf16(PAF(0),VFR(0),o[0],0,0,0), C0,0); \
    GAPB(o[1]=__builtin_amdgcn_mfma_f32_32x32x16_bf16(PAF(0),VFR(4),o[1],0,0,0), C0,4); \
    KRD(GL,0); GAPB(o[0]=__builtin_amdgcn_mfma_f32_32x32x16_bf16(PAF(1),VFR(1),o[0],0,0,0), C0,8); \
    KRD(GL,1); GAPB(o[1]=__builtin_amdgcn_mfma_f32_32x32x16_bf16(PAF(1),VFR(5),o[1],0,0,0), C0,12); \
    KRD(GL,2); GAPB(o[0]=__builtin_amdgcn_mfma_f32_32x32x16_bf16(PAF(2),VFR(2),o[0],0,0,0), C1,0); \
    KRD(GL,3); GAPB(o[1]=__builtin_amdgcn_mfma_f32_32x32x16_bf16(PAF(2),VFR(6),o[1],0,0,0), C1,4); \
    GAPB(o[0]=__builtin_amdgcn_mfma_f32_32x32x16_bf16(PAF(3),VFR(3),o[0],0,0,0), C1,8); \
    GAPB(o[1]=__builtin_amdgcn_mfma_f32_32x32x16_bf16(PAF(3),VFR(7),o[1],0,0,0), C1,12); \
    }while(0)
  int t=1;
  #undef CMASK
  #define CMASK(P0,P1,t) do{}while(0)
  for(;t+5<NT;t+=2){
    STEP(pB0,pB1,pA0,pA1,t,true,true,true);     WAIT_BAR(2); RESC(); ROT();
    STEP(pA0,pA1,pB0,pB1,t+1,true,true,true);   WAIT_BAR(2); RESC(); ROT();
  }
  #undef CMASK
  #define CMASK(P0,P1,t) do{int jb_=(t)-(NT-4); if(jb_>=0)cmask(P0,P1,jb_,qrel,hi);}while(0)
  #define ENDW(tt) do{ if((tt)+3<NT){WAIT_BAR(2);} else if((tt)+2<NT){WAIT_BAR(1);} else {WAIT_BAR(0);} }while(0)
  for(;t+1<NT;t+=2){
    STEP(pB0,pB1,pA0,pA1,t,(t+3<NT),(t+1<NT),(t+1<NT));       ENDW(t);   RESC(); ROT();
    STEP(pA0,pA1,pB0,pB1,t+1,(t+4<NT),(t+2<NT),(t+2<NT));     ENDW(t+1); RESC(); ROT();
  }
  STEP(pB0,pB1,pA0,pA1,NT-1,false,false,false); RESC();
  { float sacc=pB0[0]+pB0[1]; _Pragma("unroll") for(int r=2;r<16;++r)sacc+=pB0[r]; _Pragma("unroll") for(int r=0;r<16;++r)sacc+=pB1[r]; l_reg+=sacc;
    pw0=(u32x4){PKW(pB0,0),PKW(pB0,2),PKW(pB0,4),PKW(pB0,6)};pw1=(u32x4){PKW(pB0,8),PKW(pB0,10),PKW(pB0,12),PKW(pB0,14)};pw2=(u32x4){PKW(pB1,0),PKW(pB1,2),PKW(pB1,4),PKW(pB1,6)};pw3=(u32x4){PKW(pB1,8),PKW(pB1,10),PKW(pB1,12),PKW(pB1,14)};
    SBAR(); pv(o,vb0+sl_cur,PAF(0),PAF(1),PAF(2),PAF(3)); }
  #undef PKW
  #undef PAF
  #undef VFR
  #undef PIN
  #undef MX3
  #undef GAPA
  #undef GAPB
  #undef EX
  #undef VRD
  #undef KRD
  #undef STEP
  #undef ENDW
  {auto rr=__builtin_amdgcn_permlane32_swap(__float_as_uint(l_reg),__float_as_uint(l_reg),false,false);l_reg=__uint_as_float(rr[0])+__uint_as_float(rr[1]);}
  if(hi==0)wsf[32+r32]=l_reg;asm volatile("s_waitcnt lgkmcnt(0)":::"memory");
  float rli[16];
  #pragma unroll
  for(int r=0;r<16;++r)rli[r]=__builtin_amdgcn_rcpf(wsf[32+crow(r,hi)]);
  bf16*Ow=O+(rowbase+q0+wid*QBLK)*OPITCH+h*D;
  { bf16*stg=(bf16*)(shm+LDS_OST)+wid*2048;
    #pragma unroll
    for(int r=0;r<16;++r){const int orow=crow(r,hi);
      #pragma unroll
      for(int d0=0;d0<2;++d0)stg[orow*64+d0*32+r32]=__float2bfloat16(o[d0][r]*rli[r]);}
    asm volatile("s_waitcnt lgkmcnt(0)":::"memory");
    #pragma unroll
    for(int i=0;i<4;++i){const int row=i*8+(lane>>3),ch=lane&7; const u32x4 v=*(const u32x4*)(stg+row*64+ch*8); ATTN_STORE16(Ow+(long)row*OPITCH+ch*8,v);} }
  asm volatile("s_waitcnt lgkmcnt(0)\n\ts_barrier":::"memory");
  #undef DMA_K
  #undef DMA_V
  #undef CMASK
  #undef START
  #undef RESC
  #undef ROT
}
constexpr int ATTN_LDS_BYTES=LDS_BYTES;
constexpr int GATE_KM_OFF=86016, GATE_SEL_OFF=GATE_KM_OFF+4096, GATE_MAXU=16, ATTN_LDS_TOTAL=GATE_SEL_OFF+GATE_MAXU*1024;
__device__ __forceinline__ void moba_gate(int b,int h,int qb,const bf16*Q,const float*KM,char*shm,int slot){
  int tid_=threadIdx.x; asm volatile("":"+v"(tid_)); const int tid=tid_;
  float*kmS=(float*)(shm+GATE_KM_OFF); unsigned*selS=(unsigned*)(shm+GATE_SEL_OFF)+slot*QB;
  if(qb>3){
    for(int i=tid;i<qb*64;i+=512)kmS[i]=KM[(size_t)((b*16+(i>>6))*512)+h*64+(i&63)];
    __syncthreads();
    const int row=tid>>1,half=tid&1;
    const bf16*qp=Q+((long)b*SEQ+qb*QB+row)*DM+h*D+half*32;
    float qv[32];
    #pragma unroll
    for(int c=0;c<4;++c){const u32x4 w=*reinterpret_cast<const u32x4*>(qp+c*8);
      #pragma unroll
      for(int e=0;e<4;++e){qv[c*8+2*e]=__uint_as_float(w[e]<<16);qv[c*8+2*e+1]=__uint_as_float(w[e]&0xffff0000u);}}
    float v0=-INFINITY,v1=-INFINITY,v2=-INFINITY;int i0=0,i1=0,i2=0;
    for(int n=0;n<qb;++n){const float*kr=kmS+n*64+half*32;float d=0.f;
      #pragma unroll
      for(int e=0;e<32;++e)d+=qv[e]*kr[e];
      d+=__shfl_xor(d,1);
      if(d>v0){v2=v1;i2=i1;v1=v0;i1=i0;v0=d;i0=n;}else if(d>v1){v2=v1;i2=i1;v1=d;i1=n;}else if(d>v2){v2=d;i2=n;}}
    if(half==0)selS[row]=(1u<<i0)|(1u<<i1)|(1u<<i2);
  }else{ if(tid<QB)selS[tid]=(1u<<qb)-1u; }
  __syncthreads();
}
struct AttnTensors { const bf16* Q; const bf16* K; const bf16* V; bf16* O; const float* KM; };
__device__ __forceinline__ void unit_of(int idx,int&b,int&h,int&qb){
  const int v=idx&255,i=idx>>8; const int bh=v>>2,s0=(v&3)*2; qb=(i==0)?s0:(i==1)?15-s0:(i==2)?s0+1:14-s0; b=bh/NHEAD; h=bh%NHEAD;
}
template<int THRL=8> __device__ __forceinline__ void attn_phase(char*lds,const AttnTensors&T,int G,int block){
  const int vcu=(G%8==0)?(block%8)*(G/8)+block/8:block;
  { int slot=0; for(int idx=vcu;idx<BATCH*NHEAD*NQB&&slot<GATE_MAXU;idx+=G,++slot){ int b,h,qb; unit_of(idx,b,h,qb); moba_gate(b,h,qb,T.Q,T.KM,lds,slot); } }
  const unsigned selS0=(unsigned)(uintptr_t)(lds+GATE_SEL_OFF);
  int slot=0;
  for(int idx=vcu;idx<BATCH*NHEAD*NQB;idx+=G,++slot){
    int b,h,qb; unit_of(idx,b,h,qb);
    attn_unit<THRL>(b,h,qb,selS0+(unsigned)slot*(QB*4),T.Q,T.K,T.V,T.O,lds);
  }
}
#undef SBAR
#undef WAIT_BAR
}
namespace mk {
using pg8::bf16_t; using pg8::bf16x8; using pg8::f32x4; using pg8::u32x4; using pg8::Unit; using pg8::cvt_pk_bf16;
typedef unsigned u32x2 __attribute__((ext_vector_type(2)));
constexpr int NB = 8, SEQ = 4096, DMODEL = 1024, T = NB * SEQ, FF = 2816, NIN = 5632, INW = 5640;
constexpr int ZP = 5632;
constexpr int ZC_Q = 0, ZC_K = 512, ZC_V = 1024, ZC_QKB = 1536, ZC_VB = 2560, ZC_OB = 3072, ZC_GA = 3584, ZC_GB = 4608;
constexpr float EPS = 1e-6f;
constexpr float C2 = 0.125f * 1.4426950408889634f;
constexpr size_t MiB = 1u << 20;
constexpr size_t WS_BAR = 0;
constexpr size_t WS_WIN = 2 * MiB, WS_WPA = 13 * MiB, WS_WPB = 14 * MiB, WS_WOUT = 15 * MiB;
constexpr size_t WS_R1 = 17 * MiB, WS_KMEAN = 17 * MiB + 128 * 1024, WS_MST = 17 * MiB + 384 * 1024, WS_MC = 17 * MiB + 400 * 1024;
constexpr size_t WS_ROPE = 18 * MiB, WS_GATES = 19 * MiB, WS_SS = 20 * MiB, WS_DN = 22 * MiB, WS_NST = 23 * MiB;
constexpr size_t WS_XB = 24 * MiB;
constexpr size_t WS_YA = 88 * MiB, WS_YB = 120 * MiB;
constexpr size_t WS_Z = 152 * MiB;
constexpr size_t WS_WGU = 328 * MiB + 152 * MiB - 152 * MiB, WS_WDN = 340 * MiB, WS_END = 504 * MiB;
static_assert(WS_Z + (size_t)T * ZP * 2 <= WS_END && WS_Z + (size_t)T * FF * 2 <= WS_WGU && WS_WGU + (size_t)NIN * 1024 * 2 <= WS_WDN && WS_WDN + (size_t)1024 * FF * 2 <= WS_END, "ws map");

struct Params {
    const float* x; const float* g_mix; const float* w_in; const float* conv_w; const float* b_i; const float* b_f; const float* g_ml;
    const float* w_pa; const float* w_pb; const float* w_out; const float* g_ffn; const float* w_gu; const float* w_dn; const float* g_fin;
    float* out; unsigned char* ws;
};

__device__ __forceinline__ float bf2f(unsigned short b) { return __uint_as_float(((unsigned)b) << 16); }
__device__ __forceinline__ unsigned short f2bf(float f) { unsigned u = __float_as_uint(f); return (unsigned short)((u + 0x7fffu + ((u >> 16) & 1u)) >> 16); }
typedef float f32x2_t __attribute__((ext_vector_type(2))); typedef __bf16 bf16x2_t __attribute__((ext_vector_type(2)));
__device__ __forceinline__ unsigned cvtpk_safe(float lo, float hi) { f32x2_t v = {lo, hi}; bf16x2_t b = __builtin_convertvector(v, bf16x2_t); return __builtin_bit_cast(unsigned, b); }
__device__ __forceinline__ float wave_sum(float v) {
#pragma unroll
    for (int o = 1; o < 64; o <<= 1) v += __shfl_xor(v, o);
    return v;
}
template <int CTRL> __device__ __forceinline__ float dpp_mov(float v) { return __int_as_float(__builtin_amdgcn_update_dpp(0, __float_as_int(v), CTRL, 0xf, 0xf, false)); }
__device__ __forceinline__ float row_sum16(float v) { v += dpp_mov<0x128>(v); v += dpp_mov<0x124>(v); v += dpp_mov<0x122>(v); v += dpp_mov<0x121>(v); return v; }
__device__ __forceinline__ float wave_max(float v) {
#pragma unroll
    for (int o = 1; o < 64; o <<= 1) v = fmaxf(v, __shfl_xor(v, o));
    return v;
}
__device__ __forceinline__ float sigmoidf_(float v) { return __builtin_amdgcn_rcpf(1.f + __expf(-v)); }
__device__ __forceinline__ float siluf_(float v) { return v * __builtin_amdgcn_rcpf(1.f + __expf(-v)); }
__device__ __forceinline__ float logsigmoidf_(float v) { return fminf(v, 0.f) - log1pf(__expf(-fabsf(v))); }
__device__ __forceinline__ void unpack8(const u32x4 w, float (&f)[8]) {
#pragma unroll
    for (int e = 0; e < 4; ++e) { f[2 * e] = __uint_as_float(w[e] << 16); f[2 * e + 1] = __uint_as_float(w[e] & 0xffff0000u); }
}

struct EpiInProj {
    static constexpr bool PERM = true, AFTER_DRAIN = false, MID = false;
    bf16_t* Z; const float* r1; const float* rope; float* kmean;
    __device__ __forceinline__ void operator()(const f32x4 (&acc)[2][2][4][2], const Unit& u, int wr, int wc, int fr, int fq) const {
        const int row0 = u.pm * 256 + wr * 64 + fr, pn = u.pn, col0 = pn * 256 + wc * 32 + 8 * fq;
        if (pn < 4) {
            const bool isK = pn >= 2; const float sc = isK ? 1.f : C2; const int jj = 4 * (wc & 1) + fq;
            f32x4 cs[2][2];
#pragma unroll
            for (int a = 0; a < 2; ++a)
#pragma unroll
                for (int b = 0; b < 2; ++b) cs[a][b] = (f32x4){0.f, 0.f, 0.f, 0.f};
#pragma unroll
            for (int ai = 0; ai < 2; ++ai)
#pragma unroll
                for (int m = 0; m < 4; ++m) {
                    const int row = row0 + ai * 128 + m * 16; const float rs = sc; const int pos = row & (SEQ - 1);
                    const f32x4 c4 = *(const f32x4*)(rope + (size_t)(pos * 8 + jj) * 8), s4 = *(const f32x4*)(rope + (size_t)(pos * 8 + jj) * 8 + 4);
                    bf16_t* rowp = Z + (size_t)row * ZP + col0;
#pragma unroll
                    for (int bj = 0; bj < 2; ++bj) {
                        const f32x4 v0 = acc[ai][bj][m][0] * rs, v1 = acc[ai][bj][m][1] * rs;
                        const f32x4 o0 = v0 * c4 - v1 * s4, o1 = v1 * c4 + v0 * s4;
                        cs[bj][0] += o0; cs[bj][1] += o1;
                        u32x4 w; w.x = cvt_pk_bf16(o0[0], o0[1]); w.y = cvt_pk_bf16(o0[2], o0[3]); w.z = cvt_pk_bf16(o1[0], o1[1]); w.w = cvt_pk_bf16(o1[2], o1[3]);
                        *(u32x4*)(rowp + bj * 128) = w;
                    }
                }
            if (isK) {
#pragma unroll
                for (int bj = 0; bj < 2; ++bj)
#pragma unroll
                    for (int n = 0; n < 2; ++n)
#pragma unroll
                        for (int i = 0; i < 4; ++i) {
                            float v = cs[bj][n][i];
                            v = row_sum16(v);
                            if (fr == 0) atomicAdd(kmean + (size_t)u.pm * 512 + (pn - 2) * 256 + bj * 128 + wc * 32 + 8 * fq + 4 * n + i, v);
                        }
            }
        } else if (pn < 14) {
            const bool sig = pn >= 12;
#pragma unroll
            for (int ai = 0; ai < 2; ++ai)
#pragma unroll
                for (int m = 0; m < 4; ++m) {
                    const int row = row0 + ai * 128 + m * 16;
                    bf16_t* rowp = Z + (size_t)row * ZP + col0;
#pragma unroll
                    for (int bj = 0; bj < 2; ++bj) {
                        f32x4 v0 = acc[ai][bj][m][0], v1 = acc[ai][bj][m][1];
                        if (sig) {
#pragma unroll
                            for (int i = 0; i < 4; ++i) { v0[i] = sigmoidf_(v0[i]); v1[i] = sigmoidf_(v1[i]); }
                        }
                        u32x4 w; w.x = cvt_pk_bf16(v0[0], v0[1]); w.y = cvt_pk_bf16(v0[2], v0[3]); w.z = cvt_pk_bf16(v1[0], v1[1]); w.w = cvt_pk_bf16(v1[2], v1[3]);
                        *(u32x4*)(rowp + bj * 128) = w;
                    }
                }
        } else {
            const int oc0 = 128 * (pn - 14) + 32 * wc + 8 * fq;
#pragma unroll
            for (int ai = 0; ai < 2; ++ai)
#pragma unroll
                for (int m = 0; m < 4; ++m) {
                    const int row = row0 + ai * 128 + m * 16; float r[8], sb[8];
#pragma unroll
                    for (int bj = 0; bj < 2; ++bj) { const f32x4 v0 = acc[ai][bj][m][0], v1 = acc[ai][bj][m][1];
#pragma unroll
                        for (int i = 0; i < 4; ++i) { const float ea = 1.f + __expf(-v0[i]), eb = 1.f + __expf(-v1[i]); sb[4 * bj + i] = __builtin_amdgcn_rcpf(eb); r[4 * bj + i] = eb * __builtin_amdgcn_rcpf(ea); } }
                    bf16_t* gp = Z + (size_t)row * ZP + ZC_GA + 128 * (oc0 >> 6) + (oc0 & 63);
                    u32x4 w0, w1; w0.x = cvt_pk_bf16(r[0], r[1]); w0.y = cvt_pk_bf16(r[2], r[3]); w0.z = cvt_pk_bf16(r[4], r[5]); w0.w = cvt_pk_bf16(r[6], r[7]);
                    w1.x = cvt_pk_bf16(sb[0], sb[1]); w1.y = cvt_pk_bf16(sb[2], sb[3]); w1.z = cvt_pk_bf16(sb[4], sb[5]); w1.w = cvt_pk_bf16(sb[6], sb[7]);
                    *(u32x4*)gp = w0; *(u32x4*)(gp + 64) = w1;
                }
        }
    }
};
struct EpiMerge {
    static constexpr bool PERM = true, AFTER_DRAIN = false, MID = true;
    const bf16_t* Zg; bf16_t* O;
    __device__ __forceinline__ void mid(f32x4 (&acc)[2][2][4][2], const Unit& u, int wr, int wc, int fr, int fq) const {
        int row0 = u.pm * 256 + wr * 64 + fr; asm volatile("" : "+v"(row0)); const int col0 = u.pn * 256 + wc * 32 + 8 * fq;
#pragma unroll
        for (int ai = 0; ai < 2; ++ai)
#pragma unroll
            for (int m = 0; m < 4; ++m) {
                const int row = row0 + ai * 128 + m * 16;
#pragma unroll
                for (int bj = 0; bj < 2; ++bj) {
                    const int c = col0 + bj * 128; float r[8]; unpack8(*(const u32x4*)(Zg + (size_t)row * ZP + 128 * (c >> 6) + (c & 63)), r);
#pragma unroll
                    for (int i = 0; i < 4; ++i) { acc[ai][bj][m][0][i] *= r[i]; acc[ai][bj][m][1][i] *= r[4 + i]; }
                }
            }
    }
    __device__ __forceinline__ void operator()(const f32x4 (&acc)[2][2][4][2], const Unit& u, int wr, int wc, int fr, int fq) const {
        const int row0 = u.pm * 256 + wr * 64 + fr, col0 = u.pn * 256 + wc * 32 + 8 * fq;
#pragma unroll
        for (int ai = 0; ai < 2; ++ai)
#pragma unroll
            for (int m = 0; m < 4; ++m) {
                const int row = row0 + ai * 128 + m * 16;
#pragma unroll
                for (int bj = 0; bj < 2; ++bj) {
                    const int c = col0 + bj * 128; float gb[8]; unpack8(*(const u32x4*)(Zg + (size_t)row * ZP + 128 * (c >> 6) + 64 + (c & 63)), gb);
                    const f32x4 v0 = acc[ai][bj][m][0], v1 = acc[ai][bj][m][1];
                    u32x4 w; w.x = cvt_pk_bf16(v0[0] * gb[0], v0[1] * gb[1]); w.y = cvt_pk_bf16(v0[2] * gb[2], v0[3] * gb[3]); w.z = cvt_pk_bf16(v1[0] * gb[4], v1[1] * gb[5]); w.w = cvt_pk_bf16(v1[2] * gb[6], v1[3] * gb[7]);
                    *(u32x4*)(O + (size_t)row * 1024 + col0 + bj * 128) = w;
                }
            }
    }
};
struct EpiOut {
    static constexpr bool PERM = true, AFTER_DRAIN = false, MID = false;
    const float* x; bf16_t* h1b; float* ss;
    __device__ __forceinline__ void operator()(const f32x4 (&acc)[2][2][4][2], const Unit& u, int wr, int wc, int fr, int fq) const {
        const int row0 = u.pm * 256 + wr * 64 + fr, col0 = u.pn * 256 + wc * 32 + 8 * fq;
#pragma unroll
        for (int ai = 0; ai < 2; ++ai)
#pragma unroll
            for (int m = 0; m < 4; ++m) {
                const int row = row0 + ai * 128 + m * 16; float s = 0.f;
#pragma unroll
                for (int bj = 0; bj < 2; ++bj) {
                    const size_t off = (size_t)row * 1024 + col0 + bj * 128;
                    const f32x4 a0 = *(const f32x4*)(x + off) + acc[ai][bj][m][0], a1 = *(const f32x4*)(x + off + 4) + acc[ai][bj][m][1];
                    s += (a0[0] * a0[0] + a0[1] * a0[1]) + (a0[2] * a0[2] + a0[3] * a0[3]) + (a1[0] * a1[0] + a1[1] * a1[1]) + (a1[2] * a1[2] + a1[3] * a1[3]);
                    u32x4 w; w.x = cvt_pk_bf16(a0[0], a0[1]); w.y = cvt_pk_bf16(a0[2], a0[3]); w.z = cvt_pk_bf16(a1[0], a1[1]); w.w = cvt_pk_bf16(a1[2], a1[3]);
                    *(u32x4*)(h1b + off) = w;
                }
                s += __shfl_xor(s, 16); s += __shfl_xor(s, 32);
                if (fq == 0) atomicAdd(ss + row, s);
            }
    }
};
struct EpiGateUp {
    static constexpr bool PERM = true, AFTER_DRAIN = false, MID = false;
    const float* ss; bf16_t* act;
    __device__ __forceinline__ void operator()(const f32x4 (&acc)[2][2][4][2], const Unit& u, int wr, int wc, int fr, int fq) const {
        const int row0 = u.pm * 256 + wr * 64 + fr, col0 = u.pn * 128 + wc * 32 + 8 * fq;
#pragma unroll
        for (int ai = 0; ai < 2; ++ai)
#pragma unroll
            for (int m = 0; m < 4; ++m) {
                const int row = row0 + ai * 128 + m * 16;
                const float rs = rsqrtf(ss[row] * (1.f / 1024.f) + EPS);
                float o[8];
#pragma unroll
                for (int bj = 0; bj < 2; ++bj) {
                    const f32x4 g = acc[ai][bj][m][0] * rs, up = acc[ai][bj][m][1] * rs;
#pragma unroll
                    for (int i = 0; i < 4; ++i) o[4 * bj + i] = siluf_(g[i]) * up[i];
                }
                u32x4 w; w.x = cvt_pk_bf16(o[0], o[1]); w.y = cvt_pk_bf16(o[2], o[3]); w.z = cvt_pk_bf16(o[4], o[5]); w.w = cvt_pk_bf16(o[6], o[7]);
                *(u32x4*)(act + (size_t)row * FF + col0) = w;
            }
    }
};
struct EpiDown {
    static constexpr bool PERM = true, AFTER_DRAIN = false, MID = false;
    const bf16_t* h1b; bf16_t* h2b;
    __device__ __forceinline__ void operator()(const f32x4 (&acc)[2][2][4][2], const Unit& u, int wr, int wc, int fr, int fq) const {
        const int row0 = u.pm * 256 + wr * 64 + fr, col0 = u.pn * 256 + wc * 32 + 8 * fq;
#pragma unroll
        for (int ai = 0; ai < 2; ++ai)
#pragma unroll
            for (int m = 0; m < 4; ++m) {
                const int row = row0 + ai * 128 + m * 16;
#pragma unroll
                for (int bj = 0; bj < 2; ++bj) {
                    const size_t off = (size_t)row * 1024 + col0 + bj * 128;
                    float r[8]; unpack8(*(const u32x4*)(h1b + off), r);
                    const f32x4 a0 = acc[ai][bj][m][0], a1 = acc[ai][bj][m][1];
                    u32x4 w; w.x = cvt_pk_bf16(r[0] + a0[0], r[1] + a0[1]); w.y = cvt_pk_bf16(r[2] + a0[2], r[3] + a0[3]); w.z = cvt_pk_bf16(r[4] + a1[0], r[5] + a1[1]); w.w = cvt_pk_bf16(r[6] + a1[2], r[7] + a1[3]);
                    *(u32x4*)(h2b + off) = w;
                }
            }
    }
};
}
namespace mk {
#define LAS __attribute__((address_space(3)))
constexpr int NTHR = 512, RING_BYTES = 131072, LDS_BYTES = 147456;

__device__ __forceinline__ int srccol_in(int n) {
    if (n < 1024) { const int hd = n >> 6, p = n & 63, j = p >> 3, i = p & 7; return (hd << 6) + ((i < 4) ? 4 * j + i : 32 + 4 * j + (i - 4)); }
    if (n < 3584) return n;
    { const int q = n - 3584, t = q >> 8, bj = (q >> 7) & 1, wc = (q >> 5) & 3, fq = (q >> 3) & 3, nn = (q >> 2) & 1, i = q & 3; const int oc = 128 * t + 32 * wc + 8 * fq + 4 * bj + i; return nn ? 4616 + oc : 3592 + oc; }
}
__device__ __forceinline__ int srccol_gu(int n) { const int pn = n >> 8, bj = (n >> 7) & 1, wc = (n >> 5) & 3, fq = (n >> 3) & 3, nn = (n >> 2) & 1, i = n & 3; const int oc = 128 * pn + 32 * wc + 8 * fq + 4 * bj + i; return nn ? FF + oc : oc; }
template <int MODE> __device__ __forceinline__ void tr_item(const float* W, int K, int Nsrc, int Ndst, const float* gain, bf16_t* WT, float* scr, int item, int lane, int Kp = 0, int koff = 0) {
    if (Kp == 0) Kp = K;
    const int nblk = Ndst / 32, kb = item / nblk, nb = item % nblk, k0 = 64 * kb, n0 = 32 * nb;
    const int nd = n0 + (lane & 31); const int sc = MODE == 1 ? srccol_in(nd) : MODE == 2 ? srccol_gu(nd) : nd;
#pragma unroll
    for (int i = 0; i < 32; ++i) { const int kk = 2 * i + (lane >> 5); float v = W[(size_t)(k0 + kk) * Nsrc + sc]; if (gain) v *= gain[k0 + kk]; scr[kk * 33 + (lane & 31)] = v; }
    asm volatile("s_waitcnt lgkmcnt(0)" ::: "memory");
    const int c = lane & 7;
#pragma unroll
    for (int j = 0; j < 4; ++j) { const int n = (lane >> 3) + 8 * j; const float* s = scr + (8 * c) * 33 + n;
        u32x4 o; o.x = cvt_pk_bf16(s[0 * 33], s[1 * 33]); o.y = cvt_pk_bf16(s[2 * 33], s[3 * 33]); o.z = cvt_pk_bf16(s[4 * 33], s[5 * 33]); o.w = cvt_pk_bf16(s[6 * 33], s[7 * 33]);
        *(u32x4*)(WT + (size_t)(n0 + n) * Kp + koff + k0 + 8 * c) = o; }
    asm volatile("s_waitcnt lgkmcnt(0)" ::: "memory");
}

__device__ __forceinline__ void p0_prologue(const Params& p, unsigned char* lds, int G) {
    int tid_ = threadIdx.x; asm volatile("" : "+v"(tid_));
    const int tid = tid_, lane = tid & 63, wave = tid >> 6;
    const int gw = blockIdx.x * 8 + wave, NGW = G * 8, gt = blockIdx.x * NTHR + tid, NGT = G * NTHR;
    unsigned char* ws = p.ws;
    float* scr = (float*)(lds + wave * 8704);
    float* GW = (float*)(lds + 73728);
    for (int i = tid; i < 8192; i += NTHR) { const int k = i >> 3, c = i & 7; const int slot = (((k >> 8) * 4 + (k & 3)) * 64 + ((k >> 2) & 63)); GW[slot * 8 + c] = p.w_in[(size_t)k * INW + 3584 + c] * p.g_mix[k]; }
    { float* km = (float*)(ws + WS_KMEAN); for (int i = gt; i < NB * 16 * 512; i += NGT) km[i] = 0.f; }
    { float* r2 = (float*)(ws + WS_R1); for (int i = gt; i < T; i += NGT) r2[i] = 0.f; }
    { float* rt = (float*)(ws + WS_ROPE);
      for (int i = gt; i < SEQ * 32; i += NGT) { const int pos = i >> 5, d = i & 31; const float inv = powf(10000.f, -(float)d / 32.f); const float ang = (float)pos * inv; float s, c; sincosf(ang, &s, &c);
          const int j = d >> 2, ii = d & 3; rt[(size_t)(pos * 8 + j) * 8 + ii] = c; rt[(size_t)(pos * 8 + j) * 8 + 4 + ii] = s; } }
    { constexpr int I_IN = 16 * (NIN / 32), I_PA = 8 * 32, I_PB = 8 * 32, I_OUT = 16 * 32; constexpr int NITEMS = I_IN + I_PA + I_PB + I_OUT;
      for (int it = gw; it < NITEMS; it += NGW) { int r = it;
          if (r < I_IN) { tr_item<1>(p.w_in, 1024, INW, NIN, p.g_mix, (bf16_t*)(ws + WS_WIN), scr, r, lane); continue; } r -= I_IN;
          if (r < I_PA) { tr_item<0>(p.w_pa, 512, 1024, 1024, nullptr, (bf16_t*)(ws + WS_WPA), scr, r, lane, 1024, 0); continue; } r -= I_PA;
          if (r < I_PB) { tr_item<0>(p.w_pb, 512, 1024, 1024, nullptr, (bf16_t*)(ws + WS_WPA), scr, r, lane, 1024, 512); continue; } r -= I_PB;
          tr_item<0>(p.w_out, 1024, 1024, 1024, nullptr, (bf16_t*)(ws + WS_WOUT), scr, r, lane); } }
    __syncthreads();
    { bf16_t* XB = (bf16_t*)(ws + WS_XB); float* R1 = (float*)(ws + WS_R1); float* GT = (float*)(ws + WS_GATES);
      const int qsel = (lane >> 1) & 31, csel = qsel & 7; const float bias = csel < 4 ? p.b_i[csel] : p.b_f[csel - 4];
      for (int rb = gw * 16; rb < T; rb += NGW * 16) {
        for (int r4 = 0; r4 < 16; r4 += 4) {
          const int row = rb + r4;
          f32x4 v[4][4]; float ssq[4];
#pragma unroll
          for (int r = 0; r < 4; ++r) { const f32x4* xr = (const f32x4*)(p.x + (size_t)(row + r) * 1024) + lane;
#pragma unroll
              for (int j = 0; j < 4; ++j) v[r][j] = xr[64 * j]; }
          float acc[32];
#pragma unroll
          for (int q = 0; q < 32; ++q) acc[q] = 0.f;
#pragma unroll
          for (int r = 0; r < 4; ++r) { float s = 0.f;
#pragma unroll
              for (int j = 0; j < 4; ++j) s += (v[r][j][0] * v[r][j][0] + v[r][j][1] * v[r][j][1]) + (v[r][j][2] * v[r][j][2] + v[r][j][3] * v[r][j][3]);
              ssq[r] = s; }
#pragma unroll
          for (int j = 0; j < 4; ++j)
#pragma unroll
              for (int i = 0; i < 4; ++i) { const f32x4* gwp = (const f32x4*)(GW + (size_t)((j * 4 + i) * 64 + lane) * 8); const f32x4 g0 = gwp[0], g1 = gwp[1];
#pragma unroll
                  for (int r = 0; r < 4; ++r) { const float xv = v[r][j][i];
#pragma unroll
                      for (int c = 0; c < 4; ++c) { acc[r * 8 + c] += g0[c] * xv; acc[r * 8 + 4 + c] += g1[c] * xv; } } }
#pragma unroll
          for (int r = 0; r < 4; ++r) { ssq[r] = wave_sum(ssq[r]); const float rs = rsqrtf(ssq[r] * (1.f / 1024.f) + EPS); u32x2* o8 = (u32x2*)(XB + (size_t)(row + r) * 1024) + lane;
#pragma unroll
              for (int j = 0; j < 4; ++j) { const f32x4 xs = v[r][j] * rs; u32x2 w; w.x = cvt_pk_bf16(xs[0], xs[1]); w.y = cvt_pk_bf16(xs[2], xs[3]); o8[64 * j] = w; } }
#pragma unroll
          for (int st = 0; st < 5; ++st) { const int M = 32 >> st, n2 = 16 >> st; const bool up = (lane & M) != 0;
#pragma unroll
              for (int i = 0; i < n2; ++i) { const float lo = acc[i], hi = acc[i + n2]; const float send = up ? lo : hi, keep = up ? hi : lo; acc[i] = keep + __shfl_xor(send, M); } }
          const float tot = acc[0] + __shfl_xor(acc[0], 1);
          const int rsel = qsel >> 3; const float ss = rsel == 0 ? ssq[0] : rsel == 1 ? ssq[1] : rsel == 2 ? ssq[2] : ssq[3];
          const float rstd = rsqrtf(ss * (1.f / 1024.f) + EPS);
          if ((lane & 1) == 0) GT[(size_t)(row + rsel) * 8 + csel] = tot * rstd + bias;
        } } }
}
__device__ __forceinline__ void p4_weights(const Params& p, unsigned char* lds, int G) {
    int tid_ = threadIdx.x; asm volatile("" : "+v"(tid_));
    const int tid = tid_, lane = tid & 63, wave = tid >> 6; const int gw = blockIdx.x * 8 + wave, NGW = G * 8;
    float* scr = (float*)(lds + wave * 8704);
    constexpr int I_GU = 16 * (NIN / 32), I_DN = (FF / 64) * 32;
    for (int it = gw; it < I_GU + I_DN; it += NGW) {
        if (it < I_GU) tr_item<2>(p.w_gu, 1024, 2 * FF, NIN, p.g_ffn, (bf16_t*)(p.ws + WS_WGU), scr, it, lane);
        else tr_item<0>(p.w_dn, FF, 1024, 1024, nullptr, (bf16_t*)(p.ws + WS_WDN), scr, it - I_GU, lane);
    }
    __syncthreads();
}

template <int CTRL, int RMASK> __device__ __forceinline__ float dpp_or(float oldv, float v) { return __int_as_float(__builtin_amdgcn_update_dpp(__float_as_int(oldv), __float_as_int(v), CTRL, RMASK, 0xf, false)); }
__device__ __forceinline__ float wave_incl_sum(float v, int) {
    v += dpp_or<0x111, 0xf>(0.f, v); v += dpp_or<0x112, 0xf>(0.f, v); v += dpp_or<0x114, 0xf>(0.f, v); v += dpp_or<0x118, 0xf>(0.f, v);
    v += dpp_or<0x142, 0xa>(0.f, v); v += dpp_or<0x143, 0xc>(0.f, v);
    return v;
}
__device__ __forceinline__ float wave_incl_max(float v, int) {
    const float ninf = -INFINITY;
    v = fmaxf(v, dpp_or<0x111, 0xf>(ninf, v)); v = fmaxf(v, dpp_or<0x112, 0xf>(ninf, v)); v = fmaxf(v, dpp_or<0x114, 0xf>(ninf, v)); v = fmaxf(v, dpp_or<0x118, 0xf>(ninf, v));
    v = fmaxf(v, dpp_or<0x142, 0xa>(ninf, v)); v = fmaxf(v, dpp_or<0x143, 0xc>(ninf, v));
    return v;
}
__device__ __forceinline__ void conv2x8r(const u32x4 (&xr)[5], const float* cw, float (&y)[2][8]) {
#pragma unroll
    for (int hf = 0; hf < 2; ++hf) {
        f32x4 wj[4];
#pragma unroll
        for (int j = 0; j < 4; ++j) wj[j] = *(const f32x4*)(cw + j * 1024 + 4 * hf);
        f32x4 x[5];
#pragma unroll
        for (int i = 0; i < 5; ++i) { const unsigned a = xr[i][2 * hf], b = xr[i][2 * hf + 1]; x[i] = (f32x4){__uint_as_float(a << 16), __uint_as_float(a & 0xffff0000u), __uint_as_float(b << 16), __uint_as_float(b & 0xffff0000u)}; }
#pragma unroll
        for (int r = 0; r < 2; ++r) { const f32x4 z = wj[0] * x[r] + wj[1] * x[r + 1] + wj[2] * x[r + 2] + wj[3] * x[r + 3];
#pragma unroll
            for (int i = 0; i < 4; ++i) y[r][4 * hf + i] = siluf_(z[i]); }
    }
}
__device__ __forceinline__ void load5(const bf16_t* src, int c, int t, u32x4 (&xr)[5]) {
#pragma unroll
    for (int i = 0; i < 5; ++i) { const int tt = t - 3 + i; const bool ok = (c > 0) | (tt >= 0); const u32x4 w = *(const u32x4*)(src + (long)(ok ? tt : 0) * ZP); xr[i] = ok ? w : (u32x4){0u, 0u, 0u, 0u}; }
}
constexpr float KSCALE = 0.08838834764831845f;

struct M1Pre { u32x4 k[5], v[2]; float li, fp; };
__device__ __forceinline__ void m1_issue(const Params& p, int u, int tid, M1Pre& q) {
    const int lane = tid & 63, bh = u >> 6, c = u & 63, b = bh >> 2, h = bh & 3; const size_t row0 = (size_t)b * SEQ + c * 64;
    const bf16_t* Z = (const bf16_t*)(p.ws + WS_Z); const int d0 = (tid & 15) * 8, t = 2 * (tid >> 4);
    load5(Z + row0 * ZP + ZC_QKB + 512 + h * 128 + d0, c, t, q.k);
    const bf16_t* vs = Z + row0 * ZP + ZC_VB + h * 128 + d0; q.v[0] = *(const u32x4*)(vs + (long)t * ZP); q.v[1] = *(const u32x4*)(vs + (long)(t + 1) * ZP);
    const float* gp = (const float*)(p.ws + WS_GATES) + (row0 + lane) * 8; q.li = gp[h]; q.fp = gp[4 + h];
}
__device__ __forceinline__ void m1_compute(const Params& p, unsigned char* lds, int u, int tid_in, const M1Pre& q) {
    int tid = tid_in; asm volatile("" : "+v"(tid));
    const int lane = tid & 63, wid = tid >> 6;
    const int bh = u >> 6, h = bh & 3;
    bf16_t* KT = (bf16_t*)lds; bf16_t* VT = KT + 128 * 72; float* wS = (float*)(VT + 128 * 72); float* dnp = wS + 64;
    if (wid == 0) {
        const float li = q.li, lf = logsigmoidf_(q.fp);
        const float bcs = wave_incl_sum(lf, lane), btot = __shfl(bcs, 63);
        const float g = btot - bcs + li, gm = wave_max(g);
        wS[lane] = __expf(g - gm);
        if (lane == 0) { float* mst = (float*)(p.ws + WS_MST); mst[u * 2] = btot; mst[u * 2 + 1] = gm; }
    }
    const int d0 = (tid & 15) * 8, rg = tid >> 4, t = 2 * rg;
    float y[2][8];
    conv2x8r(q.k, (const float*)(lds + 65536) + 512 + h * 128 + d0, y);
    float vv[2][8]; unpack8(q.v[0], vv[0]); unpack8(q.v[1], vv[1]);
    __syncthreads();
    { const float w0 = KSCALE * wS[t], w1 = KSCALE * wS[t + 1];
#pragma unroll
      for (int i = 0; i < 8; ++i) { const float a = y[0][i] * w0, bq = y[1][i] * w1;
          *(unsigned*)(KT + (d0 + i) * 72 + t) = cvt_pk_bf16(a, bq); dnp[rg * 128 + d0 + i] = a + bq;
          *(unsigned*)(VT + (d0 + i) * 72 + t) = cvt_pk_bf16(vv[0][i], vv[1][i]); } }
    __syncthreads();
    if (tid < 128) { float s = 0.f;
#pragma unroll
        for (int r = 0; r < 32; ++r) s += dnp[r * 128 + tid];
        ((float*)(p.ws + WS_DN))[(size_t)u * 128 + tid] = s; }
    bf16_t* DT = (bf16_t*)(lds + 81920);
    { const int fr = lane & 15, fq = lane >> 4;
      const bf16x8 a0 = *(const bf16x8*)(KT + (16 * wid + fr) * 72 + fq * 8), a1 = *(const bf16x8*)(KT + (16 * wid + fr) * 72 + 32 + fq * 8);
#pragma unroll
      for (int et = 0; et < 8; ++et) {
          const bf16x8 b0 = *(const bf16x8*)(VT + (16 * et + fr) * 72 + fq * 8), b1 = *(const bf16x8*)(VT + (16 * et + fr) * 72 + 32 + fq * 8);
          f32x4 acc = (f32x4){0.f, 0.f, 0.f, 0.f};
          acc = __builtin_amdgcn_mfma_f32_16x16x32_bf16(a0, b0, acc, 0, 0, 0); acc = __builtin_amdgcn_mfma_f32_16x16x32_bf16(a1, b1, acc, 0, 0, 0);
          u32x2 w; w.x = cvtpk_safe(acc[0], acc[1]); w.y = cvtpk_safe(acc[2], acc[3]);
          *(u32x2*)(DT + (16 * et + fr) * 136 + 16 * wid + fq * 4) = w;
      } }
    __syncthreads();
    { bf16_t* DC = (bf16_t*)p.out + (size_t)u * 16384;
#pragma unroll
      for (int i = 0; i < 4; ++i) { const int ch = tid + NTHR * i, e = ch >> 4, part = ch & 15; *(u32x4*)(DC + e * 128 + part * 8) = *(const u32x4*)(DT + e * 136 + part * 8); } }
}
__device__ __forceinline__ void m1_phase(const Params& p, unsigned char* lds, int G) {
    int tid_ = threadIdx.x; asm volatile("" : "+v"(tid_)); const int tid = tid_;
    int u = blockIdx.x; if (u >= 2048) return;
    { float* cwS = (float*)(lds + 65536); for (int i = tid; i < 1024; i += NTHR) *(f32x4*)(cwS + 4 * i) = *(const f32x4*)(p.conv_w + 4 * i); }
    M1Pre cur; m1_issue(p, u, tid, cur);
    __syncthreads();
    for (;;) {
        const int un = u + G; const bool more = un < 2048; M1Pre nxt = cur;
        if (more) m1_issue(p, un, tid, nxt);
        __builtin_amdgcn_sched_barrier(0);
        m1_compute(p, lds, u, tid, cur);
        if (!more) break;
        cur = nxt; u = un;
    }
}
__device__ __forceinline__ void m2_scan(const Params& p, int G) {
    const int gt = blockIdx.x * NTHR + threadIdx.x, NGT = G * NTHR;
    const float* mst = (const float*)(p.ws + WS_MST); float* MC = (float*)(p.ws + WS_MC);
    const bf16_t* DC = (const bf16_t*)p.out; const float* DN = (const float*)(p.ws + WS_DN); float* NST = (float*)(p.ws + WS_NST); bf16_t* CST = (bf16_t*)(p.ws + WS_XB);
    for (int item = gt; item < 32 * 4128; item += NGT) {
        const int bh = item / 4128, vi = item % 4128; const bool isn = vi >= 4096;
        float m = 0.f; f32x4 S = (f32x4){0.f, 0.f, 0.f, 0.f};
        for (int c0 = 0; c0 < 64; c0 += 8) {
            f32x4 dv[8]; float bt[8], gmv[8];
#pragma unroll
            for (int k = 0; k < 8; ++k) { const int u = bh * 64 + c0 + k;
                if (isn) dv[k] = *(const f32x4*)(DN + (size_t)u * 128 + (vi - 4096) * 4);
                else { const u32x2 w = *(const u32x2*)(DC + (size_t)u * 16384 + vi * 4); dv[k] = (f32x4){__uint_as_float(w.x << 16), __uint_as_float(w.x & 0xffff0000u), __uint_as_float(w.y << 16), __uint_as_float(w.y & 0xffff0000u)}; }
                bt[k] = mst[u * 2]; gmv[k] = mst[u * 2 + 1]; }
#pragma unroll
            for (int k = 0; k < 8; ++k) { const int u = bh * 64 + c0 + k;
                if (isn) *(f32x4*)(NST + (size_t)u * 128 + (vi - 4096) * 4) = S;
                else { u32x2 w; w.x = cvt_pk_bf16(S[0], S[1]); w.y = cvt_pk_bf16(S[2], S[3]); *(u32x2*)(CST + (size_t)u * 16384 + vi * 4) = w; }
                if (vi == 0) MC[u] = m;
                const float mn = fmaxf(bt[k] + m, gmv[k]), a = __expf(bt[k] + m - mn), dd = __expf(gmv[k] - mn);
                S = S * a + dv[k] * dd; m = mn; }
        }
    }
}
struct M3Pre { u32x4 q[5], k[5]; float li, fp, mc, nv; };
__device__ __forceinline__ void m3_issue(const Params& p, int u, int tid, M3Pre& q) {
    const int lane = tid & 63, bh = u >> 6, c = u & 63, b = bh >> 2, h = bh & 3; const size_t row0 = (size_t)b * SEQ + c * 64;
    const bf16_t* Z = (const bf16_t*)(p.ws + WS_Z); const int d0 = (tid & 15) * 8, t = 2 * (tid >> 4);
    load5(Z + row0 * ZP + ZC_QKB + h * 128 + d0, c, t, q.q);
    load5(Z + row0 * ZP + ZC_QKB + 512 + h * 128 + d0, c, t, q.k);
    const float* gp = (const float*)(p.ws + WS_GATES) + (row0 + lane) * 8; q.li = gp[h]; q.fp = gp[4 + h];
    q.mc = ((const float*)(p.ws + WS_MC))[u]; q.nv = ((const float*)(p.ws + WS_NST))[(size_t)u * 128 + (tid & 127)];
}
__device__ __forceinline__ void m3_compute(const Params& p, unsigned char* lds, int u, int tid_in, const M3Pre& pre, const u32x4 (&vin)[2], const u32x4 (&cin)[4], float gn) {
    int tid = tid_in; asm volatile("" : "+v"(tid));
    const int lane = tid & 63, wid = tid >> 6, fr = lane & 15, fq = lane >> 4;
    const int bh = u >> 6, c = u & 63, b = bh >> 2, h = bh & 3; const size_t row0 = (size_t)b * SEQ + c * 64;
    bf16_t* QS = (bf16_t*)lds; bf16_t* KS = (bf16_t*)(lds + 17408); bf16_t* VT = (bf16_t*)(lds + 34816); bf16_t* CT = (bf16_t*)(lds + 53248); bf16_t* SC = (bf16_t*)(lds + 88064);
    float* fb = (float*)(lds + 97280); float* bS = fb; float* aS = fb + 64; float* mT = fb + 128; float* wI = fb + 192; float* qn = fb + 256; float* denP = fb + 320; float* nS = fb + 576; float* hsq = fb + 704;
    if (wid == 0) {
        const float li = pre.li, lf = logsigmoidf_(pre.fp);
        const float bcs = wave_incl_sum(lf, lane); const float a = li - bcs; const float pm = wave_incl_max(a, lane);
        const float mc = pre.mc; const float mt = bcs + fmaxf(mc, pm);
        bS[lane] = bcs; aS[lane] = a; mT[lane] = mt; wI[lane] = __expf(bcs + mc - mt);
    }
    { const int d0 = (tid & 15) * 8, rg = tid >> 4, t = 2 * rg; float y[2][8];
      conv2x8r(pre.q, (const float*)(lds + 102400) + h * 128 + d0, y);
#pragma unroll
      for (int r = 0; r < 2; ++r) { u32x4 w; w.x = cvt_pk_bf16(y[r][0], y[r][1]); w.y = cvt_pk_bf16(y[r][2], y[r][3]); w.z = cvt_pk_bf16(y[r][4], y[r][5]); w.w = cvt_pk_bf16(y[r][6], y[r][7]); *(u32x4*)(QS + (t + r) * 136 + d0) = w; }
      conv2x8r(pre.k, (const float*)(lds + 102400) + 512 + h * 128 + d0, y);
#pragma unroll
      for (int r = 0; r < 2; ++r) { u32x4 w; w.x = cvt_pk_bf16(y[r][0] * KSCALE, y[r][1] * KSCALE); w.y = cvt_pk_bf16(y[r][2] * KSCALE, y[r][3] * KSCALE); w.z = cvt_pk_bf16(y[r][4] * KSCALE, y[r][5] * KSCALE); w.w = cvt_pk_bf16(y[r][6] * KSCALE, y[r][7] * KSCALE); *(u32x4*)(KS + (t + r) * 136 + d0) = w; }
      if (tid < 128) nS[tid] = pre.nv; }
    __syncthreads();
    { const int tr = wid >> 1;
#pragma unroll
      for (int tci = 0; tci < 2; ++tci) { const int tc = 2 * (wid & 1) + tci;
          f32x4 acc = (f32x4){0.f, 0.f, 0.f, 0.f};
          if (tc <= tr) {
#pragma unroll
              for (int ks = 0; ks < 4; ++ks) { const bf16x8 a = *(const bf16x8*)(QS + (16 * tr + fr) * 136 + ks * 32 + fq * 8), bb = *(const bf16x8*)(KS + (16 * tc + fr) * 136 + ks * 32 + fq * 8);
                  acc = __builtin_amdgcn_mfma_f32_16x16x32_bf16(a, bb, acc, 0, 0, 0); } }
          const int s = 16 * tc + fr; const float as = aS[s]; const int t0 = 16 * tr + fq * 4;
          const f32x4 bt4 = *(const f32x4*)(bS + t0), mt4 = *(const f32x4*)(mT + t0);
          float val[4];
#pragma unroll
          for (int j = 0; j < 4; ++j) { const float e = __expf(fminf(bt4[j] + as - mt4[j], 0.f)); const float x = acc[j] * e; val[j] = (tc <= tr && s <= t0 + j) ? x : 0.f; }
#pragma unroll
          for (int j = 0; j < 4; ++j) SC[(t0 + j) * 72 + s] = f2bf(val[j]);
#pragma unroll
          for (int j = 0; j < 4; ++j) val[j] = row_sum16(val[j]);
          if (fr == 0) {
#pragma unroll
              for (int j = 0; j < 4; ++j) denP[(t0 + j) * 4 + tc] = val[j]; } }
      { const int t = tid >> 3, part = tid & 7; float dot = 0.f;
#pragma unroll
        for (int i = 0; i < 16; ++i) dot += bf2f(QS[t * 136 + 16 * part + i]) * nS[16 * part + i];
        dot += __shfl_xor(dot, 1); dot += __shfl_xor(dot, 2); dot += __shfl_xor(dot, 4);
        if (part == 0) qn[t] = dot; }
      { const int d0 = (tid & 15) * 8, t = 2 * (tid >> 4); const u32x4 va = vin[0], vb = vin[1];
#pragma unroll
        for (int i = 0; i < 4; ++i) { *(unsigned*)(VT + (d0 + 2 * i) * 72 + t) = (va[i] & 0xffffu) | (vb[i] << 16); *(unsigned*)(VT + (d0 + 2 * i + 1) * 72 + t) = (va[i] >> 16) | (vb[i] & 0xffff0000u); }
#pragma unroll
        for (int i = 0; i < 4; ++i) { const int ch = tid + NTHR * i, e = ch >> 4, part = ch & 15; *(u32x4*)(CT + e * 136 + part * 8) = cin[i]; } } }
    u32x4 sob[2];
    { const bf16_t* Zo = (const bf16_t*)(p.ws + WS_Z) + ZC_OB + h * 128;
#pragma unroll
      for (int i = 0; i < 2; ++i) { const int id = tid + NTHR * i; sob[i] = *(const u32x4*)(Zo + (row0 + (id >> 4)) * ZP + (id & 15) * 8); } }
    __syncthreads();
    f32x4 hv[4];
    { f32x4 acc1[4], acc2[4];
#pragma unroll
      for (int tt = 0; tt < 4; ++tt) { acc1[tt] = (f32x4){0.f, 0.f, 0.f, 0.f}; acc2[tt] = (f32x4){0.f, 0.f, 0.f, 0.f}; }
#pragma unroll
      for (int ks = 0; ks < 2; ++ks) { const bf16x8 bv = *(const bf16x8*)(VT + (16 * wid + fr) * 72 + ks * 32 + fq * 8);
#pragma unroll
          for (int tt = 0; tt < 4; ++tt) { const bf16x8 a = *(const bf16x8*)(SC + (16 * tt + fr) * 72 + ks * 32 + fq * 8); acc1[tt] = __builtin_amdgcn_mfma_f32_16x16x32_bf16(a, bv, acc1[tt], 0, 0, 0); } }
#pragma unroll
      for (int ks = 0; ks < 4; ++ks) { const bf16x8 bc = *(const bf16x8*)(CT + (16 * wid + fr) * 136 + ks * 32 + fq * 8);
#pragma unroll
          for (int tt = 0; tt < 4; ++tt) { const bf16x8 a = *(const bf16x8*)(QS + (16 * tt + fr) * 136 + ks * 32 + fq * 8); acc2[tt] = __builtin_amdgcn_mfma_f32_16x16x32_bf16(a, bc, acc2[tt], 0, 0, 0); } }
#pragma unroll
      for (int tt = 0; tt < 4; ++tt) { const int t0 = 16 * tt + fq * 4;
          const f32x4 wi4 = *(const f32x4*)(wI + t0), qn4 = *(const f32x4*)(qn + t0), mt4 = *(const f32x4*)(mT + t0);
          f32x4 sq4;
#pragma unroll
          for (int j = 0; j < 4; ++j) { const f32x4 d4 = *(const f32x4*)(denP + (t0 + j) * 4);
              const float num = acc1[tt][j] + wi4[j] * acc2[tt][j];
              const float den = (d4[0] + d4[1]) + (d4[2] + d4[3]) + wi4[j] * qn4[j];
              const float hval = num * __builtin_amdgcn_rcpf(fmaxf(fabsf(den), __expf(-mt4[j]))); hv[tt][j] = hval;
              sq4[j] = row_sum16(hval * hval); }
          if (fr == 0) {
#pragma unroll
              for (int j = 0; j < 4; ++j) hsq[(t0 + j) * 8 + wid] = sq4[j]; } } }
    __syncthreads();
    { float* OT = (float*)(lds + 53248);
#pragma unroll
      for (int tt = 0; tt < 4; ++tt)
#pragma unroll
          for (int j = 0; j < 4; ++j) { const int t = 16 * tt + fq * 4 + j; const f32x4* hp = (const f32x4*)(hsq + t * 8); const f32x4 s4 = hp[0] + hp[1];
              const float rstd = rsqrtf(((s4[0] + s4[1]) + (s4[2] + s4[3])) * (1.f / 128.f) + EPS);
              OT[t * 132 + 16 * wid + fr] = hv[tt][j] * rstd; } }
    __syncthreads();
    { const float* OT = (const float*)(lds + 53248); bf16_t* YB = (bf16_t*)(p.ws + WS_YA) + 512 + h * 128;
#pragma unroll
      for (int i = 0; i < 2; ++i) { const int id = tid + NTHR * i, t = id >> 4, e0 = (id & 15) * 8;
          const f32x4 h0 = *(const f32x4*)(OT + t * 132 + e0), h1 = *(const f32x4*)(OT + t * 132 + e0 + 4);
          const f32x4 g0 = *(const f32x4*)(p.g_ml + h * 128 + e0), g1 = *(const f32x4*)(p.g_ml + h * 128 + e0 + 4);
          float so[8]; unpack8(sob[i], so);
          u32x4 w; w.x = cvt_pk_bf16(h0[0] * g0[0] * so[0], h0[1] * g0[1] * so[1]); w.y = cvt_pk_bf16(h0[2] * g0[2] * so[2], h0[3] * g0[3] * so[3]);
          w.z = cvt_pk_bf16(h1[0] * g1[0] * so[4], h1[1] * g1[1] * so[5]); w.w = cvt_pk_bf16(h1[2] * g1[2] * so[6], h1[3] * g1[3] * so[7]);
          *(u32x4*)(YB + (row0 + t) * 1024 + e0) = w; } }
}
__device__ __forceinline__ void m3_phase(const Params& p, unsigned char* lds, int G) {
    int tid_ = threadIdx.x; asm volatile("" : "+v"(tid_)); const int tid = tid_;
    const int lane = tid & 63, wid = tid >> 6, fr = lane & 15, fq = lane >> 4;
    int u = blockIdx.x; if (u >= 2048) return;
    const bf16_t* Z = (const bf16_t*)(p.ws + WS_Z);
    { float* cwS = (float*)(lds + 102400); for (int i = tid; i < 1024; i += NTHR) *(f32x4*)(cwS + 4 * i) = *(const f32x4*)(p.conv_w + 4 * i); }
    M3Pre cur; m3_issue(p, u, tid, cur);
    __syncthreads();
    for (;;) {
        const int bh = u >> 6, c = u & 63, b = bh >> 2, h = bh & 3; const size_t row0 = (size_t)b * SEQ + c * 64;
        u32x4 vin[2], cin[4];
        { const int d0 = (tid & 15) * 8, t = 2 * (tid >> 4); const bf16_t* vs = Z + row0 * ZP + ZC_VB + h * 128 + d0; vin[0] = *(const u32x4*)(vs + (long)t * ZP); vin[1] = *(const u32x4*)(vs + (long)(t + 1) * ZP);
          const bf16_t* CST = (const bf16_t*)(p.ws + WS_XB) + (size_t)u * 16384;
#pragma unroll
          for (int i = 0; i < 4; ++i) { const int ch = tid + NTHR * i, e = ch >> 4, part = ch & 15; cin[i] = *(const u32x4*)(CST + e * 128 + part * 8); } }
        const float gn = p.g_ml[h * 128 + 16 * wid + fr];
        const int un = u + G; const bool more = un < 2048; M3Pre nxt = cur;
        if (more) m3_issue(p, un, tid, nxt);
        __builtin_amdgcn_sched_barrier(0);
        m3_compute(p, lds, u, tid, cur, vin, cin, gn);
        if (!more) break;
        cur = nxt; u = un;
    }
}
__device__ __forceinline__ void p7_final(const Params& p, int G) {
    const int lane = threadIdx.x & 63, gw = blockIdx.x * 8 + (threadIdx.x >> 6), NGW = G * 8;
    const bf16_t* H2B = (const bf16_t*)(p.ws + WS_XB);
    f32x4 g4[4];
#pragma unroll
    for (int j = 0; j < 2; ++j) { g4[2 * j] = *(const f32x4*)(p.g_fin + 512 * j + 8 * lane); g4[2 * j + 1] = *(const f32x4*)(p.g_fin + 512 * j + 8 * lane + 4); }
    for (int rb = gw * 16; rb < T; rb += NGW * 16)
        for (int r4 = 0; r4 < 16; r4 += 4) {
            u32x4 w[4][2];
#pragma unroll
            for (int r = 0; r < 4; ++r)
#pragma unroll
                for (int j = 0; j < 2; ++j) w[r][j] = *(const u32x4*)(H2B + (size_t)(rb + r4 + r) * 1024 + 512 * j + 8 * lane);
#pragma unroll
            for (int r = 0; r < 4; ++r) { float v[2][8]; unpack8(w[r][0], v[0]); unpack8(w[r][1], v[1]); float s = 0.f;
#pragma unroll
                for (int j = 0; j < 2; ++j)
#pragma unroll
                    for (int i = 0; i < 8; ++i) s += v[j][i] * v[j][i];
                const float rstd = rsqrtf(wave_sum(s) * (1.f / 1024.f) + EPS); float* xo = p.out + (size_t)(rb + r4 + r) * 1024 + 8 * lane;
#pragma unroll
                for (int j = 0; j < 2; ++j) { const f32x4 o0 = (f32x4){v[j][0], v[j][1], v[j][2], v[j][3]} * rstd * g4[2 * j], o1 = (f32x4){v[j][4], v[j][5], v[j][6], v[j][7]} * rstd * g4[2 * j + 1];
                    *(f32x4*)(xo + 512 * j) = o0; *(f32x4*)(xo + 512 * j + 4) = o1; } }
        }
}

#define XB_TMO      128
#define XB_XCNT(j)  (256  + 64 * (j))
#define XB_XSUB(j)  (1280 + 64 * (j))
#define XB_XGEN(j)  (2304 + 64 * (j))
#define XB_TOP      3328
#define XB_TOPGEN   3392
#define XCD_BAR_WORDS 3456
#define XB_SPIN_CAP (1u << 18)

__device__ __forceinline__ unsigned xb_ld(unsigned* p)              { return __hip_atomic_load(p, __ATOMIC_RELAXED, __HIP_MEMORY_SCOPE_AGENT); }
__device__ __forceinline__ unsigned xb_add(unsigned* p, unsigned v) { return __hip_atomic_fetch_add(p, v, __ATOMIC_RELAXED, __HIP_MEMORY_SCOPE_AGENT); }
__device__ __forceinline__ unsigned xb_xcc_id() { return (unsigned)__builtin_amdgcn_s_getreg((3 << 11) | 20) & 0xFu; }
#define XB_SPIN(cond, bar) do { unsigned _sp = 0; while (cond) { __builtin_amdgcn_s_sleep(1); \
    if ((++_sp & 255u) == 0u) { if (xb_ld(&(bar)[XB_TMO])) break; if (_sp > XB_SPIN_CAP) { atomicAdd(&(bar)[XB_TMO], 1u); break; } } } } while (0)

struct XcdBarrier {
    unsigned* bar; unsigned x;
    volatile LAS unsigned* st;
};

__device__ __forceinline__ XcdBarrier xcd_barrier_post(unsigned* bar, volatile LAS unsigned* st) {
    XcdBarrier b; b.bar = bar; b.x = xb_xcc_id(); b.st = st;
    if (threadIdx.x == 0) (void)xb_add(&bar[XB_XCNT(b.x)], 1u);
    return b;
}
__device__ __forceinline__ void xcd_barrier_complete(unsigned* bar, unsigned x, unsigned& nloc, unsigned& nx) {
    const unsigned G = gridDim.x * gridDim.y * gridDim.z;
    unsigned sum, cnt, mine, sp = 0u;
    for (;;) {
        sum = 0u; cnt = 0u; mine = 0u;
#pragma unroll
        for (unsigned j = 0; j < 16; ++j) { const unsigned c = xb_ld(&bar[XB_XCNT(j)]); sum += c; cnt += (c > 0u) ? 1u : 0u; mine = (j == x) ? c : mine; }
        if (sum == G) break;
        __builtin_amdgcn_s_sleep(1);
        if ((++sp & 255u) == 0u) { if (xb_ld(&bar[XB_TMO])) break; if (sp > XB_SPIN_CAP) { atomicAdd(&bar[XB_TMO], 1u); break; } }
    }
    nloc = mine > 0u ? mine : 1u; nx = cnt > 0u ? cnt : 1u;
}

__device__ __forceinline__ void xcd_barrier(const XcdBarrier& b) {
    asm volatile("s_waitcnt vmcnt(0)" ::: "memory");
    __syncthreads();
    if (threadIdx.x == 0) {
        unsigned* bar = b.bar;
        __builtin_amdgcn_s_waitcnt(0);
        unsigned nloc = b.st[0], nx = b.st[1];
        if (nloc == 0u) { xcd_barrier_complete(bar, b.x, nloc, nx); b.st[0] = nloc; b.st[1] = nx; }
        const unsigned old = xb_add(&bar[XB_XSUB(b.x)], 1u);
        const unsigned gen = old / nloc;
        if (old + 1u == (gen + 1u) * nloc) {
            __builtin_amdgcn_fence(__ATOMIC_RELEASE, "agent");
            asm volatile("s_waitcnt vmcnt(0)" ::: "memory");
            const unsigned og = xb_add(&bar[XB_TOP], 1u);
            const unsigned tg = og / nx;
            if (og + 1u == (tg + 1u) * nx) xb_add(&bar[XB_TOPGEN], 1u);
            else XB_SPIN(xb_ld(&bar[XB_TOPGEN]) == tg, bar);
            __builtin_amdgcn_fence(__ATOMIC_ACQUIRE, "agent");
            xb_add(&bar[XB_XGEN(b.x)], 1u);
            asm volatile("s_waitcnt vmcnt(0)" ::: "memory");
        } else {
            XB_SPIN(xb_ld(&bar[XB_XGEN(b.x)]) == gen, bar);
            __builtin_amdgcn_fence(__ATOMIC_ACQUIRE, "agent");
            asm volatile("s_waitcnt vmcnt(0)" ::: "memory");
        }
    }
    __syncthreads();
}

__global__ void __launch_bounds__(NTHR, 2) fwd_megakernel(Params p) {
    extern __shared__ __attribute__((aligned(16))) unsigned char lds[];
    cg::grid_group grid = cg::this_grid();
    const int G = gridDim.x;
    unsigned char* ws = p.ws;
    PG8_LAS unsigned char* ldsl = (PG8_LAS unsigned char*)lds;
    bf16_t* Z = (bf16_t*)(ws + WS_Z);

    volatile LAS unsigned* bst = (volatile LAS unsigned*)((LAS unsigned char*)lds + LDS_BYTES - 64);
    if (threadIdx.x == 0) { bst[0] = 0u; bst[1] = 0u; }
    __syncthreads();
    const XcdBarrier xb = xcd_barrier_post((unsigned*)(ws + WS_BAR) + 4096, bst);
    if (p.ws == nullptr) grid.sync();
    p0_prologue(p, lds, G);
    xcd_barrier(xb);
    {
        pg8::Gemm g{(const bf16_t*)(ws + WS_XB), (const bf16_t*)(ws + WS_WIN), T, NIN, 1024}; pg8::StaticOrder S; S.init(T, NIN, G, (int)blockIdx.x);
        EpiInProj E{Z, (const float*)(ws + WS_R1), (const float*)(ws + WS_ROPE), (float*)(ws + WS_KMEAN)};
        pg8::gemm_phase<EpiInProj, pg8::StaticOrder, true, true>(ldsl, g, S, E);
    }
    xcd_barrier(xb);
    m1_phase(p, lds, G);
    xcd_barrier(xb);
    m2_scan(p, G);
    {
        const attn_body::AttnTensors AT{(const attn_body::bf16*)(Z + ZC_Q), (const attn_body::bf16*)(Z + ZC_K), (const attn_body::bf16*)(Z + ZC_V), (attn_body::bf16*)(ws + WS_YA), (const float*)(ws + WS_KMEAN)};
        attn_body::attn_phase<8>((char*)lds, AT, G, (int)blockIdx.x);
    }
    xcd_barrier(xb);
    m3_phase(p, lds, G);
    xcd_barrier(xb);
    {
        pg8::StaticOrder S; S.init(T, 1024, G, (int)blockIdx.x);
        pg8::Gemm g{(const bf16_t*)(ws + WS_YA), (const bf16_t*)(ws + WS_WPA), T, 1024, 1024};
        EpiMerge E{Z + ZC_GA, (bf16_t*)(ws + WS_XB)};
        pg8::gemm_phase<EpiMerge, pg8::StaticOrder, true, true>(ldsl, g, S, E);
    }
    xcd_barrier(xb);
    {
        p4_weights(p, lds, G);
        pg8::Gemm g{(const bf16_t*)(ws + WS_XB), (const bf16_t*)(ws + WS_WOUT), T, 1024, 1024}; pg8::StaticOrder S; S.init(T, 1024, G, (int)blockIdx.x);
        EpiOut E{p.x, (bf16_t*)(ws + WS_YA), (float*)(ws + WS_R1)};
        pg8::gemm_phase<EpiOut, pg8::StaticOrder, true, true>(ldsl, g, S, E);
    }
    xcd_barrier(xb);
    {
        pg8::Gemm g{(const bf16_t*)(ws + WS_YA), (const bf16_t*)(ws + WS_WGU), T, NIN, 1024}; pg8::StaticOrder S; S.init(T, NIN, G, (int)blockIdx.x);
        EpiGateUp E{(const float*)(ws + WS_R1), Z};
        pg8::gemm_phase<EpiGateUp, pg8::StaticOrder, true, true>(ldsl, g, S, E);
    }
    xcd_barrier(xb);
    {
        pg8::Gemm g{(const bf16_t*)Z, (const bf16_t*)(ws + WS_WDN), T, 1024, FF}; pg8::StaticOrder S; S.init(T, 1024, G, (int)blockIdx.x);
        EpiDown E{(const bf16_t*)(ws + WS_YA), (bf16_t*)(ws + WS_XB)};
        pg8::gemm_phase<EpiDown, pg8::StaticOrder, true, true>(ldsl, g, S, E);
    }
    xcd_barrier(xb);
    p7_final(p, G);
}
}

extern "C" void kernel_launch(void* const* d_in, const int* in_sizes, int n_in, void* d_out, int out_size, void* d_ws, size_t ws_size, hipStream_t stream) {
    static int grid = 0;
    if (grid == 0) {
        if (n_in != 14 || in_sizes[0] != mk::T * 1024 || out_size != mk::T * 1024 || ws_size < mk::WS_END) { fprintf(stderr, "kernel_launch: unexpected shapes (n_in %d, in0 %d, out %d, ws %zu)\n", n_in, n_in > 0 ? in_sizes[0] : -1, out_size, ws_size); grid = -1; return; }
        int dev = 0, cus = 0, per_cu = 0;
        hipGetDevice(&dev); hipDeviceGetAttribute(&cus, hipDeviceAttributeMultiprocessorCount, dev);
        if (hipFuncSetAttribute((const void*)mk::fwd_megakernel, hipFuncAttributeMaxDynamicSharedMemorySize, mk::LDS_BYTES) != hipSuccess) { fprintf(stderr, "kernel_launch: hipFuncSetAttribute failed\n"); grid = -1; return; }
        if (hipOccupancyMaxActiveBlocksPerMultiprocessor(&per_cu, (const void*)mk::fwd_megakernel, mk::NTHR, mk::LDS_BYTES) != hipSuccess || per_cu < 1) { fprintf(stderr, "kernel_launch: occupancy query says %d blocks per CU\n", per_cu); per_cu = 1; }
        (void)hipGetLastError();
        grid = cus;
    }
    if (grid < 0) return;
    mk::Params p{};
    p.x = (const float*)d_in[0]; p.g_mix = (const float*)d_in[1]; p.w_in = (const float*)d_in[2]; p.conv_w = (const float*)d_in[3]; p.b_i = (const float*)d_in[4]; p.b_f = (const float*)d_in[5];
    p.g_ml = (const float*)d_in[6]; p.w_pa = (const float*)d_in[7]; p.w_pb = (const float*)d_in[8]; p.w_out = (const float*)d_in[9]; p.g_ffn = (const float*)d_in[10]; p.w_gu = (const float*)d_in[11];
    p.w_dn = (const float*)d_in[12]; p.g_fin = (const float*)d_in[13]; p.out = (float*)d_out; p.ws = (unsigned char*)d_ws;
    if (hipMemsetAsync((char*)d_ws + mk::WS_BAR, 0, 32768, stream) != hipSuccess) { fprintf(stderr, "kernel_launch: hipMemsetAsync of the barrier words failed\n"); return; }
    void* args[] = {&p};
    hipError_t e = hipLaunchCooperativeKernel((const void*)mk::fwd_megakernel, dim3(grid), dim3(mk::NTHR), args, mk::LDS_BYTES, stream);
    if (e != hipSuccess) fprintf(stderr, "kernel_launch: cooperative launch failed: %s (grid %d)\n", hipGetErrorString(e), grid);
}
```

```cpp
#include <hip/hip_runtime.h>
#include <hip/hip_cooperative_groups.h>
#include <hip/hip_bf16.h>
#include <cstdio>
#include <cstdint>
#include <cmath>
namespace cg = cooperative_groups;
namespace pg8 {
#define PG8_LAS __attribute__((address_space(3)))
typedef unsigned short bf16_t;
typedef short bf16x8 __attribute__((ext_vector_type(8)));
typedef float f32x4 __attribute__((ext_vector_type(4)));
typedef unsigned u32x4 __attribute__((ext_vector_type(4)));
constexpr int BM = 256, BK = 64, HALF = 128, HTB = HALF * BK * 2  , STAGE_BYTES = 8 * HTB, NXCD = 8, WGM = 8;

__host__ __device__ __forceinline__ int lds_byte(int r, int c) { const int st = (r >> 4) * 2 + (c >> 5), rr = r & 15, cc = c & 31, ob = rr * 64 + cc * 2; return st * 1024 + (ob ^ (((ob >> 9) & 1) << 5)); }
__host__ __device__ __forceinline__ void stage_rc(int b, int& R, int& C) { const int st = b / 1024, sb = b % 1024, swz = sb ^ (((sb >> 9) & 1) << 5); R = (st >> 1) * 16 + swz / 64; C = (st & 1) * 32 + (swz % 64) / 2; }
__host__ __device__ __forceinline__ int perm32(int rho) { const int n = rho >> 4, i = rho & 15; return 8 * (i >> 2) + 4 * n + (i & 3); }

struct Unit { int pm, pn; };
struct Gemm { const bf16_t* A; const bf16_t* Bt; int M, N, K; };

struct StaticOrder {
    int nM, nN, nwg, G, c;
    __host__ __device__ void init(int M, int N, int G_, int c_) { nM = M / BM; nN = N / BM; nwg = nM * nN; G = G_; c = c_; }
    __host__ __device__ bool next(int i, Unit& u) const {
        const long L = (long)i * G + c; if (L >= nwg) return false;
        int wgid = (int)L; { const int q = nwg / NXCD, r = nwg % NXCD, xcd = wgid % NXCD, off = wgid / NXCD; wgid = (xcd < r ? xcd * (q + 1) : r * (q + 1) + (xcd - r) * q) + off; }
        const int nig = WGM * nN, gid = wgid / nig, fm = gid * WGM, gsz = (nM - fm) < WGM ? (nM - fm) : WGM;
        u.pm = fm + ((wgid % nig) % gsz); u.pn = (wgid % nig) / gsz; return true;
    }
    __device__ __forceinline__ void a_ready(const Unit&) const {}
    __device__ __forceinline__ void done(const Unit&) const {}
};
__device__ __forceinline__ unsigned cvt_pk_bf16(float lo, float hi) { unsigned r; asm volatile("v_cvt_pk_bf16_f32 %0, %1, %2" : "=v"(r) : "v"(lo), "v"(hi)); return r; }
typedef float f32x2 __attribute__((ext_vector_type(2)));
template <class Epi, class Sched, bool ALIGN_EPI = false, bool SP2 = false>
__device__ __forceinline__ void gemm_phase(PG8_LAS unsigned char* lds, const Gemm g, const Sched& S, const Epi& E) {
    int tid_ = threadIdx.x; asm volatile("" : "+v"(tid_));
    const int tid = tid_, wid = __builtin_amdgcn_readfirstlane(tid >> 6), lane = tid & 63, wr = wid >> 2, wc = wid & 3, fr = lane & 15, fq = lane >> 4;
    const int K = g.K, nt = K / BK;
    unsigned voffA[2], voffB[2];
#pragma unroll
    for (int i = 0; i < 2; ++i) { int R, C; stage_rc(tid * 16 + i * 8192, R, C); const int Rb = Epi::PERM ? ((R & ~31) + perm32(R & 31)) : R;
        voffA[i] = (unsigned)(R * K + C) * 2u; voffB[i] = (unsigned)(Rb * K + C) * 2u; }
    const size_t kstep = (size_t)(BK * 2);
    const size_t hstep = (size_t)HALF * K * 2;
    const size_t tstep = 2 * hstep;
    const unsigned ldsw = (unsigned)wid * 1024u;
    const int aoff = lds_byte(wr * 64 + fr, fq * 8), boff = lds_byte(wc * 32 + fr, fq * 8);
#define PG8_SA(b, h) (((b) * 2 + (h)) * HTB)
#define PG8_SB(b, h) ((4 + (b) * 2 + (h)) * HTB)
#define PG8_STAGE(bufoff, gbase, voff) do { _Pragma("unroll") for (int _i = 0; _i < 2; ++_i) \
        __builtin_amdgcn_global_load_lds((const unsigned*)((const char*)(gbase) + (voff)[_i]), (PG8_LAS unsigned*)(lds + (bufoff) + ldsw + _i * 8192), 16, 0, 0); } while (0)
#define PG8_LDA(dst, b, h) do { _Pragma("unroll") for (int m = 0; m < 4; ++m) _Pragma("unroll") for (int k = 0; k < 2; ++k) dst[m][k] = *(const PG8_LAS bf16x8*)(lds + PG8_SA(b, h) + aoff + m * 2048 + k * 1024); } while (0)
#define PG8_LDB(dst, b, h) do { _Pragma("unroll") for (int n = 0; n < 2; ++n) _Pragma("unroll") for (int k = 0; k < 2; ++k) dst[n][k] = *(const PG8_LAS bf16x8*)(lds + PG8_SB(b, h) + boff + n * 2048 + k * 1024); } while (0)
#define PG8_MMA(ai, bj, At, Bt) do { __builtin_amdgcn_s_setprio(1); _Pragma("unroll") for (int m = 0; m < 4; ++m) _Pragma("unroll") for (int n = 0; n < 2; ++n) _Pragma("unroll") for (int k = 0; k < 2; ++k) \
        acc[ai][bj][m][n] = __builtin_amdgcn_mfma_f32_16x16x32_bf16(Bt[n][k], At[m][k], acc[ai][bj][m][n], 0, 0, 0); __builtin_amdgcn_s_setprio(0); } while (0)
#define PG8_WAIT_V(n) asm volatile("s_waitcnt vmcnt(" #n ")" ::: "memory")
#define PG8_WAIT_L(n) asm volatile("s_waitcnt lgkmcnt(" #n ")" ::: "memory")
#define PG8_BAR __builtin_amdgcn_s_barrier()
#define PG8_SCHED __builtin_amdgcn_sched_barrier(0)
    Unit cur, nxt; int ui = 0;
    if (!S.next(0, cur)) return;
    f32x4 acc[2][2][4][2];
#pragma unroll
    for (int a = 0; a < 2; ++a)
#pragma unroll
        for (int b = 0; b < 2; ++b)
#pragma unroll
            for (int m = 0; m < 4; ++m)
#pragma unroll
                for (int n = 0; n < 2; ++n) acc[a][b][m][n] = (f32x4){0.f, 0.f, 0.f, 0.f};
    bf16x8 At[4][2], B0[2][2], B1[2][2];
    const char* cA = (const char*)g.A + (size_t)cur.pm * tstep; const char* cB = (const char*)g.Bt + (size_t)cur.pn * tstep;
    S.a_ready(cur);
    if constexpr (SP2) {
        PG8_STAGE(PG8_SB(0, 0), cB, voffB); PG8_STAGE(PG8_SB(0, 1), cB + hstep, voffB); PG8_STAGE(PG8_SA(0, 0), cA, voffA); PG8_STAGE(PG8_SA(0, 1), cA + hstep, voffA);
        if (wr == 1) PG8_BAR;
        PG8_WAIT_V(2); PG8_BAR;
        PG8_STAGE(PG8_SB(1, 0), cB + kstep, voffB); PG8_STAGE(PG8_SA(1, 0), cA + kstep, voffA); PG8_STAGE(PG8_SB(1, 1), cB + hstep + kstep, voffB);
        PG8_WAIT_V(6); PG8_BAR;
    } else {
        PG8_STAGE(PG8_SB(0, 0), cB, voffB); PG8_STAGE(PG8_SA(0, 0), cA, voffA); PG8_STAGE(PG8_SB(0, 1), cB + hstep, voffB); PG8_STAGE(PG8_SA(0, 1), cA + hstep, voffA);
        if (wr == 1) PG8_BAR;
        PG8_WAIT_V(4); PG8_BAR;
        PG8_STAGE(PG8_SB(1, 0), cB + kstep, voffB); PG8_STAGE(PG8_SA(1, 0), cA + kstep, voffA); PG8_STAGE(PG8_SB(1, 1), cB + hstep + kstep, voffB);
        PG8_WAIT_V(6); PG8_BAR;
    }
    for (;;) {
        const bool has_next = S.next(ui + 1, nxt);
        const char* nA = has_next ? (const char*)g.A + (size_t)nxt.pm * tstep : cA; const char* nB = has_next ? (const char*)g.Bt + (size_t)nxt.pn * tstep : cB;
        for (int t = 0; t < nt; t += 2) {
            const bool last = (t == nt - 2);
            if constexpr (Epi::MID) { if (t == (nt >> 1)) E.mid(acc, cur, wr, wc, fr, fq); }
            const char* a1 = cA + (size_t)(t + 1) * kstep;
            const char* a2 = last ? nA : cA + (size_t)(t + 2) * kstep; const char* b2 = last ? nB : cB + (size_t)(t + 2) * kstep;
            const char* a3 = a2 + kstep; const char* b3 = b2 + kstep;
            if (last && has_next) S.a_ready(nxt);
            if constexpr (SP2) {
            PG8_LDB(B0, 0, 0); PG8_LDB(B1, 0, 1); PG8_SCHED; PG8_LDA(At, 0, 0); PG8_STAGE(PG8_SA(1, 1), a1 + hstep, voffA);
            PG8_WAIT_V(8); PG8_WAIT_L(0); PG8_BAR; PG8_MMA(0, 0, At, B0); PG8_MMA(0, 1, At, B1); PG8_BAR; PG8_SCHED;
            PG8_LDA(At, 0, 1); PG8_STAGE(PG8_SB(0, 0), b2, voffB); PG8_STAGE(PG8_SB(0, 1), b2 + hstep, voffB); PG8_STAGE(PG8_SA(0, 0), a2, voffA);
            PG8_WAIT_V(8); PG8_WAIT_L(0); PG8_BAR; PG8_MMA(1, 0, At, B0); PG8_MMA(1, 1, At, B1); PG8_BAR; PG8_SCHED;
            PG8_LDB(B0, 1, 0); PG8_LDB(B1, 1, 1); PG8_SCHED; PG8_LDA(At, 1, 0); PG8_STAGE(PG8_SA(0, 1), a2 + hstep, voffA);
            PG8_WAIT_V(8); PG8_WAIT_L(0); PG8_BAR; PG8_MMA(0, 0, At, B0); PG8_MMA(0, 1, At, B1); PG8_BAR; PG8_SCHED;
            PG8_LDA(At, 1, 1); PG8_STAGE(PG8_SB(1, 0), b3, voffB); PG8_STAGE(PG8_SB(1, 1), b3 + hstep, voffB); PG8_STAGE(PG8_SA(1, 0), a3, voffA);
            PG8_WAIT_V(8); PG8_WAIT_L(0); PG8_BAR; PG8_MMA(1, 0, At, B0); PG8_MMA(1, 1, At, B1); PG8_BAR; PG8_SCHED;
            } else {
            PG8_LDB(B0, 0, 0); PG8_SCHED; PG8_LDA(At, 0, 0); PG8_STAGE(PG8_SA(1, 1), a1 + hstep, voffA);
            PG8_WAIT_L(8); PG8_BAR; PG8_WAIT_L(0); PG8_MMA(0, 0, At, B0); PG8_BAR; PG8_SCHED;
            PG8_LDB(B1, 0, 1); PG8_STAGE(PG8_SB(0, 0), b2, voffB);
            PG8_BAR; PG8_WAIT_L(0); PG8_MMA(0, 1, At, B1); PG8_BAR;
            PG8_LDA(At, 0, 1); PG8_STAGE(PG8_SA(0, 0), a2, voffA);
            PG8_BAR; PG8_WAIT_L(0); PG8_MMA(1, 0, At, B0); PG8_BAR; PG8_SCHED;
            PG8_STAGE(PG8_SB(0, 1), b2 + hstep, voffB);
            PG8_WAIT_V(6); PG8_BAR; PG8_MMA(1, 1, At, B1); PG8_BAR;
            PG8_LDB(B0, 1, 0); PG8_SCHED; PG8_LDA(At, 1, 0); PG8_STAGE(PG8_SA(0, 1), a2 + hstep, voffA);
            PG8_WAIT_L(8); PG8_BAR; PG8_WAIT_L(0); PG8_MMA(0, 0, At, B0); PG8_BAR; PG8_SCHED;
            PG8_LDB(B1, 1, 1); PG8_STAGE(PG8_SB(1, 0), b3, voffB);
            PG8_BAR; PG8_WAIT_L(0); PG8_MMA(0, 1, At, B1); PG8_BAR;
            PG8_LDA(At, 1, 1); PG8_STAGE(PG8_SA(1, 0), a3, voffA);
            PG8_BAR; PG8_WAIT_L(0); PG8_MMA(1, 0, At, B0); PG8_BAR; PG8_SCHED;
            PG8_STAGE(PG8_SB(1, 1), b3 + hstep, voffB);
            PG8_WAIT_V(6); PG8_BAR; PG8_MMA(1, 1, At, B1); PG8_BAR;
            }
        }
        if constexpr (ALIGN_EPI) { if (wr == 0) PG8_BAR; }
        if constexpr (!Epi::AFTER_DRAIN) { E(acc, cur, wr, wc, fr, fq); S.done(cur); }
        if (!has_next) break;
#pragma unroll
        for (int a = 0; a < 2; ++a)
#pragma unroll
            for (int b = 0; b < 2; ++b)
#pragma unroll
                for (int m = 0; m < 4; ++m)
#pragma unroll
                    for (int n = 0; n < 2; ++n) acc[a][b][m][n] = (f32x4){0.f, 0.f, 0.f, 0.f};
        cur = nxt; cA = nA; cB = nB; ++ui;
        if constexpr (ALIGN_EPI) { if (wr == 1) PG8_BAR; }
    }
    PG8_WAIT_V(0);
    if constexpr (!ALIGN_EPI) { if (wr == 0) PG8_BAR; }
    PG8_BAR;
    if constexpr (Epi::AFTER_DRAIN) { E.fused(acc, cur, wr, wc, fr, fq, lds, wid, lane); S.done(cur); }
#undef PG8_SA
#undef PG8_SB
#undef PG8_STAGE
#undef PG8_LDA
#undef PG8_LDB
#undef PG8_MMA
#undef PG8_WAIT_V
#undef PG8_WAIT_L
#undef PG8_BAR
#undef PG8_SCHED
}
}
namespace attn_body {
using bf16=__hip_bfloat16;
using bf16x8=__attribute__((ext_vector_type(8)))short;
using s16x4=__attribute__((ext_vector_type(4)))short;
using f32x16=__attribute__((ext_vector_type(16)))float;
using u32x4=__attribute__((ext_vector_type(4)))unsigned;
constexpr int BATCH=8,NHEAD=8,SEQ=4096,D=64,DM=5632,OPITCH=1024;
constexpr int NW=8,QBLK=32,QB=QBLK*NW,KVBLK=64,NQB=SEQ/QB;
constexpr int ATTN_PITCH=DM, ATTN_UNIT_ROWS=QB;
__device__ __forceinline__ int crow(int r,int hi){return (r&3)+8*(r>>2)+4*hi;}
#define SBAR() __builtin_amdgcn_sched_barrier(0)
__device__ __forceinline__ void cmask(f32x16&p0,f32x16&p1,int jb,int qrel,int hi){
  const float NEG=-INFINITY; const int lim=qrel-(64*jb+4*hi);
  #pragma unroll
  for(int r=0;r<16;++r){const int cr=(r&3)+8*(r>>2); if(cr>lim)p0[r]=NEG; if(cr+32>lim)p1[r]=NEG;}
}

__device__ __forceinline__ void smask(f32x16&p0,f32x16&p1,unsigned seladdr,int blk){
  const unsigned sel=*(const __attribute__((address_space(3))) unsigned*)(uintptr_t)seladdr;
  if(!((sel>>blk)&1u)){
  #pragma unroll
  for(int r=0;r<16;++r){p0[r]=-INFINITY;p1[r]=-INFINITY;}}
}
constexpr int NSLOT=3, SLOTB=8192;
constexpr int LDS_K=0, LDS_V=NSLOT*SLOTB, LDS_WS=2*NSLOT*SLOTB, LDS_OST=LDS_WS+NW*64*4, LDS_BYTES=LDS_OST+NW*4096;
constexpr float C2=0.125f*1.4426950408889634f;
__device__ __forceinline__ void glds16(const void*gsrc,unsigned lds_dst){unsigned keep;
  asm volatile("s_mov_b32 %0, m0\n\ts_mov_b32 m0, %2\n\ts_nop 0\n\tglobal_load_lds_dwordx4 %1, off\n\ts_mov_b32 m0, %0":"=&s"(keep):"v"(gsrc),"s"(lds_dst):"memory");}
__device__ __forceinline__ float max3f(float a,float b,float c){float r;asm("v_max3_f32 %0, %1, %2, %3":"=v"(r):"v"(a),"v"(b),"v"(c));return r;}
__device__ __forceinline__ float max2f(float a,float b){float r;asm("v_max_f32_e32 %0, %1, %2":"=v"(r):"v"(a),"v"(b));return r;}
__device__ __forceinline__ float fadd_s(float a,float b){float r;asm("v_add_f32_e32 %0, %1, %2":"=v"(r):"v"(a),"v"(b));return r;}
__device__ __forceinline__ float fsub_s(float a,float b){float r;asm("v_sub_f32_e32 %0, %1, %2":"=v"(r):"v"(a),"v"(b));return r;}
typedef float f32x2_t __attribute__((ext_vector_type(2))); typedef __bf16 bf16x2_t __attribute__((ext_vector_type(2)));
__device__ __forceinline__ unsigned cvtpk_s(float lo,float hi){f32x2_t v={lo,hi};bf16x2_t b=__builtin_convertvector(v,bf16x2_t);return __builtin_bit_cast(unsigned,b);}
#define WAIT_BAR(N) asm volatile("s_waitcnt vmcnt(" #N ") lgkmcnt(0)\n\ts_barrier":::"memory")

__device__ __forceinline__ void qkt(f32x16&p0,f32x16&p1,const char*Kslot,const bf16x8*qr,const f32x16&negm,int r32,int hi){
  const char*kb=Kslot+hi*1024+r32*16;
  #pragma unroll
  for(int d0=0;d0<4;++d0){
    const bf16x8 b0=*reinterpret_cast<const bf16x8*>(kb+d0*2048);
    const bf16x8 b1=*reinterpret_cast<const bf16x8*>(kb+d0*2048+512);
    if(d0==0){p0=__builtin_amdgcn_mfma_f32_32x32x16_bf16(b0,qr[0],negm,0,0,0);p1=__builtin_amdgcn_mfma_f32_32x32x16_bf16(b1,qr[0],negm,0,0,0);}
    else{p0=__builtin_amdgcn_mfma_f32_32x32x16_bf16(b0,qr[d0],p0,0,0,0);p1=__builtin_amdgcn_mfma_f32_32x32x16_bf16(b1,qr[d0],p1,0,0,0);}}
}
typedef __attribute__((address_space(3))) const char* lds_cptr;
typedef short v4i16_t __attribute__((ext_vector_type(4)));
__device__ __forceinline__ void kload8(bf16x8*kf,lds_cptr kp){
  kf[0]=*(const __attribute__((address_space(3))) bf16x8*)(kp);      kf[1]=*(const __attribute__((address_space(3))) bf16x8*)(kp+512);
  kf[2]=*(const __attribute__((address_space(3))) bf16x8*)(kp+2048); kf[3]=*(const __attribute__((address_space(3))) bf16x8*)(kp+2560);
  kf[4]=*(const __attribute__((address_space(3))) bf16x8*)(kp+4096); kf[5]=*(const __attribute__((address_space(3))) bf16x8*)(kp+4608);
  kf[6]=*(const __attribute__((address_space(3))) bf16x8*)(kp+6144); kf[7]=*(const __attribute__((address_space(3))) bf16x8*)(kp+6656);
}
__device__ __forceinline__ void kload2(bf16x8*kf,lds_cptr kp,int j){ kf[2*j]=*(const __attribute__((address_space(3))) bf16x8*)(kp+j*2048); kf[2*j+1]=*(const __attribute__((address_space(3))) bf16x8*)(kp+j*2048+512); }
__device__ __forceinline__ s16x4 vtr(lds_cptr p){ return __builtin_bit_cast(s16x4,__builtin_amdgcn_ds_read_tr16_b64_v4i16((__attribute__((address_space(3))) v4i16_t*)p)); }
__device__ __forceinline__ float rowmax(const f32x16&p0,const f32x16&p1){
  float a=max3f(p0[0],p0[1],p1[0]),b=max3f(p0[2],p0[3],p1[1]);a=max3f(a,p1[2],p1[3]);
  #pragma unroll
  for(int r=4;r<16;r+=4){a=max3f(a,p0[r],p0[r+1]);b=max3f(b,p0[r+2],p0[r+3]);a=max3f(a,p1[r],p1[r+1]);b=max3f(b,p1[r+2],p1[r+3]);}
  const float m=max2f(a,b);
  auto rr=__builtin_amdgcn_permlane32_swap(__float_as_uint(m),__float_as_uint(m),false,false);
  return max2f(__uint_as_float(rr[0]),__uint_as_float(rr[1]));
}
__device__ __forceinline__ void pv(f32x16*o,int vb,bf16x8 pa0,bf16x8 pa1,bf16x8 pa2,bf16x8 pa3){
  #pragma unroll
  for(int d0=0;d0<2;++d0){s16x4 lo[4],hi[4];
    #pragma unroll
    for(int ks=0;ks<4;++ks){
      asm volatile("ds_read_b64_tr_b16 %0,%1 offset:%c2":"=&v"(lo[ks]):"v"(vb),"i"(d0*4096+ks*1024):"memory");
      asm volatile("ds_read_b64_tr_b16 %0,%1 offset:%c2":"=&v"(hi[ks]):"v"(vb),"i"(d0*4096+ks*1024+512):"memory");}
    asm volatile("s_waitcnt lgkmcnt(0)":::"memory");SBAR();
    #define PK(k) (bf16x8){lo[k][0],lo[k][1],lo[k][2],lo[k][3],hi[k][0],hi[k][1],hi[k][2],hi[k][3]}
    o[d0]=__builtin_amdgcn_mfma_f32_32x32x16_bf16(pa0,PK(0),o[d0],0,0,0);
    o[d0]=__builtin_amdgcn_mfma_f32_32x32x16_bf16(pa1,PK(1),o[d0],0,0,0);
    o[d0]=__builtin_amdgcn_mfma_f32_32x32x16_bf16(pa2,PK(2),o[d0],0,0,0);
    o[d0]=__builtin_amdgcn_mfma_f32_32x32x16_bf16(pa3,PK(3),o[d0],0,0,0);
    #undef PK
  }
}

#ifndef ATTN_STORE16
#define ATTN_STORE16(p,v) (*(u32x4*)(p)=(v))
#endif
template<int THRL> __device__ __forceinline__ void attn_unit(int b,int h,int qb,unsigned selbase,const bf16*Q,const bf16*__restrict__ K,const bf16*__restrict__ V,bf16*O,char*shm){
  int tid_=threadIdx.x; asm volatile("":"+v"(tid_));
  const int tid=tid_,lane=tid&63,r32=lane&31,hi=lane>>5; const int wid=__builtin_amdgcn_readfirstlane(tid>>6);
  const long rowbase=(long)b*SEQ; const int q0=qb*QB;
  const bf16*Qw=Q+(rowbase+q0+wid*QBLK)*DM+h*D;
  const bf16*Kh=K+rowbase*DM+h*D,*Vh=V+rowbase*DM+h*D;
  const unsigned lds0=(unsigned)(uintptr_t)shm;
  float*wsf=(float*)(shm+LDS_WS)+wid*64;
  const bf16*ksrc=Kh+(long)lane*DM+wid*8;
  const bf16*vsrc=Vh+(long)(16*(wid&3)+(lane>>2))*DM+(wid>>2)*32+(lane&3)*8;
  const unsigned kdst=lds0+LDS_K+wid*1024, vdst=lds0+LDS_V+wid*1024;
  #define DMA_K(t,slot) glds16(ksrc+(long)(t)*KVBLK*DM,(unsigned)__builtin_amdgcn_readfirstlane(kdst+(slot)))
  #define DMA_V(t,slot) glds16(vsrc+(long)(t)*KVBLK*DM,(unsigned)__builtin_amdgcn_readfirstlane(vdst+(slot)))
  const int vb0=(int)(lds0+LDS_V)+((lane>>4)&1)*32+(lane&3)*8+(4*hi+((lane&15)>>2))*64;
  const char*Kbase=shm+LDS_K; bf16x8 kf[8];
  const lds_cptr shm3=(lds_cptr)shm; const lds_cptr kp0=shm3+LDS_K+hi*1024+r32*16; const lds_cptr vp0=shm3+LDS_V+((lane>>4)&1)*32+(lane&3)*8+(4*hi+((lane&15)>>2))*64;
  const int NT=(q0+QB)/KVBLK;
  DMA_K(0,0);DMA_V(0,0);DMA_K(1,SLOTB);
  bf16x8 qr[4];
  #pragma unroll
  for(int d0=0;d0<4;++d0)qr[d0]=*reinterpret_cast<const bf16x8*>(&Qw[(long)r32*DM+d0*16+hi*8]);
  float mhat=0.f,l_reg=0.f;f32x16 o[2];o[0]=f32x16{};o[1]=f32x16{};
  const int qrel=wid*QBLK+r32;
  #define SELBITS() (*(const volatile __attribute__((address_space(3))) unsigned*)(uintptr_t)(selbase+4u*(unsigned)qrel))
  #define CMASK(P0,P1,t) do{int jb_=(t)-(NT-4); if(jb_>=0)cmask(P0,P1,jb_,qrel,hi);}while(0)
  bool resc=false;
  #define START(P0,P1) do{ const float rm=rowmax(P0,P1); resc=false; \
    { const float dl=(rm==-INFINITY)?0.f:rm; mhat=fadd_s(mhat,dl); \
      _Pragma("unroll") for(int r=0;r<16;++r){P0[r]=fsub_s(P0[r],dl);P1[r]=fsub_s(P1[r],dl);} \
      } \
    _Pragma("unroll") for(int r=0;r<16;++r)P0[r]=__builtin_amdgcn_exp2f(P0[r]); }while(0)
  #define RESC() do{ if(resc){ asm volatile("s_waitcnt lgkmcnt(0)":::"memory"); \
      _Pragma("unroll") for(int d_=0;d_<2;++d_) _Pragma("unroll") for(int r=0;r<16;++r)o[d_][r]*=wsf[crow(r,hi)]; } }while(0)
  f32x16 pA0,pA1,pB0,pB1;
  int sl_prev=0,sl_cur=0,sl_next=SLOTB;
  #define ROT() do{sl_prev=sl_cur;sl_cur=sl_next;sl_next=(sl_next==(NSLOT-1)*SLOTB)?0:sl_next+SLOTB;}while(0)
  DMA_K(2,2*SLOTB);
  WAIT_BAR(3);
  qkt(pA0,pA1,Kbase,qr,f32x16{},r32,hi);asm volatile("s_nop 15\n\ts_nop 7":"+v"(pA0),"+v"(pA1));CMASK(pA0,pA1,0);
  if(NT>4&&!(SELBITS()&1u)){
  #pragma unroll
  for(int r=0;r<16;++r){pA0[r]=-INFINITY;pA1[r]=-INFINITY;}}
  START(pA0,pA1);
  _Pragma("unroll") for(int r=0;r<16;++r)pA1[r]=__builtin_amdgcn_exp2f(pA1[r]);
  WAIT_BAR(0);
  DMA_K(3,0);DMA_V(1,SLOTB);
  ROT();
  kload8(kf,kp0+sl_cur);
  WAIT_BAR(2);
  s16x4 vlo[8],vhi[8]; u32x4 pw0,pw1,pw2,pw3;
  #define PKW(P,B) cvtpk_s(P[B],P[B+1])
  #define PAF(k) __builtin_bit_cast(bf16x8,pw##k)
  #define VFR(i) (bf16x8){vlo[i][0],vlo[i][1],vlo[i][2],vlo[i][3],vhi[i][0],vhi[i][1],vhi[i][2],vhi[i][3]}
  #define PIN(x) asm volatile("":"+v"(x))
  #define MX3(a,b,c) __builtin_fmaxf(__builtin_fmaxf((a),(b)),(c))
  #define GAPA(MF,A0,A1,A2,A3,W0,W1,PW) do{ MF; sacc+=A0; sacc+=A1; sacc+=A2; sacc+=A3; PIN(sacc); W0; W1; PIN(PW); SBAR(); }while(0)
  #define EX(v) __builtin_amdgcn_exp2f(v)
  #define GAPB(MF,X,B) do{ MF; X[B]=EX(X[B]); X[B+1]=EX(X[B+1]); X[B+2]=EX(X[B+2]); X[B+3]=EX(X[B+3]); PIN(X); SBAR(); }while(0)
  #define VRD(i) do{ vlo[i]=vtr(vp_+(((i)>>2)*4096+((i)&3)*1024)); vhi[i]=vtr(vp_+(((i)>>2)*4096+((i)&3)*1024+512)); }while(0)
  #define KRD(G,j) do{ if(G){ kload2(kf,kp0+sl_next,j); SBAR(); } }while(0)
  #define STEP(C0,C1,P0,P1,t,GK,GV,GL) do{ SBAR(); \
    const lds_cptr vp_=vp0+sl_prev; \
    VRD(0); SBAR(); float sacc=(P0[0]+P0[1]); \
    GAPA(C0=__builtin_amdgcn_mfma_f32_32x32x16_bf16(kf[0],qr[0],f32x16{},0,0,0), P0[2],P0[3],P0[4],P0[5],     pw0[0]=PKW(P0,0), pw0[1]=PKW(P0,2), pw0); \
    VRD(4); SBAR(); GAPA(C1=__builtin_amdgcn_mfma_f32_32x32x16_bf16(kf[1],qr[0],f32x16{},0,0,0), P0[6],P0[7],P0[8],P0[9],     pw0[2]=PKW(P0,4), pw0[3]=PKW(P0,6), pw0); \
    VRD(1); SBAR(); GAPA(C0=__builtin_amdgcn_mfma_f32_32x32x16_bf16(kf[2],qr[1],C0,0,0,0),   P0[10],P0[11],P0[12],P0[13], pw1[0]=PKW(P0,8), pw1[1]=PKW(P0,10), pw1); \
    VRD(5); SBAR(); GAPA(C1=__builtin_amdgcn_mfma_f32_32x32x16_bf16(kf[3],qr[1],C1,0,0,0),   P0[14],P0[15],P1[0],P1[1],   pw1[2]=PKW(P0,12),pw1[3]=PKW(P0,14), pw1); \
    VRD(2); SBAR(); GAPA(C0=__builtin_amdgcn_mfma_f32_32x32x16_bf16(kf[4],qr[2],C0,0,0,0),   P1[2],P1[3],P1[4],P1[5],     pw2[0]=PKW(P1,0), pw2[1]=PKW(P1,2), pw2); \
    VRD(6); SBAR(); GAPA(C1=__builtin_amdgcn_mfma_f32_32x32x16_bf16(kf[5],qr[2],C1,0,0,0),   P1[6],P1[7],P1[8],P1[9],     pw2[2]=PKW(P1,4), pw2[3]=PKW(P1,6), pw2); \
    VRD(3); SBAR(); GAPA(C0=__builtin_amdgcn_mfma_f32_32x32x16_bf16(kf[6],qr[3],C0,0,0,0),   P1[10],P1[11],P1[12],P1[13], pw3[0]=PKW(P1,8), pw3[1]=PKW(P1,10), pw3); \
    VRD(7); SBAR(); GAPA(C1=__builtin_amdgcn_mfma_f32_32x32x16_bf16(kf[7],qr[3],C1,0,0,0),   P1[14],P1[15],0.f,0.f,       pw3[2]=PKW(P1,12),pw3[3]=PKW(P1,14), pw3); \
    l_reg+=sacc; \
    if(GK){DMA_K((t)+3,sl_cur);} if(GV){DMA_V((t)+1,sl_next);} \
    { float bias_=-mhat; if((t)<NT-4&&!((SELBITS()>>((t)>>2))&1u))bias_=-INFINITY; _Pragma("unroll") for(int r=0;r<16;++r){C0[r]+=bias_;C1[r]+=bias_;} } \
    CMASK(C0,C1,t); \
    { float a=MX3(C0[0],C0[1],C1[0]),b=MX3(C0[2],C0[3],C1[1]); a=MX3(a,C1[2],C1[3]); \
      _Pragma("unroll") for(int r=4;r<16;r+=4){a=MX3(a,C0[r],C0[r+1]);b=MX3(b,C0[r+2],C0[r+3]);a=MX3(a,C1[r],C1[r+1]);b=MX3(b,C1[r+2],C1[r+3]);} \
      float rm=__builtin_fmaxf(a,b); { auto rr=__builtin_amdgcn_permlane32_swap(__float_as_uint(rm),__float_as_uint(rm),false,false); rm=__builtin_fmaxf(__uint_as_float(rr[0]),__uint_as_float(rr[1])); } \
      resc=false; \
      if(__builtin_expect(__any(rm>(float)THRL),0)){ const float dl=__builtin_fmaxf(rm,0.f); mhat+=dl; \
        _Pragma("unroll") for(int r=0;r<16;++r){C0[r]-=dl;C1[r]-=dl;} \
        const float f=__builtin_amdgcn_exp2f(-dl); l_reg*=f; if(hi==0)wsf[r32]=f; resc=true; } } \
    SBAR(); \
    GAPB(o[0]=__builtin_amdgcn_mfma_f32_32x32x16_bf16(PAF(0),VFR(0),o[0],0,0,0), C0,0); \
    GAPB(o[1]=__builtin_amdgcn_mfma_f32_32x32x16_bf16(PAF(0),VFR(4),o[1],0,0,0), C0,4); \
    KRD(GL,0); GAPB(o[0]=__builtin_amdgcn_mfma_f32_32x32x16_bf16(PAF(1),VFR(1),o[0],0,0,0), C0,8); \
    KRD(GL,1); GAPB(o[1]=__builtin_amdgcn_mfma_f32_32x32x16_bf16(PAF(1),VFR(5),o[1],0,0,0), C0,12); \
    KRD(GL,2); GAPB(o[0]=__builtin_amdgcn_mfma_f32_32x32x16_bf16(PAF(2),VFR(2),o[0],0,0,0), C1,0); \
    KRD(GL,3); GAPB(o[1]=__builtin_amdgcn_mfma_f32_32x32x16_bf16(PAF(2),VFR(6),o[1],0,0,0), C1,4); \
    GAPB(o[0]=__builtin_amdgcn_mfma_f32_32x32x16_bf16(PAF(3),VFR(3),o[0],0,0,0), C1,8); \
    GAPB(o[1]=__builtin_amdgcn_mfma_f32_32x32x16_bf16(PAF(3),VFR(7),o[1],0,0,0), C1,12); \
    }while(0)
  int t=1;
  #undef CMASK
  #define CMASK(P0,P1,t) do{}while(0)
  for(;t+5<NT;t+=2){
    STEP(pB0,pB1,pA0,pA1,t,true,true,true);     WAIT_BAR(2); RESC(); ROT();
    STEP(pA0,pA1,pB0,pB1,t+1,true,true,true);   WAIT_BAR(2); RESC(); ROT();
  }
  #undef CMASK
  #define CMASK(P0,P1,t) do{int jb_=(t)-(NT-4); if(jb_>=0)cmask(P0,P1,jb_,qrel,hi);}while(0)
  #define ENDW(tt) do{ if((tt)+3<NT){WAIT_BAR(2);} else if((tt)+2<NT){WAIT_BAR(1);} else {WAIT_BAR(0);} }while(0)
  for(;t+1<NT;t+=2){
    STEP(pB0,pB1,pA0,pA1,t,(t+3<NT),(t+1<NT),(t+1<NT));       ENDW(t);   RESC(); ROT();
    STEP(pA0,pA1,pB0,pB1,t+1,(t+4<NT),(t+2<NT),(t+2<NT));     ENDW(t+1); RESC(); ROT();
  }
  STEP(pB0,pB1,pA0,pA1,NT-1,false,false,false); RESC();
  { float sacc=pB0[0]+pB0[1]; _Pragma("unroll") for(int r=2;r<16;++r)sacc+=pB0[r]; _Pragma("unroll") for(int r=0;r<16;++r)sacc+=pB1[r]; l_reg+=sacc;
    pw0=(u32x4){PKW(pB0,0),PKW(pB0,2),PKW(pB0,4),PKW(pB0,6)};pw1=(u32x4){PKW(pB0,8),PKW(pB0,10),PKW(pB0,12),PKW(pB0,14)};pw2=(u32x4){PKW(pB1,0),PKW(pB1,2),PKW(pB1,4),PKW(pB1,6)};pw3=(u32x4){PKW(pB1,8),PKW(pB1,10),PKW(pB1,12),PKW(pB1,14)};
    SBAR(); pv(o,vb0+sl_cur,PAF(0),PAF(1),PAF(2),PAF(3)); }
  #undef PKW
  #undef PAF
  #undef VFR
  #undef PIN
  #undef MX3
  #undef GAPA
  #undef GAPB
  #undef EX
  #undef VRD
  #undef KRD
  #undef STEP
  #undef ENDW
  {auto rr=__builtin_amdgcn_permlane32_swap(__float_as_uint(l_reg),__float_as_uint(l_reg),false,false);l_reg=__uint_as_float(rr[0])+__uint_as_float(rr[1]);}
  if(hi==0)wsf[32+r32]=l_reg;asm volatile("s_waitcnt lgkmcnt(0)":::"memory");
  float rli[16];
  #pragma unroll
  for(int r=0;r<16;++r)rli[r]=__builtin_amdgcn_rcpf(wsf[32+crow(r,hi)]);
  bf16*Ow=O+(rowbase+q0+wid*QBLK)*OPITCH+h*D;
  { bf16*stg=(bf16*)(shm+LDS_OST)+wid*2048;
    #pragma unroll
    for(int r=0;r<16;++r){const int orow=crow(r,hi);
      #pragma unroll
      for(int d0=0;d0<2;++d0)stg[orow*64+d0*32+r32]=__float2bfloat16(o[d0][r]*rli[r]);}
    asm volatile("s_waitcnt lgkmcnt(0)":::"memory");
    #pragma unroll
    for(int i=0;i<4;++i){const int row=i*8+(lane>>3),ch=lane&7; const u32x4 v=*(const u32x4*)(stg+row*64+ch*8); ATTN_STORE16(Ow+(long)row*OPITCH+ch*8,v);} }
  asm volatile("s_waitcnt lgkmcnt(0)\n\ts_barrier":::"memory");
  #undef DMA_K
  #undef DMA_V
  #undef CMASK
  #undef START
  #undef RESC
  #undef ROT
}
constexpr int ATTN_LDS_BYTES=LDS_BYTES;
constexpr int GATE_KM_OFF=86016, GATE_SEL_OFF=GATE_KM_OFF+4096, GATE_MAXU=16, ATTN_LDS_TOTAL=GATE_SEL_OFF+GATE_MAXU*1024;
__device__ __forceinline__ void moba_gate(int b,int h,int qb,const bf16*Q,const float*KM,char*shm,int slot){
  int tid_=threadIdx.x; asm volatile("":"+v"(tid_)); const int tid=tid_;
  float*kmS=(float*)(shm+GATE_KM_OFF); unsigned*selS=(unsigned*)(shm+GATE_SEL_OFF)+slot*QB;
  if(qb>3){
    for(int i=tid;i<qb*64;i+=512)kmS[i]=KM[(size_t)((b*16+(i>>6))*512)+h*64+(i&63)];
    __syncthreads();
    const int row=tid>>1,half=tid&1;
    const bf16*qp=Q+((long)b*SEQ+qb*QB+row)*DM+h*D+half*32;
    float qv[32];
    #pragma unroll
    for(int c=0;c<4;++c){const u32x4 w=*reinterpret_cast<const u32x4*>(qp+c*8);
      #pragma unroll
      for(int e=0;e<4;++e){qv[c*8+2*e]=__uint_as_float(w[e]<<16);qv[c*8+2*e+1]=__uint_as_float(w[e]&0xffff0000u);}}
    float v0=-INFINITY,v1=-INFINITY,v2=-INFINITY;int i0=0,i1=0,i2=0;
    for(int n=0;n<qb;++n){const float*kr=kmS+n*64+half*32;float d=0.f;
      #pragma unroll
      for(int e=0;e<32;++e)d+=qv[e]*kr[e];
      d+=__shfl_xor(d,1);
      if(d>v0){v2=v1;i2=i1;v1=v0;i1=i0;v0=d;i0=n;}else if(d>v1){v2=v1;i2=i1;v1=d;i1=n;}else if(d>v2){v2=d;i2=n;}}
    if(half==0)selS[row]=(1u<<i0)|(1u<<i1)|(1u<<i2);
  }else{ if(tid<QB)selS[tid]=(1u<<qb)-1u; }
  __syncthreads();
}
struct AttnTensors { const bf16* Q; const bf16* K; const bf16* V; bf16* O; const float* KM; };
__device__ __forceinline__ void unit_of(int idx,int&b,int&h,int&qb){
  const int v=idx&255,i=idx>>8; const int bh=v>>2,s0=(v&3)*2; qb=(i==0)?s0:(i==1)?15-s0:(i==2)?s0+1:14-s0; b=bh/NHEAD; h=bh%NHEAD;
}
template<int THRL=8> __device__ __forceinline__ void attn_phase(char*lds,const AttnTensors&T,int G,int block){
  const int vcu=(G%8==0)?(block%8)*(G/8)+block/8:block;
  { int slot=0; for(int idx=vcu;idx<BATCH*NHEAD*NQB&&slot<GATE_MAXU;idx+=G,++slot){ int b,h,qb; unit_of(idx,b,h,qb); moba_gate(b,h,qb,T.Q,T.KM,lds,slot); } }
  const unsigned selS0=(unsigned)(uintptr_t)(lds+GATE_SEL_OFF);
  int slot=0;
  for(int idx=vcu;idx<BATCH*NHEAD*NQB;idx+=G,++slot){
    int b,h,qb; unit_of(idx,b,h,qb);
    attn_unit<THRL>(b,h,qb,selS0+(unsigned)slot*(QB*4),T.Q,T.K,T.V,T.O,lds);
  }
}
#undef SBAR
#undef WAIT_BAR
}
namespace mk {
using pg8::bf16_t; using pg8::bf16x8; using pg8::f32x4; using pg8::u32x4; using pg8::Unit; using pg8::cvt_pk_bf16;
typedef unsigned u32x2 __attribute__((ext_vector_type(2)));
constexpr int NB = 8, SEQ = 4096, DMODEL = 1024, T = NB * SEQ, FF = 2816, NIN = 5632, INW = 5640;
constexpr int ZP = 5632;
constexpr int ZC_Q = 0, ZC_K = 512, ZC_V = 1024, ZC_QKB = 1536, ZC_VB = 2560, ZC_OB = 3072, ZC_GA = 3584, ZC_GB = 4608;
constexpr float EPS = 1e-6f;
constexpr float C2 = 0.125f * 1.4426950408889634f;
constexpr size_t MiB = 1u << 20;
constexpr size_t WS_BAR = 0;
constexpr size_t WS_WIN = 2 * MiB, WS_WPA = 13 * MiB, WS_WPB = 14 * MiB, WS_WOUT = 15 * MiB;
constexpr size_t WS_R1 = 17 * MiB, WS_KMEAN = 17 * MiB + 128 * 1024, WS_MST = 17 * MiB + 384 * 1024, WS_MC = 17 * MiB + 400 * 1024;
constexpr size_t WS_ROPE = 18 * MiB, WS_GATES = 19 * MiB, WS_SS = 20 * MiB, WS_DN = 22 * MiB, WS_NST = 23 * MiB;
constexpr size_t WS_XB = 24 * MiB;
constexpr size_t WS_YA = 88 * MiB, WS_YB = 120 * MiB;
constexpr size_t WS_Z = 152 * MiB;
constexpr size_t WS_WGU = 328 * MiB + 152 * MiB - 152 * MiB, WS_WDN = 340 * MiB, WS_END = 504 * MiB;
static_assert(WS_Z + (size_t)T * ZP * 2 <= WS_END && WS_Z + (size_t)T * FF * 2 <= WS_WGU && WS_WGU + (size_t)NIN * 1024 * 2 <= WS_WDN && WS_WDN + (size_t)1024 * FF * 2 <= WS_END, "ws map");

struct Params {
    const float* x; const float* g_mix; const float* w_in; const float* conv_w; const float* b_i; const float* b_f; const float* g_ml;
    const float* w_pa; const float* w_pb; const float* w_out; const float* g_ffn; const float* w_gu; const float* w_dn; const float* g_fin;
    float* out; unsigned char* ws;
};

__device__ __forceinline__ float bf2f(unsigned short b) { return __uint_as_float(((unsigned)b) << 16); }
__device__ __forceinline__ unsigned short f2bf(float f) { unsigned u = __float_as_uint(f); return (unsigned short)((u + 0x7fffu + ((u >> 16) & 1u)) >> 16); }
typedef float f32x2_t __attribute__((ext_vector_type(2))); typedef __bf16 bf16x2_t __attribute__((ext_vector_type(2)));
__device__ __forceinline__ unsigned cvtpk_safe(float lo, float hi) { f32x2_t v = {lo, hi}; bf16x2_t b = __builtin_convertvector(v, bf16x2_t); return __builtin_bit_cast(unsigned, b); }
__device__ __forceinline__ float wave_sum(float v) {
#pragma unroll
    for (int o = 1; o < 64; o <<= 1) v += __shfl_xor(v, o);
    return v;
}
template <int CTRL> __device__ __forceinline__ float dpp_mov(float v) { return __int_as_float(__builtin_amdgcn_update_dpp(0, __float_as_int(v), CTRL, 0xf, 0xf, false)); }
__device__ __forceinline__ float row_sum16(float v) { v += dpp_mov<0x128>(v); v += dpp_mov<0x124>(v); v += dpp_mov<0x122>(v); v += dpp_mov<0x121>(v); return v; }
__device__ __forceinline__ float wave_max(float v) {
#pragma unroll
    for (int o = 1; o < 64; o <<= 1) v = fmaxf(v, __shfl_xor(v, o));
    return v;
}
__device__ __forceinline__ float sigmoidf_(float v) { return __builtin_amdgcn_rcpf(1.f + __expf(-v)); }
__device__ __forceinline__ float siluf_(float v) { return v * __builtin_amdgcn_rcpf(1.f + __expf(-v)); }
__device__ __forceinline__ float logsigmoidf_(float v) { return fminf(v, 0.f) - log1pf(__expf(-fabsf(v))); }
__device__ __forceinline__ void unpack8(const u32x4 w, float (&f)[8]) {
#pragma unroll
    for (int e = 0; e < 4; ++e) { f[2 * e] = __uint_as_float(w[e] << 16); f[2 * e + 1] = __uint_as_float(w[e] & 0xffff0000u); }
}

struct EpiInProj {
    static constexpr bool PERM = true, AFTER_DRAIN = false, MID = false;
    bf16_t* Z; const float* r1; const float* rope; float* kmean;
    __device__ __forceinline__ void operator()(const f32x4 (&acc)[2][2][4][2], const Unit& u, int wr, int wc, int fr, int fq) const {
        const int row0 = u.pm * 256 + wr * 64 + fr, pn = u.pn, col0 = pn * 256 + wc * 32 + 8 * fq;
        if (pn < 4) {
            const bool isK = pn >= 2; const float sc = isK ? 1.f : C2; const int jj = 4 * (wc & 1) + fq;
            f32x4 cs[2][2];
#pragma unroll
            for (int a = 0; a < 2; ++a)
#pragma unroll
                for (int b = 0; b < 2; ++b) cs[a][b] = (f32x4){0.f, 0.f, 0.f, 0.f};
#pragma unroll
            for (int ai = 0; ai < 2; ++ai)
#pragma unroll
                for (int m = 0; m < 4; ++m) {
                    const int row = row0 + ai * 128 + m * 16; const float rs = sc; const int pos = row & (SEQ - 1);
                    const f32x4 c4 = *(const f32x4*)(rope + (size_t)(pos * 8 + jj) * 8), s4 = *(const f32x4*)(rope + (size_t)(pos * 8 + jj) * 8 + 4);
                    bf16_t* rowp = Z + (size_t)row * ZP + col0;
#pragma unroll
                    for (int bj = 0; bj < 2; ++bj) {
                        const f32x4 v0 = acc[ai][bj][m][0] * rs, v1 = acc[ai][bj][m][1] * rs;
                        const f32x4 o0 = v0 * c4 - v1 * s4, o1 = v1 * c4 + v0 * s4;
                        cs[bj][0] += o0; cs[bj][1] += o1;
                        u32x4 w; w.x = cvt_pk_bf16(o0[0], o0[1]); w.y = cvt_pk_bf16(o0[2], o0[3]); w.z = cvt_pk_bf16(o1[0], o1[1]); w.w = cvt_pk_bf16(o1[2], o1[3]);
                        *(u32x4*)(rowp + bj * 128) = w;
                    }
                }
            if (isK) {
#pragma unroll
                for (int bj = 0; bj < 2; ++bj)
#pragma unroll
                    for (int n = 0; n < 2; ++n)
#pragma unroll
                        for (int i = 0; i < 4; ++i) {
                            float v = cs[bj][n][i];
                            v = row_sum16(v);
                            if (fr == 0) atomicAdd(kmean + (size_t)u.pm * 512 + (pn - 2) * 256 + bj * 128 + wc * 32 + 8 * fq + 4 * n + i, v);
                        }
            }
        } else if (pn < 14) {
            const bool sig = pn >= 12;
#pragma unroll
            for (int ai = 0; ai < 2; ++ai)
#pragma unroll
                for (int m = 0; m < 4; ++m) {
                    const int row = row0 + ai * 128 + m * 16;
                    bf16_t* rowp = Z + (size_t)row * ZP + col0;
#pragma unroll
                    for (int bj = 0; bj < 2; ++bj) {
                        f32x4 v0 = acc[ai][bj][m][0], v1 = acc[ai][bj][m][1];
                        if (sig) {
#pragma unroll
                            for (int i = 0; i < 4; ++i) { v0[i] = sigmoidf_(v0[i]); v1[i] = sigmoidf_(v1[i]); }
                        }
                        u32x4 w; w.x = cvt_pk_bf16(v0[0], v0[1]); w.y = cvt_pk_bf16(v0[2], v0[3]); w.z = cvt_pk_bf16(v1[0], v1[1]); w.w = cvt_pk_bf16(v1[2], v1[3]);
                        *(u32x4*)(rowp + bj * 128) = w;
                    }
                }
        } else {
            const int oc0 = 128 * (pn - 14) + 32 * wc + 8 * fq;
#pragma unroll
            for (int ai = 0; ai < 2; ++ai)
#pragma unroll
                for (int m = 0; m < 4; ++m) {
                    const int row = row0 + ai * 128 + m * 16; float r[8], sb[8];
#pragma unroll
                    for (int bj = 0; bj < 2; ++bj) { const f32x4 v0 = acc[ai][bj][m][0], v1 = acc[ai][bj][m][1];
#pragma unroll
                        for (int i = 0; i < 4; ++i) { const float ea = 1.f + __expf(-v0[i]), eb = 1.f + __expf(-v1[i]); sb[4 * bj + i] = __builtin_amdgcn_rcpf(eb); r[4 * bj + i] = eb * __builtin_amdgcn_rcpf(ea); } }
                    bf16_t* gp = Z + (size_t)row * ZP + ZC_GA + 128 * (oc0 >> 6) + (oc0 & 63);
                    u32x4 w0, w1; w0.x = cvt_pk_bf16(r[0], r[1]); w0.y = cvt_pk_bf16(r[2], r[3]); w0.z = cvt_pk_bf16(r[4], r[5]); w0.w = cvt_pk_bf16(r[6], r[7]);
                    w1.x = cvt_pk_bf16(sb[0], sb[1]); w1.y = cvt_pk_bf16(sb[2], sb[3]); w1.z = cvt_pk_bf16(sb[4], sb[5]); w1.w = cvt_pk_bf16(sb[6], sb[7]);
                    *(u32x4*)gp = w0; *(u32x4*)(gp + 64) = w1;
                }
        }
    }
};
struct EpiMerge {
    static constexpr bool PERM = true, AFTER_DRAIN = false, MID = true;
    const bf16_t* Zg; bf16_t* O;
    __device__ __forceinline__ void mid(f32x4 (&acc)[2][2][4][2], const Unit& u, int wr, int wc, int fr, int fq) const {
        int row0 = u.pm * 256 + wr * 64 + fr; asm volatile("" : "+v"(row0)); const int col0 = u.pn * 256 + wc * 32 + 8 * fq;
#pragma unroll
        for (int ai = 0; ai < 2; ++ai)
#pragma unroll
            for (int m = 0; m < 4; ++m) {
                const int row = row0 + ai * 128 + m * 16;
#pragma unroll
                for (int bj = 0; bj < 2; ++bj) {
                    const int c = col0 + bj * 128; float r[8]; unpack8(*(const u32x4*)(Zg + (size_t)row * ZP + 128 * (c >> 6) + (c & 63)), r);
#pragma unroll
                    for (int i = 0; i < 4; ++i) { acc[ai][bj][m][0][i] *= r[i]; acc[ai][bj][m][1][i] *= r[4 + i]; }
                }
            }
    }
    __device__ __forceinline__ void operator()(const f32x4 (&acc)[2][2][4][2], const Unit& u, int wr, int wc, int fr, int fq) const {
        const int row0 = u.pm * 256 + wr * 64 + fr, col0 = u.pn * 256 + wc * 32 + 8 * fq;
#pragma unroll
        for (int ai = 0; ai < 2; ++ai)
#pragma unroll
            for (int m = 0; m < 4; ++m) {
                const int row = row0 + ai * 128 + m * 16;
#pragma unroll
                for (int bj = 0; bj < 2; ++bj) {
                    const int c = col0 + bj * 128; float gb[8]; unpack8(*(const u32x4*)(Zg + (size_t)row * ZP + 128 * (c >> 6) + 64 + (c & 63)), gb);
                    const f32x4 v0 = acc[ai][bj][m][0], v1 = acc[ai][bj][m][1];
                    u32x4 w; w.x = cvt_pk_bf16(v0[0] * gb[0], v0[1] * gb[1]); w.y = cvt_pk_bf16(v0[2] * gb[2], v0[3] * gb[3]); w.z = cvt_pk_bf16(v1[0] * gb[4], v1[1] * gb[5]); w.w = cvt_pk_bf16(v1[2] * gb[6], v1[3] * gb[7]);
                    *(u32x4*)(O + (size_t)row * 1024 + col0 + bj * 128) = w;
                }
            }
    }
};
struct EpiOut {
    static constexpr bool PERM = true, AFTER_DRAIN = false, MID = false;
    const float* x; bf16_t* h1b; float* ss;
    __device__ __forceinline__ void operator()(const f32x4 (&acc)[2][2][4][2], const Unit& u, int wr, int wc, int fr, int fq) const {
        const int row0 = u.pm * 256 + wr * 64 + fr, col0 = u.pn * 256 + wc * 32 + 8 * fq;
#pragma unroll
        for (int ai = 0; ai < 2; ++ai)
#pragma unroll
            for (int m = 0; m < 4; ++m) {
                const int row = row0 + ai * 128 + m * 16; float s = 0.f;
#pragma unroll
                for (int bj = 0; bj < 2; ++bj) {
                    const size_t off = (size_t)row * 1024 + col0 + bj * 128;
                    const f32x4 a0 = *(const f32x4*)(x + off) + acc[ai][bj][m][0], a1 = *(const f32x4*)(x + off + 4) + acc[ai][bj][m][1];
                    s += (a0[0] * a0[0] + a0[1] * a0[1]) + (a0[2] * a0[2] + a0[3] * a0[3]) + (a1[0] * a1[0] + a1[1] * a1[1]) + (a1[2] * a1[2] + a1[3] * a1[3]);
                    u32x4 w; w.x = cvt_pk_bf16(a0[0], a0[1]); w.y = cvt_pk_bf16(a0[2], a0[3]); w.z = cvt_pk_bf16(a1[0], a1[1]); w.w = cvt_pk_bf16(a1[2], a1[3]);
                    *(u32x4*)(h1b + off) = w;
                }
                s += __shfl_xor(s, 16); s += __shfl_xor(s, 32);
                if (fq == 0) atomicAdd(ss + row, s);
            }
    }
};
struct EpiGateUp {
    static constexpr bool PERM = true, AFTER_DRAIN = false, MID = false;
    const float* ss; bf16_t* act;
    __device__ __forceinline__ void operator()(const f32x4 (&acc)[2][2][4][2], const Unit& u, int wr, int wc, int fr, int fq) const {
        const int row0 = u.pm * 256 + wr * 64 + fr, col0 = u.pn * 128 + wc * 32 + 8 * fq;
#pragma unroll
        for (int ai = 0; ai < 2; ++ai)
#pragma unroll
            for (int m = 0; m < 4; ++m) {
                const int row = row0 + ai * 128 + m * 16;
                const float rs = rsqrtf(ss[row] * (1.f / 1024.f) + EPS);
                float o[8];
#pragma unroll
                for (int bj = 0; bj < 2; ++bj) {
                    const f32x4 g = acc[ai][bj][m][0] * rs, up = acc[ai][bj][m][1] * rs;
#pragma unroll
                    for (int i = 0; i < 4; ++i) o[4 * bj + i] = siluf_(g[i]) * up[i];
                }
                u32x4 w; w.x = cvt_pk_bf16(o[0], o[1]); w.y = cvt_pk_bf16(o[2], o[3]); w.z = cvt_pk_bf16(o[4], o[5]); w.w = cvt_pk_bf16(o[6], o[7]);
                *(u32x4*)(act + (size_t)row * FF + col0) = w;
            }
    }
};
struct EpiDown {
    static constexpr bool PERM = true, AFTER_DRAIN = false, MID = false;
    const bf16_t* h1b; bf16_t* h2b;
    __device__ __forceinline__ void operator()(const f32x4 (&acc)[2][2][4][2], const Unit& u, int wr, int wc, int fr, int fq) const {
        const int row0 = u.pm * 256 + wr * 64 + fr, col0 = u.pn * 256 + wc * 32 + 8 * fq;
#pragma unroll
        for (int ai = 0; ai < 2; ++ai)
#pragma unroll
            for (int m = 0; m < 4; ++m) {
                const int row = row0 + ai * 128 + m * 16;
#pragma unroll
                for (int bj = 0; bj < 2; ++bj) {
                    const size_t off = (size_t)row * 1024 + col0 + bj * 128;
                    float r[8]; unpack8(*(const u32x4*)(h1b + off), r);
                    const f32x4 a0 = acc[ai][bj][m][0], a1 = acc[ai][bj][m][1];
                    u32x4 w; w.x = cvt_pk_bf16(r[0] + a0[0], r[1] + a0[1]); w.y = cvt_pk_bf16(r[2] + a0[2], r[3] + a0[3]); w.z = cvt_pk_bf16(r[4] + a1[0], r[5] + a1[1]); w.w = cvt_pk_bf16(r[6] + a1[2], r[7] + a1[3]);
                    *(u32x4*)(h2b + off) = w;
                }
            }
    }
};
}
namespace mk {
#define LAS __attribute__((address_space(3)))
constexpr int NTHR = 512, RING_BYTES = 131072, LDS_BYTES = 147456;

__device__ __forceinline__ int srccol_in(int n) {
    if (n < 1024) { const int hd = n >> 6, p = n & 63, j = p >> 3, i = p & 7; return (hd << 6) + ((i < 4) ? 4 * j + i : 32 + 4 * j + (i - 4)); }
    if (n < 3584) return n;
    { const int q = n - 3584, t = q >> 8, bj = (q >> 7) & 1, wc = (q >> 5) & 3, fq = (q >> 3) & 3, nn = (q >> 2) & 1, i = q & 3; const int oc = 128 * t + 32 * wc + 8 * fq + 4 * bj + i; return nn ? 4616 + oc : 3592 + oc; }
}
__device__ __forceinline__ int srccol_gu(int n) { const int pn = n >> 8, bj = (n >> 7) & 1, wc = (n >> 5) & 3, fq = (n >> 3) & 3, nn = (n >> 2) & 1, i = n & 3; const int oc = 128 * pn + 32 * wc + 8 * fq + 4 * bj + i; return nn ? FF + oc : oc; }
template <int MODE> __device__ __forceinline__ void tr_item(const float* W, int K, int Nsrc, int Ndst, const float* gain, bf16_t* WT, float* scr, int item, int lane, int Kp = 0, int koff = 0) {
    if (Kp == 0) Kp = K;
    const int nblk = Ndst / 32, kb = item / nblk, nb = item % nblk, k0 = 64 * kb, n0 = 32 * nb;
    const int nd = n0 + (lane & 31); const int sc = MODE == 1 ? srccol_in(nd) : MODE == 2 ? srccol_gu(nd) : nd;
#pragma unroll
    for (int i = 0; i < 32; ++i) { const int kk = 2 * i + (lane >> 5); float v = W[(size_t)(k0 + kk) * Nsrc + sc]; if (gain) v *= gain[k0 + kk]; scr[kk * 33 + (lane & 31)] = v; }
    asm volatile("s_waitcnt lgkmcnt(0)" ::: "memory");
    const int c = lane & 7;
#pragma unroll
    for (int j = 0; j < 4; ++j) { const int n = (lane >> 3) + 8 * j; const float* s = scr + (8 * c) * 33 + n;
        u32x4 o; o.x = cvt_pk_bf16(s[0 * 33], s[1 * 33]); o.y = cvt_pk_bf16(s[2 * 33], s[3 * 33]); o.z = cvt_pk_bf16(s[4 * 33], s[5 * 33]); o.w = cvt_pk_bf16(s[6 * 33], s[7 * 33]);
        *(u32x4*)(WT + (size_t)(n0 + n) * Kp + koff + k0 + 8 * c) = o; }
    asm volatile("s_waitcnt lgkmcnt(0)" ::: "memory");
}

__device__ __forceinline__ void p0_prologue(const Params& p, unsigned char* lds, int G) {
    int tid_ = threadIdx.x; asm volatile("" : "+v"(tid_));
    const int tid = tid_, lane = tid & 63, wave = tid >> 6;
    const int gw = blockIdx.x * 8 + wave, NGW = G * 8, gt = blockIdx.x * NTHR + tid, NGT = G * NTHR;
    unsigned char* ws = p.ws;
    float* scr = (float*)(lds + wave * 8704);
    float* GW = (float*)(lds + 73728);
    for (int i = tid; i < 8192; i += NTHR) { const int k = i >> 3, c = i & 7; const int slot = (((k >> 8) * 4 + (k & 3)) * 64 + ((k >> 2) & 63)); GW[slot * 8 + c] = p.w_in[(size_t)k * INW + 3584 + c] * p.g_mix[k]; }
    { float* km = (float*)(ws + WS_KMEAN); for (int i = gt; i < NB * 16 * 512; i += NGT) km[i] = 0.f; }
    { float* r2 = (float*)(ws + WS_R1); for (int i = gt; i < T; i += NGT) r2[i] = 0.f; }
    { float* rt = (float*)(ws + WS_ROPE);
      for (int i = gt; i < SEQ * 32; i += NGT) { const int pos = i >> 5, d = i & 31; const float inv = powf(10000.f, -(float)d / 32.f); const float ang = (float)pos * inv; float s, c; sincosf(ang, &s, &c);
          const int j = d >> 2, ii = d & 3; rt[(size_t)(pos * 8 + j) * 8 + ii] = c; rt[(size_t)(pos * 8 + j) * 8 + 4 + ii] = s; } }
    { constexpr int I_IN = 16 * (NIN / 32), I_PA = 8 * 32, I_PB = 8 * 32, I_OUT = 16 * 32; constexpr int NITEMS = I_IN + I_PA + I_PB + I_OUT;
      for (int it = gw; it < NITEMS; it += NGW) { int r = it;
          if (r < I_IN) { tr_item<1>(p.w_in, 1024, INW, NIN, p.g_mix, (bf16_t*)(ws + WS_WIN), scr, r, lane); continue; } r -= I_IN;
          if (r < I_PA) { tr_item<0>(p.w_pa, 512, 1024, 1024, nullptr, (bf16_t*)(ws + WS_WPA), scr, r, lane, 1024, 0); continue; } r -= I_PA;
          if (r < I_PB) { tr_item<0>(p.w_pb, 512, 1024, 1024, nullptr, (bf16_t*)(ws + WS_WPA), scr, r, lane, 1024, 512); continue; } r -= I_PB;
          tr_item<0>(p.w_out, 1024, 1024, 1024, nullptr, (bf16_t*)(ws + WS_WOUT), scr, r, lane); } }
    __syncthreads();
    { bf16_t* XB = (bf16_t*)(ws + WS_XB); float* R1 = (float*)(ws + WS_R1); float* GT = (float*)(ws + WS_GATES);
      const int qsel = (lane >> 1) & 31, csel = qsel & 7; const float bias = csel < 4 ? p.b_i[csel] : p.b_f[csel - 4];
      for (int rb = gw * 16; rb < T; rb += NGW * 16) {
        for (int r4 = 0; r4 < 16; r4 += 4) {
          const int row = rb + r4;
          f32x4 v[4][4]; float ssq[4];
#pragma unroll
          for (int r = 0; r < 4; ++r) { const f32x4* xr = (const f32x4*)(p.x + (size_t)(row + r) * 1024) + lane;
#pragma unroll
              for (int j = 0; j < 4; ++j) v[r][j] = xr[64 * j]; }
          float acc[32];
#pragma unroll
          for (int q = 0; q < 32; ++q) acc[q] = 0.f;
#pragma unroll
          for (int r = 0; r < 4; ++r) { float s = 0.f;
#pragma unroll
              for (int j = 0; j < 4; ++j) s += (v[r][j][0] * v[r][j][0] + v[r][j][1] * v[r][j][1]) + (v[r][j][2] * v[r][j][2] + v[r][j][3] * v[r][j][3]);
              ssq[r] = s; }
#pragma unroll
          for (int j = 0; j < 4; ++j)
#pragma unroll
              for (int i = 0; i < 4; ++i) { const f32x4* gwp = (const f32x4*)(GW + (size_t)((j * 4 + i) * 64 + lane) * 8); const f32x4 g0 = gwp[0], g1 = gwp[1];
#pragma unroll
                  for (int r = 0; r < 4; ++r) { const float xv = v[r][j][i];
#pragma unroll
                      for (int c = 0; c < 4; ++c) { acc[r * 8 + c] += g0[c] * xv; acc[r * 8 + 4 + c] += g1[c] * xv; } } }
#pragma unroll
          for (int r = 0; r < 4; ++r) { ssq[r] = wave_sum(ssq[r]); const float rs = rsqrtf(ssq[r] * (1.f / 1024.f) + EPS); u32x2* o8 = (u32x2*)(XB + (size_t)(row + r) * 1024) + lane;
#pragma unroll
              for (int j = 0; j < 4; ++j) { const f32x4 xs = v[r][j] * rs; u32x2 w; w.x = cvt_pk_bf16(xs[0], xs[1]); w.y = cvt_pk_bf16(xs[2], xs[3]); o8[64 * j] = w; } }
#pragma unroll
          for (int st = 0; st < 5; ++st) { const int M = 32 >> st, n2 = 16 >> st; const bool up = (lane & M) != 0;
#pragma unroll
              for (int i = 0; i < n2; ++i) { const float lo = acc[i], hi = acc[i + n2]; const float send = up ? lo : hi, keep = up ? hi : lo; acc[i] = keep + __shfl_xor(send, M); } }
          const float tot = acc[0] + __shfl_xor(acc[0], 1);
          const int rsel = qsel >> 3; const float ss = rsel == 0 ? ssq[0] : rsel == 1 ? ssq[1] : rsel == 2 ? ssq[2] : ssq[3];
          const float rstd = rsqrtf(ss * (1.f / 1024.f) + EPS);
          if ((lane & 1) == 0) GT[(size_t)(row + rsel) * 8 + csel] = tot * rstd + bias;
        } } }
}
__device__ __forceinline__ void p4_weights(const Params& p, unsigned char* lds, int G) {
    int tid_ = threadIdx.x; asm volatile("" : "+v"(tid_));
    const int tid = tid_, lane = tid & 63, wave = tid >> 6; const int gw = blockIdx.x * 8 + wave, NGW = G * 8;
    float* scr = (float*)(lds + wave * 8704);
    constexpr int I_GU = 16 * (NIN / 32), I_DN = (FF / 64) * 32;
    for (int it = gw; it < I_GU + I_DN; it += NGW) {
        if (it < I_GU) tr_item<2>(p.w_gu, 1024, 2 * FF, NIN, p.g_ffn, (bf16_t*)(p.ws + WS_WGU), scr, it, lane);
        else tr_item<0>(p.w_dn, FF, 1024, 1024, nullptr, (bf16_t*)(p.ws + WS_WDN), scr, it - I_GU, lane);
    }
    __syncthreads();
}

template <int CTRL, int RMASK> __device__ __forceinline__ float dpp_or(float oldv, float v) { return __int_as_float(__builtin_amdgcn_update_dpp(__float_as_int(oldv), __float_as_int(v), CTRL, RMASK, 0xf, false)); }
__device__ __forceinline__ float wave_incl_sum(float v, int) {
    v += dpp_or<0x111, 0xf>(0.f, v); v += dpp_or<0x112, 0xf>(0.f, v); v += dpp_or<0x114, 0xf>(0.f, v); v += dpp_or<0x118, 0xf>(0.f, v);
    v += dpp_or<0x142, 0xa>(0.f, v); v += dpp_or<0x143, 0xc>(0.f, v);
    return v;
}
__device__ __forceinline__ float wave_incl_max(float v, int) {
    const float ninf = -INFINITY;
    v = fmaxf(v, dpp_or<0x111, 0xf>(ninf, v)); v = fmaxf(v, dpp_or<0x112, 0xf>(ninf, v)); v = fmaxf(v, dpp_or<0x114, 0xf>(ninf, v)); v = fmaxf(v, dpp_or<0x118, 0xf>(ninf, v));
    v = fmaxf(v, dpp_or<0x142, 0xa>(ninf, v)); v = fmaxf(v, dpp_or<0x143, 0xc>(ninf, v));
    return v;
}
__device__ __forceinline__ void conv2x8r(const u32x4 (&xr)[5], const float* cw, float (&y)[2][8]) {
#pragma unroll
    for (int hf = 0; hf < 2; ++hf) {
        f32x4 wj[4];
#pragma unroll
        for (int j = 0; j < 4; ++j) wj[j] = *(const f32x4*)(cw + j * 1024 + 4 * hf);
        f32x4 x[5];
#pragma unroll
        for (int i = 0; i < 5; ++i) { const unsigned a = xr[i][2 * hf], b = xr[i][2 * hf + 1]; x[i] = (f32x4){__uint_as_float(a << 16), __uint_as_float(a & 0xffff0000u), __uint_as_float(b << 16), __uint_as_float(b & 0xffff0000u)}; }
#pragma unroll
        for (int r = 0; r < 2; ++r) { const f32x4 z = wj[0] * x[r] + wj[1] * x[r + 1] + wj[2] * x[r + 2] + wj[3] * x[r + 3];
#pragma unroll
            for (int i = 0; i < 4; ++i) y[r][4 * hf + i] = siluf_(z[i]); }
    }
}
__device__ __forceinline__ void load5(const bf16_t* src, int c, int t, u32x4 (&xr)[5]) {
#pragma unroll
    for (int i = 0; i < 5; ++i) { const int tt = t - 3 + i; const bool ok = (c > 0) | (tt >= 0); const u32x4 w = *(const u32x4*)(src + (long)(ok ? tt : 0) * ZP); xr[i] = ok ? w : (u32x4){0u, 0u, 0u, 0u}; }
}
constexpr float KSCALE = 0.08838834764831845f;

struct M1Pre { u32x4 k[5], v[2]; float li, fp; };
__device__ __forceinline__ void m1_issue(const Params& p, int u, int tid, M1Pre& q) {
    const int lane = tid & 63, bh = u >> 6, c = u & 63, b = bh >> 2, h = bh & 3; const size_t row0 = (size_t)b * SEQ + c * 64;
    const bf16_t* Z = (const bf16_t*)(p.ws + WS_Z); const int d0 = (tid & 15) * 8, t = 2 * (tid >> 4);
    load5(Z + row0 * ZP + ZC_QKB + 512 + h * 128 + d0, c, t, q.k);
    const bf16_t* vs = Z + row0 * ZP + ZC_VB + h * 128 + d0; q.v[0] = *(const u32x4*)(vs + (long)t * ZP); q.v[1] = *(const u32x4*)(vs + (long)(t + 1) * ZP);
    const float* gp = (const float*)(p.ws + WS_GATES) + (row0 + lane) * 8; q.li = gp[h]; q.fp = gp[4 + h];
}
__device__ __forceinline__ void m1_compute(const Params& p, unsigned char* lds, int u, int tid_in, const M1Pre& q) {
    int tid = tid_in; asm volatile("" : "+v"(tid));
    const int lane = tid & 63, wid = tid >> 6;
    const int bh = u >> 6, h = bh & 3;
    bf16_t* KT = (bf16_t*)lds; bf16_t* VT = KT + 128 * 72; float* wS = (float*)(VT + 128 * 72); float* dnp = wS + 64;
    if (wid == 0) {
        const float li = q.li, lf = logsigmoidf_(q.fp);
        const float bcs = wave_incl_sum(lf, lane), btot = __shfl(bcs, 63);
        const float g = btot - bcs + li, gm = wave_max(g);
        wS[lane] = __expf(g - gm);
        if (lane == 0) { float* mst = (float*)(p.ws + WS_MST); mst[u * 2] = btot; mst[u * 2 + 1] = gm; }
    }
    const int d0 = (tid & 15) * 8, rg = tid >> 4, t = 2 * rg;
    float y[2][8];
    conv2x8r(q.k, (const float*)(lds + 65536) + 512 + h * 128 + d0, y);
    float vv[2][8]; unpack8(q.v[0], vv[0]); unpack8(q.v[1], vv[1]);
    __syncthreads();
    { const float w0 = KSCALE * wS[t], w1 = KSCALE * wS[t + 1];
#pragma unroll
      for (int i = 0; i < 8; ++i) { const float a = y[0][i] * w0, bq = y[1][i] * w1;
          *(unsigned*)(KT + (d0 + i) * 72 + t) = cvt_pk_bf16(a, bq); dnp[rg * 128 + d0 + i] = a + bq;
          *(unsigned*)(VT + (d0 + i) * 72 + t) = cvt_pk_bf16(vv[0][i], vv[1][i]); } }
    __syncthreads();
    if (tid < 128) { float s = 0.f;
#pragma unroll
        for (int r = 0; r < 32; ++r) s += dnp[r * 128 + tid];
        ((float*)(p.ws + WS_DN))[(size_t)u * 128 + tid] = s; }
    bf16_t* DT = (bf16_t*)(lds + 81920);
    { const int fr = lane & 15, fq = lane >> 4;
      const bf16x8 a0 = *(const bf16x8*)(KT + (16 * wid + fr) * 72 + fq * 8), a1 = *(const bf16x8*)(KT + (16 * wid + fr) * 72 + 32 + fq * 8);
#pragma unroll
      for (int et = 0; et < 8; ++et) {
          const bf16x8 b0 = *(const bf16x8*)(VT + (16 * et + fr) * 72 + fq * 8), b1 = *(const bf16x8*)(VT + (16 * et + fr) * 72 + 32 + fq * 8);
          f32x4 acc = (f32x4){0.f, 0.f, 0.f, 0.f};
          acc = __builtin_amdgcn_mfma_f32_16x16x32_bf16(a0, b0, acc, 0, 0, 0); acc = __builtin_amdgcn_mfma_f32_16x16x32_bf16(a1, b1, acc, 0, 0, 0);
          u32x2 w; w.x = cvtpk_safe(acc[0], acc[1]); w.y = cvtpk_safe(acc[2], acc[3]);
          *(u32x2*)(DT + (16 * et + fr) * 136 + 16 * wid + fq * 4) = w;
      } }
    __syncthreads();
    { bf16_t* DC = (bf16_t*)p.out + (size_t)u * 16384;
#pragma unroll
      for (int i = 0; i < 4; ++i) { const int ch = tid + NTHR * i, e = ch >> 4, part = ch & 15; *(u32x4*)(DC + e * 128 + part * 8) = *(const u32x4*)(DT + e * 136 + part * 8); } }
}
__device__ __forceinline__ void m1_phase(const Params& p, unsigned char* lds, int G) {
    int tid_ = threadIdx.x; asm volatile("" : "+v"(tid_)); const int tid = tid_;
    int u = blockIdx.x; if (u >= 2048) return;
    { float* cwS = (float*)(lds + 65536); for (int i = tid; i < 1024; i += NTHR) *(f32x4*)(cwS + 4 * i) = *(const f32x4*)(p.conv_w + 4 * i); }
    M1Pre cur; m1_issue(p, u, tid, cur);
    __syncthreads();
    for (;;) {
        const int un = u + G; const bool more = un < 2048; M1Pre nxt = cur;
        if (more) m1_issue(p, un, tid, nxt);
        __builtin_amdgcn_sched_barrier(0);
        m1_compute(p, lds, u, tid, cur);
        if (!more) break;
        cur = nxt; u = un;
    }
}
__device__ __forceinline__ void m2_scan(const Params& p, int G) {
    const int gt = blockIdx.x * NTHR + threadIdx.x, NGT = G * NTHR;
    const float* mst = (const float*)(p.ws + WS_MST); float* MC = (float*)(p.ws + WS_MC);
    const bf16_t* DC = (const bf16_t*)p.out; const float* DN = (const float*)(p.ws + WS_DN); float* NST = (float*)(p.ws + WS_NST); bf16_t* CST = (bf16_t*)(p.ws + WS_XB);
    for (int item = gt; item < 32 * 4096; item += NGT) {
        const int bh = item >> 12, vi = item & 4095; const bool hasn = (vi & 127) == 0; const int nv = vi >> 7;
        float m = 0.f; f32x4 S = (f32x4){0.f, 0.f, 0.f, 0.f}, Sn = (f32x4){0.f, 0.f, 0.f, 0.f};
        for (int c0 = 0; c0 < 64; c0 += 8) {
            f32x4 dv[8], dn[8]; float bt[8], gmv[8];
#pragma unroll
            for (int k = 0; k < 8; ++k) { const int u = bh * 64 + c0 + k;
                const u32x2 w = *(const u32x2*)(DC + (size_t)u * 16384 + vi * 4); dv[k] = (f32x4){__uint_as_float(w.x << 16), __uint_as_float(w.x & 0xffff0000u), __uint_as_float(w.y << 16), __uint_as_float(w.y & 0xffff0000u)};
                dn[k] = (f32x4){0.f, 0.f, 0.f, 0.f}; if (hasn) dn[k] = *(const f32x4*)(DN + (size_t)u * 128 + nv * 4);
                bt[k] = mst[u * 2]; gmv[k] = mst[u * 2 + 1]; }
#pragma unroll
            for (int k = 0; k < 8; ++k) { const int u = bh * 64 + c0 + k;
                { u32x2 w; w.x = cvt_pk_bf16(S[0], S[1]); w.y = cvt_pk_bf16(S[2], S[3]); *(u32x2*)(CST + (size_t)u * 16384 + vi * 4) = w; }
                if (hasn) *(f32x4*)(NST + (size_t)u * 128 + nv * 4) = Sn;
                if (vi == 0) MC[u] = m;
                const float mn = fmaxf(bt[k] + m, gmv[k]), a = __expf(bt[k] + m - mn), dd = __expf(gmv[k] - mn);
                S = S * a + dv[k] * dd; Sn = Sn * a + dn[k] * dd; m = mn; }
        }
    }
}
struct M3Pre { u32x4 q[5], k[5]; float li, fp, mc, nv; };
__device__ __forceinline__ void m3_issue(const Params& p, int u, int tid, M3Pre& q) {
    const int lane = tid & 63, bh = u >> 6, c = u & 63, b = bh >> 2, h = bh & 3; const size_t row0 = (size_t)b * SEQ + c * 64;
    const bf16_t* Z = (const bf16_t*)(p.ws + WS_Z); const int d0 = (tid & 15) * 8, t = 2 * (tid >> 4);
    load5(Z + row0 * ZP + ZC_QKB + h * 128 + d0, c, t, q.q);
    load5(Z + row0 * ZP + ZC_QKB + 512 + h * 128 + d0, c, t, q.k);
    const float* gp = (const float*)(p.ws + WS_GATES) + (row0 + lane) * 8; q.li = gp[h]; q.fp = gp[4 + h];
    q.mc = ((const float*)(p.ws + WS_MC))[u]; q.nv = ((const float*)(p.ws + WS_NST))[(size_t)u * 128 + (tid & 127)];
}
__device__ __forceinline__ void m3_compute(const Params& p, unsigned char* lds, int u, int tid_in, const M3Pre& pre, const u32x4 (&vin)[2], const u32x4 (&cin)[4], float gn) {
    int tid = tid_in; asm volatile("" : "+v"(tid));
    const int lane = tid & 63, wid = tid >> 6, fr = lane & 15, fq = lane >> 4;
    const int bh = u >> 6, c = u & 63, b = bh >> 2, h = bh & 3; const size_t row0 = (size_t)b * SEQ + c * 64;
    bf16_t* QS = (bf16_t*)lds; bf16_t* KS = (bf16_t*)(lds + 17408); bf16_t* VT = (bf16_t*)(lds + 34816); bf16_t* CT = (bf16_t*)(lds + 53248); bf16_t* SC = (bf16_t*)(lds + 88064);
    float* fb = (float*)(lds + 97280); float* bS = fb; float* aS = fb + 64; float* mT = fb + 128; float* wI = fb + 192; float* qn = fb + 256; float* denP = fb + 320; float* nS = fb + 576; float* hsq = fb + 704;
    if (wid == 0) {
        const float li = pre.li, lf = logsigmoidf_(pre.fp);
        const float bcs = wave_incl_sum(lf, lane); const float a = li - bcs; const float pm = wave_incl_max(a, lane);
        const float mc = pre.mc; const float mt = bcs + fmaxf(mc, pm);
        bS[lane] = bcs; aS[lane] = a; mT[lane] = mt; wI[lane] = __expf(bcs + mc - mt);
    }
    { const int d0 = (tid & 15) * 8, rg = tid >> 4, t = 2 * rg; float y[2][8];
      conv2x8r(pre.q, (const float*)(lds + 102400) + h * 128 + d0, y);
#pragma unroll
      for (int r = 0; r < 2; ++r) { u32x4 w; w.x = cvt_pk_bf16(y[r][0], y[r][1]); w.y = cvt_pk_bf16(y[r][2], y[r][3]); w.z = cvt_pk_bf16(y[r][4], y[r][5]); w.w = cvt_pk_bf16(y[r][6], y[r][7]); *(u32x4*)(QS + (t + r) * 136 + d0) = w; }
      conv2x8r(pre.k, (const float*)(lds + 102400) + 512 + h * 128 + d0, y);
#pragma unroll
      for (int r = 0; r < 2; ++r) { u32x4 w; w.x = cvt_pk_bf16(y[r][0] * KSCALE, y[r][1] * KSCALE); w.y = cvt_pk_bf16(y[r][2] * KSCALE, y[r][3] * KSCALE); w.z = cvt_pk_bf16(y[r][4] * KSCALE, y[r][5] * KSCALE); w.w = cvt_pk_bf16(y[r][6] * KSCALE, y[r][7] * KSCALE); *(u32x4*)(KS + (t + r) * 136 + d0) = w; }
      if (tid < 128) nS[tid] = pre.nv; }
    __syncthreads();
    { const int tr = wid >> 1;
#pragma unroll
      for (int tci = 0; tci < 2; ++tci) { const int tc = 2 * (wid & 1) + tci;
          f32x4 acc = (f32x4){0.f, 0.f, 0.f, 0.f};
          if (tc <= tr) {
#pragma unroll
              for (int ks = 0; ks < 4; ++ks) { const bf16x8 a = *(const bf16x8*)(QS + (16 * tr + fr) * 136 + ks * 32 + fq * 8), bb = *(const bf16x8*)(KS + (16 * tc + fr) * 136 + ks * 32 + fq * 8);
                  acc = __builtin_amdgcn_mfma_f32_16x16x32_bf16(a, bb, acc, 0, 0, 0); } }
          const int s = 16 * tc + fr; const float as = aS[s]; const int t0 = 16 * tr + fq * 4;
          const f32x4 bt4 = *(const f32x4*)(bS + t0), mt4 = *(const f32x4*)(mT + t0);
          float val[4];
#pragma unroll
          for (int j = 0; j < 4; ++j) { const float e = __expf(fminf(bt4[j] + as - mt4[j], 0.f)); const float x = acc[j] * e; val[j] = (tc <= tr && s <= t0 + j) ? x : 0.f; }
#pragma unroll
          for (int j = 0; j < 4; ++j) SC[(t0 + j) * 72 + s] = f2bf(val[j]);
#pragma unroll
          for (int j = 0; j < 4; ++j) val[j] = row_sum16(val[j]);
          if (fr == 0) {
#pragma unroll
              for (int j = 0; j < 4; ++j) denP[(t0 + j) * 4 + tc] = val[j]; } }
      { const int t = tid >> 3, part = tid & 7; float dot = 0.f;
#pragma unroll
        for (int i = 0; i < 16; ++i) dot += bf2f(QS[t * 136 + 16 * part + i]) * nS[16 * part + i];
        dot += __shfl_xor(dot, 1); dot += __shfl_xor(dot, 2); dot += __shfl_xor(dot, 4);
        if (part == 0) qn[t] = dot; }
      { const int d0 = (tid & 15) * 8, t = 2 * (tid >> 4); const u32x4 va = vin[0], vb = vin[1];
#pragma unroll
        for (int i = 0; i < 4; ++i) { *(unsigned*)(VT + (d0 + 2 * i) * 72 + t) = (va[i] & 0xffffu) | (vb[i] << 16); *(unsigned*)(VT + (d0 + 2 * i + 1) * 72 + t) = (va[i] >> 16) | (vb[i] & 0xffff0000u); }
#pragma unroll
        for (int i = 0; i < 4; ++i) { const int ch = tid + NTHR * i, e = ch >> 4, part = ch & 15; *(u32x4*)(CT + e * 136 + part * 8) = cin[i]; } } }
    u32x4 sob[2];
    { const bf16_t* Zo = (const bf16_t*)(p.ws + WS_Z) + ZC_OB + h * 128;
#pragma unroll
      for (int i = 0; i < 2; ++i) { const int id = tid + NTHR * i; sob[i] = *(const u32x4*)(Zo + (row0 + (id >> 4)) * ZP + (id & 15) * 8); } }
    __syncthreads();
    f32x4 hv[4];
    { f32x4 acc1[4], acc2[4];
#pragma unroll
      for (int tt = 0; tt < 4; ++tt) { acc1[tt] = (f32x4){0.f, 0.f, 0.f, 0.f}; acc2[tt] = (f32x4){0.f, 0.f, 0.f, 0.f}; }
#pragma unroll
      for (int ks = 0; ks < 2; ++ks) { const bf16x8 bv = *(const bf16x8*)(VT + (16 * wid + fr) * 72 + ks * 32 + fq * 8);
#pragma unroll
          for (int tt = 0; tt < 4; ++tt) { const bf16x8 a = *(const bf16x8*)(SC + (16 * tt + fr) * 72 + ks * 32 + fq * 8); acc1[tt] = __builtin_amdgcn_mfma_f32_16x16x32_bf16(a, bv, acc1[tt], 0, 0, 0); } }
#pragma unroll
      for (int ks = 0; ks < 4; ++ks) { const bf16x8 bc = *(const bf16x8*)(CT + (16 * wid + fr) * 136 + ks * 32 + fq * 8);
#pragma unroll
          for (int tt = 0; tt < 4; ++tt) { const bf16x8 a = *(const bf16x8*)(QS + (16 * tt + fr) * 136 + ks * 32 + fq * 8); acc2[tt] = __builtin_amdgcn_mfma_f32_16x16x32_bf16(a, bc, acc2[tt], 0, 0, 0); } }
#pragma unroll
      for (int tt = 0; tt < 4; ++tt) { const int t0 = 16 * tt + fq * 4;
          const f32x4 wi4 = *(const f32x4*)(wI + t0), qn4 = *(const f32x4*)(qn + t0), mt4 = *(const f32x4*)(mT + t0);
          f32x4 sq4;
#pragma unroll
          for (int j = 0; j < 4; ++j) { const f32x4 d4 = *(const f32x4*)(denP + (t0 + j) * 4);
              const float num = acc1[tt][j] + wi4[j] * acc2[tt][j];
              const float den = (d4[0] + d4[1]) + (d4[2] + d4[3]) + wi4[j] * qn4[j];
              const float hval = num * __builtin_amdgcn_rcpf(fmaxf(fabsf(den), __expf(-mt4[j]))); hv[tt][j] = hval;
              sq4[j] = row_sum16(hval * hval); }
          if (fr == 0) {
#pragma unroll
              for (int j = 0; j < 4; ++j) hsq[(t0 + j) * 8 + wid] = sq4[j]; } } }
    __syncthreads();
    { float* OT = (float*)(lds + 53248);
#pragma unroll
      for (int tt = 0; tt < 4; ++tt)
#pragma unroll
          for (int j = 0; j < 4; ++j) { const int t = 16 * tt + fq * 4 + j; const f32x4* hp = (const f32x4*)(hsq + t * 8); const f32x4 s4 = hp[0] + hp[1];
              const float rstd = rsqrtf(((s4[0] + s4[1]) + (s4[2] + s4[3])) * (1.f / 128.f) + EPS);
              OT[t * 132 + 16 * wid + fr] = hv[tt][j] * rstd; } }
    __syncthreads();
    { const float* OT = (const float*)(lds + 53248); bf16_t* YB = (bf16_t*)(p.ws + WS_YA) + 512 + h * 128;
#pragma unroll
      for (int i = 0; i < 2; ++i) { const int id = tid + NTHR * i, t = id >> 4, e0 = (id & 15) * 8;
          const f32x4 h0 = *(const f32x4*)(OT + t * 132 + e0), h1 = *(const f32x4*)(OT + t * 132 + e0 + 4);
          const f32x4 g0 = *(const f32x4*)(p.g_ml + h * 128 + e0), g1 = *(const f32x4*)(p.g_ml + h * 128 + e0 + 4);
          float so[8]; unpack8(sob[i], so);
          u32x4 w; w.x = cvt_pk_bf16(h0[0] * g0[0] * so[0], h0[1] * g0[1] * so[1]); w.y = cvt_pk_bf16(h0[2] * g0[2] * so[2], h0[3] * g0[3] * so[3]);
          w.z = cvt_pk_bf16(h1[0] * g1[0] * so[4], h1[1] * g1[1] * so[5]); w.w = cvt_pk_bf16(h1[2] * g1[2] * so[6], h1[3] * g1[3] * so[7]);
          *(u32x4*)(YB + (row0 + t) * 1024 + e0) = w; } }
}
__device__ __forceinline__ void m3_phase(const Params& p, unsigned char* lds, int G) {
    int tid_ = threadIdx.x; asm volatile("" : "+v"(tid_)); const int tid = tid_;
    const int lane = tid & 63, wid = tid >> 6, fr = lane & 15, fq = lane >> 4;
    int u = blockIdx.x; if (u >= 2048) return;
    const bf16_t* Z = (const bf16_t*)(p.ws + WS_Z);
    { float* cwS = (float*)(lds + 102400); for (int i = tid; i < 1024; i += NTHR) *(f32x4*)(cwS + 4 * i) = *(const f32x4*)(p.conv_w + 4 * i); }
    M3Pre cur; m3_issue(p, u, tid, cur);
    __syncthreads();
    for (;;) {
        const int bh = u >> 6, c = u & 63, b = bh >> 2, h = bh & 3; const size_t row0 = (size_t)b * SEQ + c * 64;
        u32x4 vin[2], cin[4];
        { const int d0 = (tid & 15) * 8, t = 2 * (tid >> 4); const bf16_t* vs = Z + row0 * ZP + ZC_VB + h * 128 + d0; vin[0] = *(const u32x4*)(vs + (long)t * ZP); vin[1] = *(const u32x4*)(vs + (long)(t + 1) * ZP);
          const bf16_t* CST = (const bf16_t*)(p.ws + WS_XB) + (size_t)u * 16384;
#pragma unroll
          for (int i = 0; i < 4; ++i) { const int ch = tid + NTHR * i, e = ch >> 4, part = ch & 15; cin[i] = *(const u32x4*)(CST + e * 128 + part * 8); } }
        const float gn = p.g_ml[h * 128 + 16 * wid + fr];
        const int un = u + G; const bool more = un < 2048; M3Pre nxt = cur;
        if (more) m3_issue(p, un, tid, nxt);
        __builtin_amdgcn_sched_barrier(0);
        m3_compute(p, lds, u, tid, cur, vin, cin, gn);
        if (!more) break;
        cur = nxt; u = un;
    }
}
__device__ __forceinline__ void p7_final(const Params& p, int G) {
    const int lane = threadIdx.x & 63, gw = blockIdx.x * 8 + (threadIdx.x >> 6), NGW = G * 8;
    const bf16_t* H2B = (const bf16_t*)(p.ws + WS_XB);
    f32x4 g4[4];
#pragma unroll
    for (int j = 0; j < 2; ++j) { g4[2 * j] = *(const f32x4*)(p.g_fin + 512 * j + 8 * lane); g4[2 * j + 1] = *(const f32x4*)(p.g_fin + 512 * j + 8 * lane + 4); }
    for (int rb = gw * 16; rb < T; rb += NGW * 16)
        for (int r4 = 0; r4 < 16; r4 += 4) {
            u32x4 w[4][2];
#pragma unroll
            for (int r = 0; r < 4; ++r)
#pragma unroll
                for (int j = 0; j < 2; ++j) w[r][j] = *(const u32x4*)(H2B + (size_t)(rb + r4 + r) * 1024 + 512 * j + 8 * lane);
#pragma unroll
            for (int r = 0; r < 4; ++r) { float v[2][8]; unpack8(w[r][0], v[0]); unpack8(w[r][1], v[1]); float s = 0.f;
#pragma unroll
                for (int j = 0; j < 2; ++j)
#pragma unroll
                    for (int i = 0; i < 8; ++i) s += v[j][i] * v[j][i];
                const float rstd = rsqrtf(wave_sum(s) * (1.f / 1024.f) + EPS); float* xo = p.out + (size_t)(rb + r4 + r) * 1024 + 8 * lane;
#pragma unroll
                for (int j = 0; j < 2; ++j) { const f32x4 o0 = (f32x4){v[j][0], v[j][1], v[j][2], v[j][3]} * rstd * g4[2 * j], o1 = (f32x4){v[j][4], v[j][5], v[j][6], v[j][7]} * rstd * g4[2 * j + 1];
                    *(f32x4*)(xo + 512 * j) = o0; *(f32x4*)(xo + 512 * j + 4) = o1; } }
        }
}

#define XB_TMO      128
#define XB_XCNT(j)  (256  + 64 * (j))
#define XB_XSUB(j)  (1280 + 64 * (j))
#define XB_XGEN(j)  (2304 + 64 * (j))
#define XB_TOP      3328
#define XB_TOPGEN   3392
#define XCD_BAR_WORDS 3456
#define XB_SPIN_CAP (1u << 18)

__device__ __forceinline__ unsigned xb_ld(unsigned* p)              { return __hip_atomic_load(p, __ATOMIC_RELAXED, __HIP_MEMORY_SCOPE_AGENT); }
__device__ __forceinline__ unsigned xb_add(unsigned* p, unsigned v) { return __hip_atomic_fetch_add(p, v, __ATOMIC_RELAXED, __HIP_MEMORY_SCOPE_AGENT); }
__device__ __forceinline__ unsigned xb_xcc_id() { return (unsigned)__builtin_amdgcn_s_getreg((3 << 11) | 20) & 0xFu; }
#define XB_SPIN(cond, bar) do { unsigned _sp = 0; while (cond) { __builtin_amdgcn_s_sleep(1); \
    if ((++_sp & 255u) == 0u) { if (xb_ld(&(bar)[XB_TMO])) break; if (_sp > XB_SPIN_CAP) { atomicAdd(&(bar)[XB_TMO], 1u); break; } } } } while (0)

struct XcdBarrier {
    unsigned* bar; unsigned x;
    volatile LAS unsigned* st;
};

__device__ __forceinline__ XcdBarrier xcd_barrier_post(unsigned* bar, volatile LAS unsigned* st) {
    XcdBarrier b; b.bar = bar; b.x = xb_xcc_id(); b.st = st;
    if (threadIdx.x == 0) (void)xb_add(&bar[XB_XCNT(b.x)], 1u);
    return b;
}
__device__ __forceinline__ void xcd_barrier_complete(unsigned* bar, unsigned x, unsigned& nloc, unsigned& nx) {
    const unsigned G = gridDim.x * gridDim.y * gridDim.z;
    unsigned sum, cnt, mine, sp = 0u;
    for (;;) {
        sum = 0u; cnt = 0u; mine = 0u;
#pragma unroll
        for (unsigned j = 0; j < 16; ++j) { const unsigned c = xb_ld(&bar[XB_XCNT(j)]); sum += c; cnt += (c > 0u) ? 1u : 0u; mine = (j == x) ? c : mine; }
        if (sum == G) break;
        __builtin_amdgcn_s_sleep(1);
        if ((++sp & 255u) == 0u) { if (xb_ld(&bar[XB_TMO])) break; if (sp > XB_SPIN_CAP) { atomicAdd(&bar[XB_TMO], 1u); break; } }
    }
    nloc = mine > 0u ? mine : 1u; nx = cnt > 0u ? cnt : 1u;
}

__device__ __forceinline__ void xcd_barrier(const XcdBarrier& b) {
    asm volatile("s_waitcnt vmcnt(0)" ::: "memory");
    __syncthreads();
    if (threadIdx.x == 0) {
        unsigned* bar = b.bar;
        __builtin_amdgcn_s_waitcnt(0);
        unsigned nloc = b.st[0], nx = b.st[1];
        if (nloc == 0u) { xcd_barrier_complete(bar, b.x, nloc, nx); b.st[0] = nloc; b.st[1] = nx; }
        const unsigned old = xb_add(&bar[XB_XSUB(b.x)], 1u);
        const unsigned gen = old / nloc;
        if (old + 1u == (gen + 1u) * nloc) {
            __builtin_amdgcn_fence(__ATOMIC_RELEASE, "agent");
            asm volatile("s_waitcnt vmcnt(0)" ::: "memory");
            const unsigned og = xb_add(&bar[XB_TOP], 1u);
            const unsigned tg = og / nx;
            if (og + 1u == (tg + 1u) * nx) xb_add(&bar[XB_TOPGEN], 1u);
            else XB_SPIN(xb_ld(&bar[XB_TOPGEN]) == tg, bar);
            __builtin_amdgcn_fence(__ATOMIC_ACQUIRE, "agent");
            xb_add(&bar[XB_XGEN(b.x)], 1u);
            asm volatile("s_waitcnt vmcnt(0)" ::: "memory");
        } else {
            XB_SPIN(xb_ld(&bar[XB_XGEN(b.x)]) == gen, bar);
            __builtin_amdgcn_fence(__ATOMIC_ACQUIRE, "agent");
            asm volatile("s_waitcnt vmcnt(0)" ::: "memory");
        }
    }
    __syncthreads();
}

__global__ void __launch_bounds__(NTHR, 2) fwd_megakernel(Params p) {
    extern __shared__ __attribute__((aligned(16))) unsigned char lds[];
    cg::grid_group grid = cg::this_grid();
    const int G = gridDim.x;
    unsigned char* ws = p.ws;
    PG8_LAS unsigned char* ldsl = (PG8_LAS unsigned char*)lds;
    bf16_t* Z = (bf16_t*)(ws + WS_Z);

    volatile LAS unsigned* bst = (volatile LAS unsigned*)((LAS unsigned char*)lds + LDS_BYTES - 64);
    if (threadIdx.x == 0) { bst[0] = 0u; bst[1] = 0u; }
    __syncthreads();
    const XcdBarrier xb = xcd_barrier_post((unsigned*)(ws + WS_BAR) + 4096, bst);
    if (p.ws == nullptr) grid.sync();
    p0_prologue(p, lds, G);
    xcd_barrier(xb);
    {
        pg8::Gemm g{(const bf16_t*)(ws + WS_XB), (const bf16_t*)(ws + WS_WIN), T, NIN, 1024}; pg8::StaticOrder S; S.init(T, NIN, G, (int)blockIdx.x);
        EpiInProj E{Z, (const float*)(ws + WS_R1), (const float*)(ws + WS_ROPE), (float*)(ws + WS_KMEAN)};
        pg8::gemm_phase<EpiInProj, pg8::StaticOrder, true, true>(ldsl, g, S, E);
    }
    xcd_barrier(xb);
    m1_phase(p, lds, G);
    xcd_barrier(xb);
    m2_scan(p, G);
    {
        const attn_body::AttnTensors AT{(const attn_body::bf16*)(Z + ZC_Q), (const attn_body::bf16*)(Z + ZC_K), (const attn_body::bf16*)(Z + ZC_V), (attn_body::bf16*)(ws + WS_YA), (const float*)(ws + WS_KMEAN)};
        attn_body::attn_phase<8>((char*)lds, AT, G, (int)blockIdx.x);
    }
    xcd_barrier(xb);
    m3_phase(p, lds, G);
    xcd_barrier(xb);
    {
        pg8::StaticOrder S; S.init(T, 1024, G, (int)blockIdx.x);
        pg8::Gemm g{(const bf16_t*)(ws + WS_YA), (const bf16_t*)(ws + WS_WPA), T, 1024, 1024};
        EpiMerge E{Z + ZC_GA, (bf16_t*)(ws + WS_XB)};
        pg8::gemm_phase<EpiMerge, pg8::StaticOrder, true, true>(ldsl, g, S, E);
    }
    xcd_barrier(xb);
    {
        p4_weights(p, lds, G);
        pg8::Gemm g{(const bf16_t*)(ws + WS_XB), (const bf16_t*)(ws + WS_WOUT), T, 1024, 1024}; pg8::StaticOrder S; S.init(T, 1024, G, (int)blockIdx.x);
        EpiOut E{p.x, (bf16_t*)(ws + WS_YA), (float*)(ws + WS_R1)};
        pg8::gemm_phase<EpiOut, pg8::StaticOrder, true, true>(ldsl, g, S, E);
    }
    xcd_barrier(xb);
    {
        pg8::Gemm g{(const bf16_t*)(ws + WS_YA), (const bf16_t*)(ws + WS_WGU), T, NIN, 1024}; pg8::StaticOrder S; S.init(T, NIN, G, (int)blockIdx.x);
        EpiGateUp E{(const float*)(ws + WS_R1), Z};
        pg8::gemm_phase<EpiGateUp, pg8::StaticOrder, true, true>(ldsl, g, S, E);
    }
    xcd_barrier(xb);
    {
        pg8::Gemm g{(const bf16_t*)Z, (const bf16_t*)(ws + WS_WDN), T, 1024, FF}; pg8::StaticOrder S; S.init(T, 1024, G, (int)blockIdx.x);
        EpiDown E{(const bf16_t*)(ws + WS_YA), (bf16_t*)(ws + WS_XB)};
        pg8::gemm_phase<EpiDown, pg8::StaticOrder, true, true>(ldsl, g, S, E);
    }
    xcd_barrier(xb);
    p7_final(p, G);
}
}

extern "C" void kernel_launch(void* const* d_in, const int* in_sizes, int n_in, void* d_out, int out_size, void* d_ws, size_t ws_size, hipStream_t stream) {
    static int grid = 0;
    if (grid == 0) {
        if (n_in != 14 || in_sizes[0] != mk::T * 1024 || out_size != mk::T * 1024 || ws_size < mk::WS_END) { fprintf(stderr, "kernel_launch: unexpected shapes (n_in %d, in0 %d, out %d, ws %zu)\n", n_in, n_in > 0 ? in_sizes[0] : -1, out_size, ws_size); grid = -1; return; }
        int dev = 0, cus = 0, per_cu = 0;
        hipGetDevice(&dev); hipDeviceGetAttribute(&cus, hipDeviceAttributeMultiprocessorCount, dev);
        if (hipFuncSetAttribute((const void*)mk::fwd_megakernel, hipFuncAttributeMaxDynamicSharedMemorySize, mk::LDS_BYTES) != hipSuccess) { fprintf(stderr, "kernel_launch: hipFuncSetAttribute failed\n"); grid = -1; return; }
        if (hipOccupancyMaxActiveBlocksPerMultiprocessor(&per_cu, (const void*)mk::fwd_megakernel, mk::NTHR, mk::LDS_BYTES) != hipSuccess || per_cu < 1) { fprintf(stderr, "kernel_launch: occupancy query says %d blocks per CU\n", per_cu); per_cu = 1; }
        (void)hipGetLastError();
        grid = cus;
    }
    if (grid < 0) return;
    mk::Params p{};
    p.x = (const float*)d_in[0]; p.g_mix = (const float*)d_in[1]; p.w_in = (const float*)d_in[2]; p.conv_w = (const float*)d_in[3]; p.b_i = (const float*)d_in[4]; p.b_f = (const float*)d_in[5];
    p.g_ml = (const float*)d_in[6]; p.w_pa = (const float*)d_in[7]; p.w_pb = (const float*)d_in[8]; p.w_out = (const float*)d_in[9]; p.g_ffn = (const float*)d_in[10]; p.w_gu = (const float*)d_in[11];
    p.w_dn = (const float*)d_in[12]; p.g_fin = (const float*)d_in[13]; p.out = (float*)d_out; p.ws = (unsigned char*)d_ws;
    if (hipMemsetAsync((char*)d_ws + mk::WS_BAR, 0, 32768, stream) != hipSuccess) { fprintf(stderr, "kernel_launch: hipMemsetAsync of the barrier words failed\n"); return; }
    void* args[] = {&p};
    hipError_t e = hipLaunchCooperativeKernel((const void*)mk::fwd_megakernel, dim3(grid), dim3(mk::NTHR), args, mk::LDS_BYTES, stream);
    if (e != hipSuccess) fprintf(stderr, "kernel_launch: cooperative launch failed: %s (grid %d)\n", hipGetErrorString(e), grid);
}
```

```cpp
#include <hip/hip_runtime.h>
#include <hip/hip_cooperative_groups.h>
#include <hip/hip_bf16.h>
#include <cstdio>
#include <cstdint>
#include <cmath>
namespace cg = cooperative_groups;
namespace pg8 {
#define PG8_LAS __attribute__((address_space(3)))
typedef unsigned short bf16_t;
typedef short bf16x8 __attribute__((ext_vector_type(8)));
typedef float f32x4 __attribute__((ext_vector_type(4)));
typedef unsigned u32x4 __attribute__((ext_vector_type(4)));
constexpr int BM = 256, BK = 64, HALF = 128, HTB = HALF * BK * 2  , STAGE_BYTES = 8 * HTB, NXCD = 8, WGM = 8;

__host__ __device__ __forceinline__ int lds_byte(int r, int c) { const int st = (r >> 4) * 2 + (c >> 5), rr = r & 15, cc = c & 31, ob = rr * 64 + cc * 2; return st * 1024 + (ob ^ (((ob >> 9) & 1) << 5)); }
__host__ __device__ __forceinline__ void stage_rc(int b, int& R, int& C) { const int st = b / 1024, sb = b % 1024, swz = sb ^ (((sb >> 9) & 1) << 5); R = (st >> 1) * 16 + swz / 64; C = (st & 1) * 32 + (swz % 64) / 2; }
__host__ __device__ __forceinline__ int perm32(int rho) { const int n = rho >> 4, i = rho & 15; return 8 * (i >> 2) + 4 * n + (i & 3); }

struct Unit { int pm, pn; };
struct Gemm { const bf16_t* A; const bf16_t* Bt; int M, N, K; };

struct StaticOrder {
    int nM, nN, nwg, G, c;
    __host__ __device__ void init(int M, int N, int G_, int c_) { nM = M / BM; nN = N / BM; nwg = nM * nN; G = G_; c = c_; }
    __host__ __device__ bool next(int i, Unit& u) const {
        const long L = (long)i * G + c; if (L >= nwg) return false;
        int wgid = (int)L; { const int q = nwg / NXCD, r = nwg % NXCD, xcd = wgid % NXCD, off = wgid / NXCD; wgid = (xcd < r ? xcd * (q + 1) : r * (q + 1) + (xcd - r) * q) + off; }
        const int nig = WGM * nN, gid = wgid / nig, fm = gid * WGM, gsz = (nM - fm) < WGM ? (nM - fm) : WGM;
        u.pm = fm + ((wgid % nig) % gsz); u.pn = (wgid % nig) / gsz; return true;
    }
    __device__ __forceinline__ void a_ready(const Unit&) const {}
    __device__ __forceinline__ void done(const Unit&) const {}
};
__device__ __forceinline__ unsigned cvt_pk_bf16(float lo, float hi) { unsigned r; asm volatile("v_cvt_pk_bf16_f32 %0, %1, %2" : "=v"(r) : "v"(lo), "v"(hi)); return r; }
typedef float f32x2 __attribute__((ext_vector_type(2)));
template <class Epi, class Sched, bool ALIGN_EPI = false, bool SP2 = false>
__device__ __forceinline__ void gemm_phase(PG8_LAS unsigned char* lds, const Gemm g, const Sched& S, const Epi& E) {
    int tid_ = threadIdx.x; asm volatile("" : "+v"(tid_));
    const int tid = tid_, wid = __builtin_amdgcn_readfirstlane(tid >> 6), lane = tid & 63, wr = wid >> 2, wc = wid & 3, fr = lane & 15, fq = lane >> 4;
    const int K = g.K, nt = K / BK;
    unsigned voffA[2], voffB[2];
#pragma unroll
    for (int i = 0; i < 2; ++i) { int R, C; stage_rc(tid * 16 + i * 8192, R, C); const int Rb = Epi::PERM ? ((R & ~31) + perm32(R & 31)) : R;
        voffA[i] = (unsigned)(R * K + C) * 2u; voffB[i] = (unsigned)(Rb * K + C) * 2u; }
    const size_t kstep = (size_t)(BK * 2);
    const size_t hstep = (size_t)HALF * K * 2;
    const size_t tstep = 2 * hstep;
    const unsigned ldsw = (unsigned)wid * 1024u;
    const int aoff = lds_byte(wr * 64 + fr, fq * 8), boff = lds_byte(wc * 32 + fr, fq * 8);
#define PG8_SA(b, h) (((b) * 2 + (h)) * HTB)
#define PG8_SB(b, h) ((4 + (b) * 2 + (h)) * HTB)
#define PG8_STAGE(bufoff, gbase, voff) do { _Pragma("unroll") for (int _i = 0; _i < 2; ++_i) \
        __builtin_amdgcn_global_load_lds((const unsigned*)((const char*)(gbase) + (voff)[_i]), (PG8_LAS unsigned*)(lds + (bufoff) + ldsw + _i * 8192), 16, 0, 0); } while (0)
#define PG8_LDA(dst, b, h) do { _Pragma("unroll") for (int m = 0; m < 4; ++m) _Pragma("unroll") for (int k = 0; k < 2; ++k) dst[m][k] = *(const PG8_LAS bf16x8*)(lds + PG8_SA(b, h) + aoff + m * 2048 + k * 1024); } while (0)
#define PG8_LDB(dst, b, h) do { _Pragma("unroll") for (int n = 0; n < 2; ++n) _Pragma("unroll") for (int k = 0; k < 2; ++k) dst[n][k] = *(const PG8_LAS bf16x8*)(lds + PG8_SB(b, h) + boff + n * 2048 + k * 1024); } while (0)
#define PG8_MMA(ai, bj, At, Bt) do { __builtin_amdgcn_s_setprio(1); _Pragma("unroll") for (int m = 0; m < 4; ++m) _Pragma("unroll") for (int n = 0; n < 2; ++n) _Pragma("unroll") for (int k = 0; k < 2; ++k) \
        acc[ai][bj][m][n] = __builtin_amdgcn_mfma_f32_16x16x32_bf16(Bt[n][k], At[m][k], acc[ai][bj][m][n], 0, 0, 0); __builtin_amdgcn_s_setprio(0); } while (0)
#define PG8_WAIT_V(n) asm volatile("s_waitcnt vmcnt(" #n ")" ::: "memory")
#define PG8_WAIT_L(n) asm volatile("s_waitcnt lgkmcnt(" #n ")" ::: "memory")
#define PG8_BAR __builtin_amdgcn_s_barrier()
#define PG8_SCHED __builtin_amdgcn_sched_barrier(0)
    Unit cur, nxt; int ui = 0;
    if (!S.next(0, cur)) return;
    f32x4 acc[2][2][4][2];
#pragma unroll
    for (int a = 0; a < 2; ++a)
#pragma unroll
        for (int b = 0; b < 2; ++b)
#pragma unroll
            for (int m = 0; m < 4; ++m)
#pragma unroll
                for (int n = 0; n < 2; ++n) acc[a][b][m][n] = (f32x4){0.f, 0.f, 0.f, 0.f};
    bf16x8 At[4][2], B0[2][2], B1[2][2];
    const char* cA = (const char*)g.A + (size_t)cur.pm * tstep; const char* cB = (const char*)g.Bt + (size_t)cur.pn * tstep;
    S.a_ready(cur);
    if constexpr (SP2) {
        PG8_STAGE(PG8_SB(0, 0), cB, voffB); PG8_STAGE(PG8_SB(0, 1), cB + hstep, voffB); PG8_STAGE(PG8_SA(0, 0), cA, voffA); PG8_STAGE(PG8_SA(0, 1), cA + hstep, voffA);
        if (wr == 1) PG8_BAR;
        PG8_WAIT_V(2); PG8_BAR;
        PG8_STAGE(PG8_SB(1, 0), cB + kstep, voffB); PG8_STAGE(PG8_SA(1, 0), cA + kstep, voffA); PG8_STAGE(PG8_SB(1, 1), cB + hstep + kstep, voffB);
        PG8_WAIT_V(6); PG8_BAR;
    } else {
        PG8_STAGE(PG8_SB(0, 0), cB, voffB); PG8_STAGE(PG8_SA(0, 0), cA, voffA); PG8_STAGE(PG8_SB(0, 1), cB + hstep, voffB); PG8_STAGE(PG8_SA(0, 1), cA + hstep, voffA);
        if (wr == 1) PG8_BAR;
        PG8_WAIT_V(4); PG8_BAR;
        PG8_STAGE(PG8_SB(1, 0), cB + kstep, voffB); PG8_STAGE(PG8_SA(1, 0), cA + kstep, voffA); PG8_STAGE(PG8_SB(1, 1), cB + hstep + kstep, voffB);
        PG8_WAIT_V(6); PG8_BAR;
    }
    for (;;) {
        const bool has_next = S.next(ui + 1, nxt);
        const char* nA = has_next ? (const char*)g.A + (size_t)nxt.pm * tstep : cA; const char* nB = has_next ? (const char*)g.Bt + (size_t)nxt.pn * tstep : cB;
        for (int t = 0; t < nt; t += 2) {
            const bool last = (t == nt - 2);
            if constexpr (Epi::MID) { if (t == (nt >> 1)) E.mid(acc, cur, wr, wc, fr, fq); }
            const char* a1 = cA + (size_t)(t + 1) * kstep;
            const char* a2 = last ? nA : cA + (size_t)(t + 2) * kstep; const char* b2 = last ? nB : cB + (size_t)(t + 2) * kstep;
            const char* a3 = a2 + kstep; const char* b3 = b2 + kstep;
            if (last && has_next) S.a_ready(nxt);
            if constexpr (SP2) {
            PG8_LDB(B0, 0, 0); PG8_LDB(B1, 0, 1); PG8_SCHED; PG8_LDA(At, 0, 0); PG8_STAGE(PG8_SA(1, 1), a1 + hstep, voffA);
            PG8_WAIT_V(8); PG8_WAIT_L(0); PG8_BAR; PG8_MMA(0, 0, At, B0); PG8_MMA(0, 1, At, B1); PG8_BAR; PG8_SCHED;
            PG8_LDA(At, 0, 1); PG8_STAGE(PG8_SB(0, 0), b2, voffB); PG8_STAGE(PG8_SB(0, 1), b2 + hstep, voffB); PG8_STAGE(PG8_SA(0, 0), a2, voffA);
            PG8_WAIT_V(8); PG8_WAIT_L(0); PG8_BAR; PG8_MMA(1, 0, At, B0); PG8_MMA(1, 1, At, B1); PG8_BAR; PG8_SCHED;
            PG8_LDB(B0, 1, 0); PG8_LDB(B1, 1, 1); PG8_SCHED; PG8_LDA(At, 1, 0); PG8_STAGE(PG8_SA(0, 1), a2 + hstep, voffA);
            PG8_WAIT_V(8); PG8_WAIT_L(0); PG8_BAR; PG8_MMA(0, 0, At, B0); PG8_MMA(0, 1, At, B1); PG8_BAR; PG8_SCHED;
            PG8_LDA(At, 1, 1); PG8_STAGE(PG8_SB(1, 0), b3, voffB); PG8_STAGE(PG8_SB(1, 1), b3 + hstep, voffB); PG8_STAGE(PG8_SA(1, 0), a3, voffA);
            PG8_WAIT_V(8); PG8_WAIT_L(0); PG8_BAR; PG8_MMA(1, 0, At, B0); PG8_MMA(1, 1, At, B1); PG8_BAR; PG8_SCHED;
            } else {
            PG8_LDB(B0, 0, 0); PG8_SCHED; PG8_LDA(At, 0, 0); PG8_STAGE(PG8_SA(1, 1), a1 + hstep, voffA);
            PG8_WAIT_L(8); PG8_BAR; PG8_WAIT_L(0); PG8_MMA(0, 0, At, B0); PG8_BAR; PG8_SCHED;
            PG8_LDB(B1, 0, 1); PG8_STAGE(PG8_SB(0, 0), b2, voffB);
            PG8_BAR; PG8_WAIT_L(0); PG8_MMA(0, 1, At, B1); PG8_BAR;
            PG8_LDA(At, 0, 1); PG8_STAGE(PG8_SA(0, 0), a2, voffA);
            PG8_BAR; PG8_WAIT_L(0); PG8_MMA(1, 0, At, B0); PG8_BAR; PG8_SCHED;
            PG8_STAGE(PG8_SB(0, 1), b2 + hstep, voffB);
            PG8_WAIT_V(6); PG8_BAR; PG8_MMA(1, 1, At, B1); PG8_BAR;
            PG8_LDB(B0, 1, 0); PG8_SCHED; PG8_LDA(At, 1, 0); PG8_STAGE(PG8_SA(0, 1), a2 + hstep, voffA);
            PG8_WAIT_L(8); PG8_BAR; PG8_WAIT_L(0); PG8_MMA(0, 0, At, B0); PG8_BAR; PG8_SCHED;
            PG8_LDB(B1, 1, 1); PG8_STAGE(PG8_SB(1, 0), b3, voffB);
            PG8_BAR; PG8_WAIT_L(0); PG8_MMA(0, 1, At, B1); PG8_BAR;
            PG8_LDA(At, 1, 1); PG8_STAGE(PG8_SA(1, 0), a3, voffA);
            PG8_BAR; PG8_WAIT_L(0); PG8_MMA(1, 0, At, B0); PG8_BAR; PG8_SCHED;
            PG8_STAGE(PG8_SB(1, 1), b3 + hstep, voffB);
            PG8_WAIT_V(6); PG8_BAR; PG8_MMA(1, 1, At, B1); PG8_BAR;
            }
        }
        if constexpr (ALIGN_EPI) { if (wr == 0) PG8_BAR; }
        if constexpr (!Epi::AFTER_DRAIN) { E(acc, cur, wr, wc, fr, fq); S.done(cur); }
        if (!has_next) break;
#pragma unroll
        for (int a = 0; a < 2; ++a)
#pragma unroll
            for (int b = 0; b < 2; ++b)
#pragma unroll
                for (int m = 0; m < 4; ++m)
#pragma unroll
                    for (int n = 0; n < 2; ++n) acc[a][b][m][n] = (f32x4){0.f, 0.f, 0.f, 0.f};
        cur = nxt; cA = nA; cB = nB; ++ui;
        if constexpr (ALIGN_EPI) { if (wr == 1) PG8_BAR; }
    }
    PG8_WAIT_V(0);
    if constexpr (!ALIGN_EPI) { if (wr == 0) PG8_BAR; }
    PG8_BAR;
    if constexpr (Epi::AFTER_DRAIN) { E.fused(acc, cur, wr, wc, fr, fq, lds, wid, lane); S.done(cur); }
#undef PG8_SA
#undef PG8_SB
#undef PG8_STAGE
#undef PG8_LDA
#undef PG8_LDB
#undef PG8_MMA
#undef PG8_WAIT_V
#undef PG8_WAIT_L
#undef PG8_BAR
#undef PG8_SCHED
}
}
namespace attn_body {
using bf16=__hip_bfloat16;
using bf16x8=__attribute__((ext_vector_type(8)))short;
using s16x4=__attribute__((ext_vector_type(4)))short;
using f32x16=__attribute__((ext_vector_type(16)))float;
using u32x4=__attribute__((ext_vector_type(4)))unsigned;
constexpr int BATCH=8,NHEAD=8,SEQ=4096,D=64,DM=5632,OPITCH=1024;
constexpr int NW=8,QBLK=32,QB=QBLK*NW,KVBLK=64,NQB=SEQ/QB;
constexpr int ATTN_PITCH=DM, ATTN_UNIT_ROWS=QB;
__device__ __forceinline__ int crow(int r,int hi){return (r&3)+8*(r>>2)+4*hi;}
#define SBAR() __builtin_amdgcn_sched_barrier(0)
__device__ __forceinline__ void cmask(f32x16&p0,f32x16&p1,int jb,int qrel,int hi){
  const float NEG=-INFINITY; const int lim=qrel-(64*jb+4*hi);
  #pragma unroll
  for(int r=0;r<16;++r){const int cr=(r&3)+8*(r>>2); if(cr>lim)p0[r]=NEG; if(cr+32>lim)p1[r]=NEG;}
}

__device__ __forceinline__ void smask(f32x16&p0,f32x16&p1,unsigned seladdr,int blk){
  const unsigned sel=*(const __attribute__((address_space(3))) unsigned*)(uintptr_t)seladdr;
  if(!((sel>>blk)&1u)){
  #pragma unroll
  for(int r=0;r<16;++r){p0[r]=-INFINITY;p1[r]=-INFINITY;}}
}
constexpr int NSLOT=3, SLOTB=8192;
constexpr int LDS_K=0, LDS_V=NSLOT*SLOTB, LDS_WS=2*NSLOT*SLOTB, LDS_OST=LDS_WS+NW*64*4, LDS_BYTES=LDS_OST+NW*4096;
constexpr float C2=0.125f*1.4426950408889634f;
__device__ __forceinline__ void glds16(const void*gsrc,unsigned lds_dst){unsigned keep;
  asm volatile("s_mov_b32 %0, m0\n\ts_mov_b32 m0, %2\n\ts_nop 0\n\tglobal_load_lds_dwordx4 %1, off\n\ts_mov_b32 m0, %0":"=&s"(keep):"v"(gsrc),"s"(lds_dst):"memory");}
__device__ __forceinline__ float max3f(float a,float b,float c){float r;asm("v_max3_f32 %0, %1, %2, %3":"=v"(r):"v"(a),"v"(b),"v"(c));return r;}
__device__ __forceinline__ float max2f(float a,float b){float r;asm("v_max_f32_e32 %0, %1, %2":"=v"(r):"v"(a),"v"(b));return r;}
__device__ __forceinline__ float fadd_s(float a,float b){float r;asm("v_add_f32_e32 %0, %1, %2":"=v"(r):"v"(a),"v"(b));return r;}
__device__ __forceinline__ float fsub_s(float a,float b){float r;asm("v_sub_f32_e32 %0, %1, %2":"=v"(r):"v"(a),"v"(b));return r;}
typedef float f32x2_t __attribute__((ext_vector_type(2))); typedef __bf16 bf16x2_t __attribute__((ext_vector_type(2)));
__device__ __forceinline__ unsigned cvtpk_s(float lo,float hi){f32x2_t v={lo,hi};bf16x2_t b=__builtin_convertvector(v,bf16x2_t);return __builtin_bit_cast(unsigned,b);}
#define WAIT_BAR(N) asm volatile("s_waitcnt vmcnt(" #N ") lgkmcnt(0)\n\ts_barrier":::"memory")

__device__ __forceinline__ void qkt(f32x16&p0,f32x16&p1,const char*Kslot,const bf16x8*qr,const f32x16&negm,int r32,int hi){
  const char*kb=Kslot+hi*1024+r32*16;
  #pragma unroll
  for(int d0=0;d0<4;++d0){
    const bf16x8 b0=*reinterpret_cast<const bf16x8*>(kb+d0*2048);
    const bf16x8 b1=*reinterpret_cast<const bf16x8*>(kb+d0*2048+512);
    if(d0==0){p0=__builtin_amdgcn_mfma_f32_32x32x16_bf16(b0,qr[0],negm,0,0,0);p1=__builtin_amdgcn_mfma_f32_32x32x16_bf16(b1,qr[0],negm,0,0,0);}
    else{p0=__builtin_amdgcn_mfma_f32_32x32x16_bf16(b0,qr[d0],p0,0,0,0);p1=__builtin_amdgcn_mfma_f32_32x32x16_bf16(b1,qr[d0],p1,0,0,0);}}
}
typedef __attribute__((address_space(3))) const char* lds_cptr;
typedef short v4i16_t __attribute__((ext_vector_type(4)));
__device__ __forceinline__ void kload8(bf16x8*kf,lds_cptr kp){
  kf[0]=*(const __attribute__((address_space(3))) bf16x8*)(kp);      kf[1]=*(const __attribute__((address_space(3))) bf16x8*)(kp+512);
  kf[2]=*(const __attribute__((address_space(3))) bf16x8*)(kp+2048); kf[3]=*(const __attribute__((address_space(3))) bf16x8*)(kp+2560);
  kf[4]=*(const __attribute__((address_space(3))) bf16x8*)(kp+4096); kf[5]=*(const __attribute__((address_space(3))) bf16x8*)(kp+4608);
  kf[6]=*(const __attribute__((address_space(3))) bf16x8*)(kp+6144); kf[7]=*(const __attribute__((address_space(3))) bf16x8*)(kp+6656);
}
__device__ __forceinline__ void kload2(bf16x8*kf,lds_cptr kp,int j){ kf[2*j]=*(const __attribute__((address_space(3))) bf16x8*)(kp+j*2048); kf[2*j+1]=*(const __attribute__((address_space(3))) bf16x8*)(kp+j*2048+512); }
__device__ __forceinline__ s16x4 vtr(lds_cptr p){ return __builtin_bit_cast(s16x4,__builtin_amdgcn_ds_read_tr16_b64_v4i16((__attribute__((address_space(3))) v4i16_t*)p)); }
__device__ __forceinline__ float rowmax(const f32x16&p0,const f32x16&p1){
  float a=max3f(p0[0],p0[1],p1[0]),b=max3f(p0[2],p0[3],p1[1]);a=max3f(a,p1[2],p1[3]);
  #pragma unroll
  for(int r=4;r<16;r+=4){a=max3f(a,p0[r],p0[r+1]);b=max3f(b,p0[r+2],p0[r+3]);a=max3f(a,p1[r],p1[r+1]);b=max3f(b,p1[r+2],p1[r+3]);}
  const float m=max2f(a,b);
  auto rr=__builtin_amdgcn_permlane32_swap(__float_as_uint(m),__float_as_uint(m),false,false);
  return max2f(__uint_as_float(rr[0]),__uint_as_float(rr[1]));
}
__device__ __forceinline__ void pv(f32x16*o,int vb,bf16x8 pa0,bf16x8 pa1,bf16x8 pa2,bf16x8 pa3){
  #pragma unroll
  for(int d0=0;d0<2;++d0){s16x4 lo[4],hi[4];
    #pragma unroll
    for(int ks=0;ks<4;++ks){
      asm volatile("ds_read_b64_tr_b16 %0,%1 offset:%c2":"=&v"(lo[ks]):"v"(vb),"i"(d0*4096+ks*1024):"memory");
      asm volatile("ds_read_b64_tr_b16 %0,%1 offset:%c2":"=&v"(hi[ks]):"v"(vb),"i"(d0*4096+ks*1024+512):"memory");}
    asm volatile("s_waitcnt lgkmcnt(0)":::"memory");SBAR();
    #define PK(k) (bf16x8){lo[k][0],lo[k][1],lo[k][2],lo[k][3],hi[k][0],hi[k][1],hi[k][2],hi[k][3]}
    o[d0]=__builtin_amdgcn_mfma_f32_32x32x16_bf16(pa0,PK(0),o[d0],0,0,0);
    o[d0]=__builtin_amdgcn_mfma_f32_32x32x16_bf16(pa1,PK(1),o[d0],0,0,0);
    o[d0]=__builtin_amdgcn_mfma_f32_32x32x16_bf16(pa2,PK(2),o[d0],0,0,0);
    o[d0]=__builtin_amdgcn_mfma_f32_32x32x16_bf16(pa3,PK(3),o[d0],0,0,0);
    #undef PK
  }
}

#ifndef ATTN_STORE16
#define ATTN_STORE16(p,v) (*(u32x4*)(p)=(v))
#endif
template<int THRL> __device__ __forceinline__ void attn_unit(int b,int h,int qb,unsigned selbase,const bf16*Q,const bf16*__restrict__ K,const bf16*__restrict__ V,bf16*O,char*shm){
  int tid_=threadIdx.x; asm volatile("":"+v"(tid_));
  const int tid=tid_,lane=tid&63,r32=lane&31,hi=lane>>5; const int wid=__builtin_amdgcn_readfirstlane(tid>>6);
  const long rowbase=(long)b*SEQ; const int q0=qb*QB;
  const bf16*Qw=Q+(rowbase+q0+wid*QBLK)*DM+h*D;
  const bf16*Kh=K+rowbase*DM+h*D,*Vh=V+rowbase*DM+h*D;
  const unsigned lds0=(unsigned)(uintptr_t)shm;
  float*wsf=(float*)(shm+LDS_WS)+wid*64;
  const bf16*ksrc=Kh+(long)lane*DM+wid*8;
  const bf16*vsrc=Vh+(long)(16*(wid&3)+(lane>>2))*DM+(wid>>2)*32+(lane&3)*8;
  const unsigned kdst=lds0+LDS_K+wid*1024, vdst=lds0+LDS_V+wid*1024;
  #define DMA_K(t,slot) glds16(ksrc+(long)(t)*KVBLK*DM,(unsigned)__builtin_amdgcn_readfirstlane(kdst+(slot)))
  #define DMA_V(t,slot) glds16(vsrc+(long)(t)*KVBLK*DM,(unsigned)__builtin_amdgcn_readfirstlane(vdst+(slot)))
  const int vb0=(int)(lds0+LDS_V)+((lane>>4)&1)*32+(lane&3)*8+(4*hi+((lane&15)>>2))*64;
  const char*Kbase=shm+LDS_K; bf16x8 kf[8];
  const lds_cptr shm3=(lds_cptr)shm; const lds_cptr kp0=shm3+LDS_K+hi*1024+r32*16; const lds_cptr vp0=shm3+LDS_V+((lane>>4)&1)*32+(lane&3)*8+(4*hi+((lane&15)>>2))*64;
  const int NT=(q0+QB)/KVBLK;
  DMA_K(0,0);DMA_V(0,0);DMA_K(1,SLOTB);
  bf16x8 qr[4];
  #pragma unroll
  for(int d0=0;d0<4;++d0)qr[d0]=*reinterpret_cast<const bf16x8*>(&Qw[(long)r32*DM+d0*16+hi*8]);
  float mhat=0.f,l_reg=0.f;f32x16 o[2];o[0]=f32x16{};o[1]=f32x16{};
  const int qrel=wid*QBLK+r32;
  #define SELBITS() (*(const volatile __attribute__((address_space(3))) unsigned*)(uintptr_t)(selbase+4u*(unsigned)qrel))
  #define CMASK(P0,P1,t) do{int jb_=(t)-(NT-4); if(jb_>=0)cmask(P0,P1,jb_,qrel,hi);}while(0)
  bool resc=false;
  #define START(P0,P1) do{ const float rm=rowmax(P0,P1); resc=false; \
    { const float dl=(rm==-INFINITY)?0.f:rm; mhat=fadd_s(mhat,dl); \
      _Pragma("unroll") for(int r=0;r<16;++r){P0[r]=fsub_s(P0[r],dl);P1[r]=fsub_s(P1[r],dl);} \
      } \
    _Pragma("unroll") for(int r=0;r<16;++r)P0[r]=__builtin_amdgcn_exp2f(P0[r]); }while(0)
  #define RESC() do{ if(resc){ asm volatile("s_waitcnt lgkmcnt(0)":::"memory"); \
      _Pragma("unroll") for(int d_=0;d_<2;++d_) _Pragma("unroll") for(int r=0;r<16;++r)o[d_][r]*=wsf[crow(r,hi)]; } }while(0)
  f32x16 pA0,pA1,pB0,pB1;
  int sl_prev=0,sl_cur=0,sl_next=SLOTB;
  #define ROT() do{sl_prev=sl_cur;sl_cur=sl_next;sl_next=(sl_next==(NSLOT-1)*SLOTB)?0:sl_next+SLOTB;}while(0)
  DMA_K(2,2*SLOTB);
  WAIT_BAR(3);
  qkt(pA0,pA1,Kbase,qr,f32x16{},r32,hi);asm volatile("s_nop 15\n\ts_nop 7":"+v"(pA0),"+v"(pA1));CMASK(pA0,pA1,0);
  if(NT>4&&!(SELBITS()&1u)){
  #pragma unroll
  for(int r=0;r<16;++r){pA0[r]=-INFINITY;pA1[r]=-INFINITY;}}
  START(pA0,pA1);
  _Pragma("unroll") for(int r=0;r<16;++r)pA1[r]=__builtin_amdgcn_exp2f(pA1[r]);
  WAIT_BAR(0);
  DMA_K(3,0);DMA_V(1,SLOTB);
  ROT();
  kload8(kf,kp0+sl_cur);
  WAIT_BAR(2);
  s16x4 vlo[8],vhi[8]; u32x4 pw0,pw1,pw2,pw3;
  #define PKW(P,B) cvtpk_s(P[B],P[B+1])
  #define PAF(k) __builtin_bit_cast(bf16x8,pw##k)
  #define VFR(i) (bf16x8){vlo[i][0],vlo[i][1],vlo[i][2],vlo[i][3],vhi[i][0],vhi[i][1],vhi[i][2],vhi[i][3]}
  #define PIN(x) asm volatile("":"+v"(x))
  #define MX3(a,b,c) __builtin_fmaxf(__builtin_fmaxf((a),(b)),(c))
  #define GAPA(MF,A0,A1,A2,A3,W0,W1,PW) do{ MF; sacc+=A0; sacc+=A1; sacc+=A2; sacc+=A3; PIN(sacc); W0; W1; PIN(PW); SBAR(); }while(0)
  #define EX(v) __builtin_amdgcn_exp2f(v)
  #define GAPB(MF,X,B) do{ MF; X[B]=EX(X[B]); X[B+1]=EX(X[B+1]); X[B+2]=EX(X[B+2]); X[B+3]=EX(X[B+3]); PIN(X); SBAR(); }while(0)
  #define VRD(i) do{ vlo[i]=vtr(vp_+(((i)>>2)*4096+((i)&3)*1024)); vhi[i]=vtr(vp_+(((i)>>2)*4096+((i)&3)*1024+512)); }while(0)
  #define KRD(G,j) do{ if(G){ kload2(kf,kp0+sl_next,j); SBAR(); } }while(0)
  #define STEP(C0,C1,P0,P1,t,GK,GV,GL) do{ SBAR(); \
    const lds_cptr vp_=vp0+sl_prev; \
    VRD(0); SBAR(); float sacc=(P0[0]+P0[1]); \
    GAPA(C0=__builtin_amdgcn_mfma_f32_32x32x16_bf16(kf[0],qr[0],f32x16{},0,0,0), P0[2],P0[3],P0[4],P0[5],     pw0[0]=PKW(P0,0), pw0[1]=PKW(P0,2), pw0); \
    VRD(4); SBAR(); GAPA(C1=__builtin_amdgcn_mfma_f32_32x32x16_bf16(kf[1],qr[0],f32x16{},0,0,0), P0[6],P0[7],P0[8],P0[9],     pw0[2]=PKW(P0,4), pw0[3]=PKW(P0,6), pw0); \
    VRD(1); SBAR(); GAPA(C0=__builtin_amdgcn_mfma_f32_32x32x16_bf16(kf[2],qr[1],C0,0,0,0),   P0[10],P0[11],P0[12],P0[13], pw1[0]=PKW(P0,8), pw1[1]=PKW(P0,10), pw1); \
    VRD(5); SBAR(); GAPA(C1=__builtin_amdgcn_mfma_f32_32x32x16_bf16(kf[3],qr[1],C1,0,0,0),   P0[14],P0[15],P1[0],P1[1],   pw1[2]=PKW(P0,12),pw1[3]=PKW(P0,14), pw1); \
    VRD(2); SBAR(); GAPA(C0=__builtin_amdgcn_mfma_f32_32x32x16_bf16(kf[4],qr[2],C0,0,0,0),   P1[2],P1[3],P1[4],P1[5],     pw2[0]=PKW(P1,0), pw2[1]=PKW(P1,2), pw2); \
    VRD(6); SBAR(); GAPA(C1=__builtin_amdgcn_mfma_f32_32x32x16_bf16(kf[5],qr[2],C1,0,0,0),   P1[6],P1[7],P1[8],P1[9],     pw2[2]=PKW(P1,4), pw2[3]=PKW(P1,6), pw2); \
    VRD(3); SBAR(); GAPA(C0=__builtin_amdgcn_mfma_f32_32x32x16_bf16(kf[6],qr[3],C0,0,0,0),   P1[10],P1[11],P1[12],P1[13], pw3[0]=PKW(P1,8), pw3[1]=PKW(P1,10), pw3); \
    VRD(7); SBAR(); GAPA(C1=__builtin_amdgcn_mfma_f32_32x32x16_bf16(kf[7],qr[3],C1,0,0,0),   P1[14],P1[15],0.f,0.f,       pw3[2]=PKW(P1,12),pw3[3]=PKW(P1,14), pw3); \
    l_reg+=sacc; \
    if(GK){DMA_K((t)+3,sl_cur);} if(GV){DMA_V((t)+1,sl_next);} \
    { float bias_=-mhat; if((t)<NT-4&&!((SELBITS()>>((t)>>2))&1u))bias_=-INFINITY; _Pragma("unroll") for(int r=0;r<16;++r){C0[r]+=bias_;C1[r]+=bias_;} } \
    CMASK(C0,C1,t); \
    { float a=MX3(C0[0],C0[1],C1[0]),b=MX3(C0[2],C0[3],C1[1]); a=MX3(a,C1[2],C1[3]); \
      _Pragma("unroll") for(int r=4;r<16;r+=4){a=MX3(a,C0[r],C0[r+1]);b=MX3(b,C0[r+2],C0[r+3]);a=MX3(a,C1[r],C1[r+1]);b=MX3(b,C1[r+2],C1[r+3]);} \
      float rm=__builtin_fmaxf(a,b); { auto rr=__builtin_amdgcn_permlane32_swap(__float_as_uint(rm),__float_as_uint(rm),false,false); rm=__builtin_fmaxf(__uint_as_float(rr[0]),__uint_as_float(rr[1])); } \
      resc=false; \
      if(__builtin_expect(__any(rm>(float)THRL),0)){ const float dl=__builtin_fmaxf(rm,0.f); mhat+=dl; \
        _Pragma("unroll") for(int r=0;r<16;++r){C0[r]-=dl;C1[r]-=dl;} \
        const float f=__builtin_amdgcn_exp2f(-dl); l_reg*=f; if(hi==0)wsf[r32]=f; resc=true; } } \
    SBAR(); \
    GAPB(o[0]=__builtin_amdgcn_mfma_f32_32x32x16_bf16(PAF(0),VFR(0),o[0],0,0,0), C0,0); \
    GAPB(o[1]=__builtin_amdgcn_mfma_f32_32x32x16_bf16(PAF(0),VFR(4),o[1],0,0,0), C0,4); \
    KRD(GL,0); GAPB(o[0]=__builtin_amdgcn_mfma_f32_32x32x16_bf16(PAF(1),VFR(1),o[0],0,0,0), C0,8); \
    KRD(GL,1); GAPB(o[1]=__builtin_amdgcn_mfma_f32_32x32x16_bf16(PAF(1),VFR(5),o[1],0,0,0), C0,12); \
    KRD(GL,2); GAPB(o[0]=__builtin_amdgcn_mfma_f32_32x32x16_bf16(PAF(2),VFR(2),o[0],0,0,0), C1,0); \
    KRD(GL,3); GAPB(o[1]=__builtin_amdgcn_mfma_f32_32x32x16_bf16(PAF(2),VFR(6),o[1],0,0,0), C1,4); \
    GAPB(o[0]=__builtin_amdgcn_mfma_f32_32x32x16_bf16(PAF(3),VFR(3),o[0],0,0,0), C1,8); \
    GAPB(o[1]=__builtin_amdgcn_mfma_f32_32x32x16_bf16(PAF(3),VFR(7),o[1],0,0,0), C1,12); \
    }while(0)
  int t=1;
  #undef CMASK
  #define CMASK(P0,P1,t) do{}while(0)
  for(;t+5<NT;t+=2){
    STEP(pB0,pB1,pA0,pA1,t,true,true,true);     WAIT_BAR(2); RESC(); ROT();
    STEP(pA0,pA1,pB0,pB1,t+1,true,true,true);   WAIT_BAR(2); RESC(); ROT();
  }
  #undef CMASK
  #define CMASK(P0,P1,t) do{int jb_=(t)-(NT-4); if(jb_>=0)cmask(P0,P1,jb_,qrel,hi);}while(0)
  #define ENDW(tt) do{ if((tt)+3<NT){WAIT_BAR(2);} else if((tt)+2<NT){WAIT_BAR(1);} else {WAIT_BAR(0);} }while(0)
  for(;t+1<NT;t+=2){
    STEP(pB0,pB1,pA0,pA1,t,(t+3<NT),(t+1<NT),(t+1<NT));       ENDW(t);   RESC(); ROT();
    STEP(pA0,pA1,pB0,pB1,t+1,(t+4<NT),(t+2<NT),(t+2<NT));     ENDW(t+1); RESC(); ROT();
  }
  STEP(pB0,pB1,pA0,pA1,NT-1,false,false,false); RESC();
  { float sacc=pB0[0]+pB0[1]; _Pragma("unroll") for(int r=2;r<16;++r)sacc+=pB0[r]; _Pragma("unroll") for(int r=0;r<16;++r)sacc+=pB1[r]; l_reg+=sacc;
    pw0=(u32x4){PKW(pB0,0),PKW(pB0,2),PKW(pB0,4),PKW(pB0,6)};pw1=(u32x4){PKW(pB0,8),PKW(pB0,10),PKW(pB0,12),PKW(pB0,14)};pw2=(u32x4){PKW(pB1,0),PKW(pB1,2),PKW(pB1,4),PKW(pB1,6)};pw3=(u32x4){PKW(pB1,8),PKW(pB1,10),PKW(pB1,12),PKW(pB1,14)};
    SBAR(); pv(o,vb0+sl_cur,PAF(0),PAF(1),PAF(2),PAF(3)); }
  #undef PKW
  #undef PAF
  #undef VFR
  #undef PIN
  #undef MX3
  #undef GAPA
  #undef GAPB
  #undef EX
  #undef VRD
  #undef KRD
  #undef STEP
  #undef ENDW
  {auto rr=__builtin_amdgcn_permlane32_swap(__float_as_uint(l_reg),__float_as_uint(l_reg),false,false);l_reg=__uint_as_float(rr[0])+__uint_as_float(rr[1]);}
  if(hi==0)wsf[32+r32]=l_reg;asm volatile("s_waitcnt lgkmcnt(0)":::"memory");
  float rli[16];
  #pragma unroll
  for(int r=0;r<16;++r)rli[r]=__builtin_amdgcn_rcpf(wsf[32+crow(r,hi)]);
  bf16*Ow=O+(rowbase+q0+wid*QBLK)*OPITCH+h*D;
  { bf16*stg=(bf16*)(shm+LDS_OST)+wid*2048;
    #pragma unroll
    for(int r=0;r<16;++r){const int orow=crow(r,hi);
      #pragma unroll
      for(int d0=0;d0<2;++d0)stg[orow*64+d0*32+r32]=__float2bfloat16(o[d0][r]*rli[r]);}
    asm volatile("s_waitcnt lgkmcnt(0)":::"memory");
    #pragma unroll
    for(int i=0;i<4;++i){const int row=i*8+(lane>>3),ch=lane&7; const u32x4 v=*(const u32x4*)(stg+row*64+ch*8); ATTN_STORE16(Ow+(long)row*OPITCH+ch*8,v);} }
  asm volatile("s_waitcnt lgkmcnt(0)\n\ts_barrier":::"memory");
  #undef DMA_K
  #undef DMA_V
  #undef CMASK
  #undef START
  #undef RESC
  #undef ROT
}
constexpr int ATTN_LDS_BYTES=LDS_BYTES;
constexpr int GATE_KM_OFF=86016, GATE_SEL_OFF=GATE_KM_OFF+4096, GATE_MAXU=16, ATTN_LDS_TOTAL=GATE_SEL_OFF+GATE_MAXU*1024;
__device__ __forceinline__ void moba_gate(int b,int h,int qb,const bf16*Q,const float*KM,char*shm,int slot){
  int tid_=threadIdx.x; asm volatile("":"+v"(tid_)); const int tid=tid_;
  float*kmS=(float*)(shm+GATE_KM_OFF); unsigned*selS=(unsigned*)(shm+GATE_SEL_OFF)+slot*QB;
  if(qb>3){
    for(int i=tid;i<qb*64;i+=512)kmS[i]=KM[(size_t)((b*16+(i>>6))*512)+h*64+(i&63)];
    __syncthreads();
    const int row=tid>>1,half=tid&1;
    const bf16*qp=Q+((long)b*SEQ+qb*QB+row)*DM+h*D+half*32;
    float qv[32];
    #pragma unroll
    for(int c=0;c<4;++c){const u32x4 w=*reinterpret_cast<const u32x4*>(qp+c*8);
      #pragma unroll
      for(int e=0;e<4;++e){qv[c*8+2*e]=__uint_as_float(w[e]<<16);qv[c*8+2*e+1]=__uint_as_float(w[e]&0xffff0000u);}}
    float v0=-INFINITY,v1=-INFINITY,v2=-INFINITY;int i0=0,i1=0,i2=0;
    for(int n=0;n<qb;++n){const float*kr=kmS+n*64+half*32;float d=0.f;
      #pragma unroll
      for(int e=0;e<32;++e)d+=qv[e]*kr[e];
      d+=__shfl_xor(d,1);
      if(d>v0){v2=v1;i2=i1;v1=v0;i1=i0;v0=d;i0=n;}else if(d>v1){v2=v1;i2=i1;v1=d;i1=n;}else if(d>v2){v2=d;i2=n;}}
    if(half==0)selS[row]=(1u<<i0)|(1u<<i1)|(1u<<i2);
  }else{ if(tid<QB)selS[tid]=(1u<<qb)-1u; }
  __syncthreads();
}
struct AttnTensors { const bf16* Q; const bf16* K; const bf16* V; bf16* O; const float* KM; };
__device__ __forceinline__ void unit_of(int idx,int&b,int&h,int&qb){
  const int v=idx&255,i=idx>>8; const int bh=v>>2,s0=(v&3)*2; qb=(i==0)?s0:(i==1)?15-s0:(i==2)?s0+1:14-s0; b=bh/NHEAD; h=bh%NHEAD;
}
template<int THRL=8> __device__ __forceinline__ void attn_phase(char*lds,const AttnTensors&T,int G,int block){
  const int vcu=(G%8==0)?(block%8)*(G/8)+block/8:block;
  { int slot=0; for(int idx=vcu;idx<BATCH*NHEAD*NQB&&slot<GATE_MAXU;idx+=G,++slot){ int b,h,qb; unit_of(idx,b,h,qb); moba_gate(b,h,qb,T.Q,T.KM,lds,slot); } }
  const unsigned selS0=(unsigned)(uintptr_t)(lds+GATE_SEL_OFF);
  int slot=0;
  if(__builtin_amdgcn_readfirstlane(threadIdx.x)>=256)__builtin_amdgcn_s_setprio(1);
  for(int idx=vcu;idx<BATCH*NHEAD*NQB;idx+=G,++slot){
    int b,h,qb; unit_of(idx,b,h,qb);
    attn_unit<THRL>(b,h,qb,selS0+(unsigned)slot*(QB*4),T.Q,T.K,T.V,T.O,lds);
  }
  __builtin_amdgcn_s_setprio(0);
}
#undef SBAR
#undef WAIT_BAR
}
namespace mk {
using pg8::bf16_t; using pg8::bf16x8; using pg8::f32x4; using pg8::u32x4; using pg8::Unit; using pg8::cvt_pk_bf16;
typedef unsigned u32x2 __attribute__((ext_vector_type(2)));
constexpr int NB = 8, SEQ = 4096, DMODEL = 1024, T = NB * SEQ, FF = 2816, NIN = 5632, INW = 5640;
constexpr int ZP = 5632;
constexpr int ZC_Q = 0, ZC_K = 512, ZC_V = 1024, ZC_QKB = 1536, ZC_VB = 2560, ZC_OB = 3072, ZC_GA = 3584, ZC_GB = 4608;
constexpr float EPS = 1e-6f;
constexpr float C2 = 0.125f * 1.4426950408889634f;
constexpr size_t MiB = 1u << 20;
constexpr size_t WS_BAR = 0;
constexpr size_t WS_WIN = 2 * MiB, WS_WPA = 13 * MiB, WS_WPB = 14 * MiB, WS_WOUT = 15 * MiB;
constexpr size_t WS_R1 = 17 * MiB, WS_KMEAN = 17 * MiB + 128 * 1024, WS_MST = 17 * MiB + 384 * 1024, WS_MC = 17 * MiB + 400 * 1024;
constexpr size_t WS_ROPE = 18 * MiB, WS_GATES = 19 * MiB, WS_SS = 20 * MiB, WS_DN = 22 * MiB, WS_NST = 23 * MiB;
constexpr size_t WS_XB = 24 * MiB;
constexpr size_t WS_YA = 88 * MiB, WS_YB = 120 * MiB;
constexpr size_t WS_Z = 152 * MiB;
constexpr size_t WS_WGU = 328 * MiB + 152 * MiB - 152 * MiB, WS_WDN = 340 * MiB, WS_END = 504 * MiB;
static_assert(WS_Z + (size_t)T * ZP * 2 <= WS_END && WS_Z + (size_t)T * FF * 2 <= WS_WGU && WS_WGU + (size_t)NIN * 1024 * 2 <= WS_WDN && WS_WDN + (size_t)1024 * FF * 2 <= WS_END, "ws map");

struct Params {
    const float* x; const float* g_mix; const float* w_in; const float* conv_w; const float* b_i; const float* b_f; const float* g_ml;
    const float* w_pa; const float* w_pb; const float* w_out; const float* g_ffn; const float* w_gu; const float* w_dn; const float* g_fin;
    float* out; unsigned char* ws;
};

__device__ __forceinline__ float bf2f(unsigned short b) { return __uint_as_float(((unsigned)b) << 16); }
__device__ __forceinline__ unsigned short f2bf(float f) { unsigned u = __float_as_uint(f); return (unsigned short)((u + 0x7fffu + ((u >> 16) & 1u)) >> 16); }
typedef float f32x2_t __attribute__((ext_vector_type(2))); typedef __bf16 bf16x2_t __attribute__((ext_vector_type(2)));
__device__ __forceinline__ unsigned cvtpk_safe(float lo, float hi) { f32x2_t v = {lo, hi}; bf16x2_t b = __builtin_convertvector(v, bf16x2_t); return __builtin_bit_cast(unsigned, b); }
__device__ __forceinline__ float wave_sum(float v) {
#pragma unroll
    for (int o = 1; o < 64; o <<= 1) v += __shfl_xor(v, o);
    return v;
}
template <int CTRL> __device__ __forceinline__ float dpp_mov(float v) { return __int_as_float(__builtin_amdgcn_update_dpp(0, __float_as_int(v), CTRL, 0xf, 0xf, false)); }
__device__ __forceinline__ float row_sum16(float v) { v += dpp_mov<0x128>(v); v += dpp_mov<0x124>(v); v += dpp_mov<0x122>(v); v += dpp_mov<0x121>(v); return v; }
__device__ __forceinline__ float wave_max(float v) {
#pragma unroll
    for (int o = 1; o < 64; o <<= 1) v = fmaxf(v, __shfl_xor(v, o));
    return v;
}
__device__ __forceinline__ float sigmoidf_(float v) { return __builtin_amdgcn_rcpf(1.f + __expf(-v)); }
__device__ __forceinline__ float siluf_(float v) { return v * __builtin_amdgcn_rcpf(1.f + __expf(-v)); }
__device__ __forceinline__ float logsigmoidf_(float v) { return fminf(v, 0.f) - log1pf(__expf(-fabsf(v))); }
__device__ __forceinline__ void unpack8(const u32x4 w, float (&f)[8]) {
#pragma unroll
    for (int e = 0; e < 4; ++e) { f[2 * e] = __uint_as_float(w[e] << 16); f[2 * e + 1] = __uint_as_float(w[e] & 0xffff0000u); }
}

struct EpiInProj {
    static constexpr bool PERM = true, AFTER_DRAIN = false, MID = false;
    bf16_t* Z; const float* r1; const float* rope; float* kmean;
    __device__ __forceinline__ void operator()(const f32x4 (&acc)[2][2][4][2], const Unit& u, int wr, int wc, int fr, int fq) const {
        const int row0 = u.pm * 256 + wr * 64 + fr, pn = u.pn, col0 = pn * 256 + wc * 32 + 8 * fq;
        if (pn < 4) {
            const bool isK = pn >= 2; const float sc = isK ? 1.f : C2; const int jj = 4 * (wc & 1) + fq;
            f32x4 cs[2][2];
#pragma unroll
            for (int a = 0; a < 2; ++a)
#pragma unroll
                for (int b = 0; b < 2; ++b) cs[a][b] = (f32x4){0.f, 0.f, 0.f, 0.f};
#pragma unroll
            for (int ai = 0; ai < 2; ++ai)
#pragma unroll
                for (int m = 0; m < 4; ++m) {
                    const int row = row0 + ai * 128 + m * 16; const float rs = sc; const int pos = row & (SEQ - 1);
                    const f32x4 c4 = *(const f32x4*)(rope + (size_t)(pos * 8 + jj) * 8), s4 = *(const f32x4*)(rope + (size_t)(pos * 8 + jj) * 8 + 4);
                    bf16_t* rowp = Z + (size_t)row * ZP + col0;
#pragma unroll
                    for (int bj = 0; bj < 2; ++bj) {
                        const f32x4 v0 = acc[ai][bj][m][0] * rs, v1 = acc[ai][bj][m][1] * rs;
                        const f32x4 o0 = v0 * c4 - v1 * s4, o1 = v1 * c4 + v0 * s4;
                        cs[bj][0] += o0; cs[bj][1] += o1;
                        u32x4 w; w.x = cvt_pk_bf16(o0[0], o0[1]); w.y = cvt_pk_bf16(o0[2], o0[3]); w.z = cvt_pk_bf16(o1[0], o1[1]); w.w = cvt_pk_bf16(o1[2], o1[3]);
                        *(u32x4*)(rowp + bj * 128) = w;
                    }
                }
            if (isK) {
#pragma unroll
                for (int bj = 0; bj < 2; ++bj)
#pragma unroll
                    for (int n = 0; n < 2; ++n)
#pragma unroll
                        for (int i = 0; i < 4; ++i) {
                            float v = cs[bj][n][i];
                            v = row_sum16(v);
                            if (fr == 0) atomicAdd(kmean + (size_t)u.pm * 512 + (pn - 2) * 256 + bj * 128 + wc * 32 + 8 * fq + 4 * n + i, v);
                        }
            }
        } else if (pn < 14) {
            const bool sig = pn >= 12;
#pragma unroll
            for (int ai = 0; ai < 2; ++ai)
#pragma unroll
                for (int m = 0; m < 4; ++m) {
                    const int row = row0 + ai * 128 + m * 16;
                    bf16_t* rowp = Z + (size_t)row * ZP + col0;
#pragma unroll
                    for (int bj = 0; bj < 2; ++bj) {
                        f32x4 v0 = acc[ai][bj][m][0], v1 = acc[ai][bj][m][1];
                        if (sig) {
#pragma unroll
                            for (int i = 0; i < 4; ++i) { v0[i] = sigmoidf_(v0[i]); v1[i] = sigmoidf_(v1[i]); }
                        }
                        u32x4 w; w.x = cvt_pk_bf16(v0[0], v0[1]); w.y = cvt_pk_bf16(v0[2], v0[3]); w.z = cvt_pk_bf16(v1[0], v1[1]); w.w = cvt_pk_bf16(v1[2], v1[3]);
                        *(u32x4*)(rowp + bj * 128) = w;
                    }
                }
        } else {
            const int oc0 = 128 * (pn - 14) + 32 * wc + 8 * fq;
#pragma unroll
            for (int ai = 0; ai < 2; ++ai)
#pragma unroll
                for (int m = 0; m < 4; ++m) {
                    const int row = row0 + ai * 128 + m * 16; float r[8], sb[8];
#pragma unroll
                    for (int bj = 0; bj < 2; ++bj) { const f32x4 v0 = acc[ai][bj][m][0], v1 = acc[ai][bj][m][1];
#pragma unroll
                        for (int i = 0; i < 4; ++i) { const float ea = 1.f + __expf(-v0[i]), eb = 1.f + __expf(-v1[i]); sb[4 * bj + i] = __builtin_amdgcn_rcpf(eb); r[4 * bj + i] = eb * __builtin_amdgcn_rcpf(ea); } }
                    bf16_t* gp = Z + (size_t)row * ZP + ZC_GA + 128 * (oc0 >> 6) + (oc0 & 63);
                    u32x4 w0, w1; w0.x = cvt_pk_bf16(r[0], r[1]); w0.y = cvt_pk_bf16(r[2], r[3]); w0.z = cvt_pk_bf16(r[4], r[5]); w0.w = cvt_pk_bf16(r[6], r[7]);
                    w1.x = cvt_pk_bf16(sb[0], sb[1]); w1.y = cvt_pk_bf16(sb[2], sb[3]); w1.z = cvt_pk_bf16(sb[4], sb[5]); w1.w = cvt_pk_bf16(sb[6], sb[7]);
                    *(u32x4*)gp = w0; *(u32x4*)(gp + 64) = w1;
                }
        }
    }
};
struct EpiMerge {
    static constexpr bool PERM = true, AFTER_DRAIN = false, MID = true;
    const bf16_t* Zg; bf16_t* O;
    __device__ __forceinline__ void mid(f32x4 (&acc)[2][2][4][2], const Unit& u, int wr, int wc, int fr, int fq) const {
        int row0 = u.pm * 256 + wr * 64 + fr; asm volatile("" : "+v"(row0)); const int col0 = u.pn * 256 + wc * 32 + 8 * fq;
#pragma unroll
        for (int ai = 0; ai < 2; ++ai)
#pragma unroll
            for (int m = 0; m < 4; ++m) {
                const int row = row0 + ai * 128 + m * 16;
#pragma unroll
                for (int bj = 0; bj < 2; ++bj) {
                    const int c = col0 + bj * 128; float r[8]; unpack8(*(const u32x4*)(Zg + (size_t)row * ZP + 128 * (c >> 6) + (c & 63)), r);
#pragma unroll
                    for (int i = 0; i < 4; ++i) { acc[ai][bj][m][0][i] *= r[i]; acc[ai][bj][m][1][i] *= r[4 + i]; }
                }
            }
    }
    __device__ __forceinline__ void operator()(const f32x4 (&acc)[2][2][4][2], const Unit& u, int wr, int wc, int fr, int fq) const {
        const int row0 = u.pm * 256 + wr * 64 + fr, col0 = u.pn * 256 + wc * 32 + 8 * fq;
#pragma unroll
        for (int ai = 0; ai < 2; ++ai)
#pragma unroll
            for (int m = 0; m < 4; ++m) {
                const int row = row0 + ai * 128 + m * 16;
#pragma unroll
                for (int bj = 0; bj < 2; ++bj) {
                    const int c = col0 + bj * 128; float gb[8]; unpack8(*(const u32x4*)(Zg + (size_t)row * ZP + 128 * (c >> 6) + 64 + (c & 63)), gb);
                    const f32x4 v0 = acc[ai][bj][m][0], v1 = acc[ai][bj][m][1];
                    u32x4 w; w.x = cvt_pk_bf16(v0[0] * gb[0], v0[1] * gb[1]); w.y = cvt_pk_bf16(v0[2] * gb[2], v0[3] * gb[3]); w.z = cvt_pk_bf16(v1[0] * gb[4], v1[1] * gb[5]); w.w = cvt_pk_bf16(v1[2] * gb[6], v1[3] * gb[7]);
                    *(u32x4*)(O + (size_t)row * 1024 + col0 + bj * 128) = w;
                }
            }
    }
};
struct EpiOut {
    static constexpr bool PERM = true, AFTER_DRAIN = false, MID = false;
    const float* x; bf16_t* h1b; float* ss;
    __device__ __forceinline__ void operator()(const f32x4 (&acc)[2][2][4][2], const Unit& u, int wr, int wc, int fr, int fq) const {
        const int row0 = u.pm * 256 + wr * 64 + fr, col0 = u.pn * 256 + wc * 32 + 8 * fq;
#pragma unroll
        for (int ai = 0; ai < 2; ++ai)
#pragma unroll
            for (int m = 0; m < 4; ++m) {
                const int row = row0 + ai * 128 + m * 16; float s = 0.f;
#pragma unroll
                for (int bj = 0; bj < 2; ++bj) {
                    const size_t off = (size_t)row * 1024 + col0 + bj * 128;
                    const f32x4 a0 = *(const f32x4*)(x + off) + acc[ai][bj][m][0], a1 = *(const f32x4*)(x + off + 4) + acc[ai][bj][m][1];
                    s += (a0[0] * a0[0] + a0[1] * a0[1]) + (a0[2] * a0[2] + a0[3] * a0[3]) + (a1[0] * a1[0] + a1[1] * a1[1]) + (a1[2] * a1[2] + a1[3] * a1[3]);
                    u32x4 w; w.x = cvt_pk_bf16(a0[0], a0[1]); w.y = cvt_pk_bf16(a0[2], a0[3]); w.z = cvt_pk_bf16(a1[0], a1[1]); w.w = cvt_pk_bf16(a1[2], a1[3]);
                    *(u32x4*)(h1b + off) = w;
                }
                s += __shfl_xor(s, 16); s += __shfl_xor(s, 32);
                if (fq == 0) atomicAdd(ss + row, s);
            }
    }
};
struct EpiGateUp {
    static constexpr bool PERM = true, AFTER_DRAIN = false, MID = false;
    const float* ss; bf16_t* act;
    __device__ __forceinline__ void operator()(const f32x4 (&acc)[2][2][4][2], const Unit& u, int wr, int wc, int fr, int fq) const {
        const int row0 = u.pm * 256 + wr * 64 + fr, col0 = u.pn * 128 + wc * 32 + 8 * fq;
#pragma unroll
        for (int ai = 0; ai < 2; ++ai)
#pragma unroll
            for (int m = 0; m < 4; ++m) {
                const int row = row0 + ai * 128 + m * 16;
                const float rs = rsqrtf(ss[row] * (1.f / 1024.f) + EPS);
                float o[8];
#pragma unroll
                for (int bj = 0; bj < 2; ++bj) {
                    const f32x4 g = acc[ai][bj][m][0] * rs, up = acc[ai][bj][m][1] * rs;
#pragma unroll
                    for (int i = 0; i < 4; ++i) o[4 * bj + i] = siluf_(g[i]) * up[i];
                }
                u32x4 w; w.x = cvt_pk_bf16(o[0], o[1]); w.y = cvt_pk_bf16(o[2], o[3]); w.z = cvt_pk_bf16(o[4], o[5]); w.w = cvt_pk_bf16(o[6], o[7]);
                *(u32x4*)(act + (size_t)row * FF + col0) = w;
            }
    }
};
struct EpiDown {
    static constexpr bool PERM = true, AFTER_DRAIN = false, MID = false;
    const bf16_t* h1b; bf16_t* h2b;
    __device__ __forceinline__ void operator()(const f32x4 (&acc)[2][2][4][2], const Unit& u, int wr, int wc, int fr, int fq) const {
        const int row0 = u.pm * 256 + wr * 64 + fr, col0 = u.pn * 256 + wc * 32 + 8 * fq;
#pragma unroll
        for (int ai = 0; ai < 2; ++ai)
#pragma unroll
            for (int m = 0; m < 4; ++m) {
                const int row = row0 + ai * 128 + m * 16;
#pragma unroll
                for (int bj = 0; bj < 2; ++bj) {
                    const size_t off = (size_t)row * 1024 + col0 + bj * 128;
                    float r[8]; unpack8(*(const u32x4*)(h1b + off), r);
                    const f32x4 a0 = acc[ai][bj][m][0], a1 = acc[ai][bj][m][1];
                    u32x4 w; w.x = cvt_pk_bf16(r[0] + a0[0], r[1] + a0[1]); w.y = cvt_pk_bf16(r[2] + a0[2], r[3] + a0[3]); w.z = cvt_pk_bf16(r[4] + a1[0], r[5] + a1[1]); w.w = cvt_pk_bf16(r[6] + a1[2], r[7] + a1[3]);
                    *(u32x4*)(h2b + off) = w;
                }
            }
    }
};
}
namespace mk {
#define LAS __attribute__((address_space(3)))
constexpr int NTHR = 512, RING_BYTES = 131072, LDS_BYTES = 147456;

__device__ __forceinline__ int srccol_in(int n) {
    if (n < 1024) { const int hd = n >> 6, p = n & 63, j = p >> 3, i = p & 7; return (hd << 6) + ((i < 4) ? 4 * j + i : 32 + 4 * j + (i - 4)); }
    if (n < 3584) return n;
    { const int q = n - 3584, t = q >> 8, bj = (q >> 7) & 1, wc = (q >> 5) & 3, fq = (q >> 3) & 3, nn = (q >> 2) & 1, i = q & 3; const int oc = 128 * t + 32 * wc + 8 * fq + 4 * bj + i; return nn ? 4616 + oc : 3592 + oc; }
}
__device__ __forceinline__ int srccol_gu(int n) { const int pn = n >> 8, bj = (n >> 7) & 1, wc = (n >> 5) & 3, fq = (n >> 3) & 3, nn = (n >> 2) & 1, i = n & 3; const int oc = 128 * pn + 32 * wc + 8 * fq + 4 * bj + i; return nn ? FF + oc : oc; }
template <int MODE> __device__ __forceinline__ void tr_item(const float* W, int K, int Nsrc, int Ndst, const float* gain, bf16_t* WT, float* scr, int item, int lane, int Kp = 0, int koff = 0) {
    if (Kp == 0) Kp = K;
    const int nblk = Ndst / 32, kb = item / nblk, nb = item % nblk, k0 = 64 * kb, n0 = 32 * nb;
    const int nd = n0 + (lane & 31); const int sc = MODE == 1 ? srccol_in(nd) : MODE == 2 ? srccol_gu(nd) : nd;
#pragma unroll
    for (int i = 0; i < 32; ++i) { const int kk = 2 * i + (lane >> 5); float v = W[(size_t)(k0 + kk) * Nsrc + sc]; if (gain) v *= gain[k0 + kk]; scr[kk * 33 + (lane & 31)] = v; }
    asm volatile("s_waitcnt lgkmcnt(0)" ::: "memory");
    const int c = lane & 7;
#pragma unroll
    for (int j = 0; j < 4; ++j) { const int n = (lane >> 3) + 8 * j; const float* s = scr + (8 * c) * 33 + n;
        u32x4 o; o.x = cvt_pk_bf16(s[0 * 33], s[1 * 33]); o.y = cvt_pk_bf16(s[2 * 33], s[3 * 33]); o.z = cvt_pk_bf16(s[4 * 33], s[5 * 33]); o.w = cvt_pk_bf16(s[6 * 33], s[7 * 33]);
        *(u32x4*)(WT + (size_t)(n0 + n) * Kp + koff + k0 + 8 * c) = o; }
    asm volatile("s_waitcnt lgkmcnt(0)" ::: "memory");
}

__device__ __forceinline__ void p0_prologue(const Params& p, unsigned char* lds, int G) {
    int tid_ = threadIdx.x; asm volatile("" : "+v"(tid_));
    const int tid = tid_, lane = tid & 63, wave = tid >> 6;
    const int gw = blockIdx.x * 8 + wave, NGW = G * 8, gt = blockIdx.x * NTHR + tid, NGT = G * NTHR;
    unsigned char* ws = p.ws;
    float* scr = (float*)(lds + wave * 8704);
    float* GW = (float*)(lds + 73728);
    for (int i = tid; i < 8192; i += NTHR) { const int k = i >> 3, c = i & 7; const int slot = (((k >> 8) * 4 + (k & 3)) * 64 + ((k >> 2) & 63)); GW[slot * 8 + c] = p.w_in[(size_t)k * INW + 3584 + c] * p.g_mix[k]; }
    { float* km = (float*)(ws + WS_KMEAN); for (int i = gt; i < NB * 16 * 512; i += NGT) km[i] = 0.f; }
    { float* r2 = (float*)(ws + WS_R1); for (int i = gt; i < T; i += NGT) r2[i] = 0.f; }
    { float* rt = (float*)(ws + WS_ROPE);
      for (int i = gt; i < SEQ * 32; i += NGT) { const int pos = i >> 5, d = i & 31; const float inv = powf(10000.f, -(float)d / 32.f); const float ang = (float)pos * inv; float s, c; sincosf(ang, &s, &c);
          const int j = d >> 2, ii = d & 3; rt[(size_t)(pos * 8 + j) * 8 + ii] = c; rt[(size_t)(pos * 8 + j) * 8 + 4 + ii] = s; } }
    { constexpr int I_IN = 16 * (NIN / 32), I_PA = 8 * 32, I_PB = 8 * 32, I_OUT = 16 * 32; constexpr int NITEMS = I_IN + I_PA + I_PB + I_OUT;
      for (int it = gw; it < NITEMS; it += NGW) { int r = it;
          if (r < I_IN) { tr_item<1>(p.w_in, 1024, INW, NIN, p.g_mix, (bf16_t*)(ws + WS_WIN), scr, r, lane); continue; } r -= I_IN;
          if (r < I_PA) { tr_item<0>(p.w_pa, 512, 1024, 1024, nullptr, (bf16_t*)(ws + WS_WPA), scr, r, lane, 1024, 0); continue; } r -= I_PA;
          if (r < I_PB) { tr_item<0>(p.w_pb, 512, 1024, 1024, nullptr, (bf16_t*)(ws + WS_WPA), scr, r, lane, 1024, 512); continue; } r -= I_PB;
          tr_item<0>(p.w_out, 1024, 1024, 1024, nullptr, (bf16_t*)(ws + WS_WOUT), scr, r, lane); } }
    __syncthreads();
    { bf16_t* XB = (bf16_t*)(ws + WS_XB); float* R1 = (float*)(ws + WS_R1); float* GT = (float*)(ws + WS_GATES);
      const int qsel = (lane >> 1) & 31, csel = qsel & 7; const float bias = csel < 4 ? p.b_i[csel] : p.b_f[csel - 4];
      for (int rb = gw * 16; rb < T; rb += NGW * 16) {
        for (int r4 = 0; r4 < 16; r4 += 4) {
          const int row = rb + r4;
          f32x4 v[4][4]; float ssq[4];
#pragma unroll
          for (int r = 0; r < 4; ++r) { const f32x4* xr = (const f32x4*)(p.x + (size_t)(row + r) * 1024) + lane;
#pragma unroll
              for (int j = 0; j < 4; ++j) v[r][j] = xr[64 * j]; }
          float acc[32];
#pragma unroll
          for (int q = 0; q < 32; ++q) acc[q] = 0.f;
#pragma unroll
          for (int r = 0; r < 4; ++r) { float s = 0.f;
#pragma unroll
              for (int j = 0; j < 4; ++j) s += (v[r][j][0] * v[r][j][0] + v[r][j][1] * v[r][j][1]) + (v[r][j][2] * v[r][j][2] + v[r][j][3] * v[r][j][3]);
              ssq[r] = s; }
#pragma unroll
          for (int j = 0; j < 4; ++j)
#pragma unroll
              for (int i = 0; i < 4; ++i) { const f32x4* gwp = (const f32x4*)(GW + (size_t)((j * 4 + i) * 64 + lane) * 8); const f32x4 g0 = gwp[0], g1 = gwp[1];
#pragma unroll
                  for (int r = 0; r < 4; ++r) { const float xv = v[r][j][i];
#pragma unroll
                      for (int c = 0; c < 4; ++c) { acc[r * 8 + c] += g0[c] * xv; acc[r * 8 + 4 + c] += g1[c] * xv; } } }
#pragma unroll
          for (int r = 0; r < 4; ++r) { ssq[r] = wave_sum(ssq[r]); const float rs = rsqrtf(ssq[r] * (1.f / 1024.f) + EPS); u32x2* o8 = (u32x2*)(XB + (size_t)(row + r) * 1024) + lane;
#pragma unroll
              for (int j = 0; j < 4; ++j) { const f32x4 xs = v[r][j] * rs; u32x2 w; w.x = cvt_pk_bf16(xs[0], xs[1]); w.y = cvt_pk_bf16(xs[2], xs[3]); o8[64 * j] = w; } }
#pragma unroll
          for (int st = 0; st < 5; ++st) { const int M = 32 >> st, n2 = 16 >> st; const bool up = (lane & M) != 0;
#pragma unroll
              for (int i = 0; i < n2; ++i) { const float lo = acc[i], hi = acc[i + n2]; const float send = up ? lo : hi, keep = up ? hi : lo; acc[i] = keep + __shfl_xor(send, M); } }
          const float tot = acc[0] + __shfl_xor(acc[0], 1);
          const int rsel = qsel >> 3; const float ss = rsel == 0 ? ssq[0] : rsel == 1 ? ssq[1] : rsel == 2 ? ssq[2] : ssq[3];
          const float rstd = rsqrtf(ss * (1.f / 1024.f) + EPS);
          if ((lane & 1) == 0) GT[(size_t)(row + rsel) * 8 + csel] = tot * rstd + bias;
        } } }
}
__device__ __forceinline__ void p4_weights(const Params& p, unsigned char* lds, int G) {
    int tid_ = threadIdx.x; asm volatile("" : "+v"(tid_));
    const int tid = tid_, lane = tid & 63, wave = tid >> 6; const int gw = blockIdx.x * 8 + wave, NGW = G * 8;
    float* scr = (float*)(lds + wave * 8704);
    constexpr int I_GU = 16 * (NIN / 32), I_DN = (FF / 64) * 32;
    for (int it = gw; it < I_GU + I_DN; it += NGW) {
        if (it < I_GU) tr_item<2>(p.w_gu, 1024, 2 * FF, NIN, p.g_ffn, (bf16_t*)(p.ws + WS_WGU), scr, it, lane);
        else tr_item<0>(p.w_dn, FF, 1024, 1024, nullptr, (bf16_t*)(p.ws + WS_WDN), scr, it - I_GU, lane);
    }
    __syncthreads();
}

template <int CTRL, int RMASK> __device__ __forceinline__ float dpp_or(float oldv, float v) { return __int_as_float(__builtin_amdgcn_update_dpp(__float_as_int(oldv), __float_as_int(v), CTRL, RMASK, 0xf, false)); }
__device__ __forceinline__ float wave_incl_sum(float v, int) {
    v += dpp_or<0x111, 0xf>(0.f, v); v += dpp_or<0x112, 0xf>(0.f, v); v += dpp_or<0x114, 0xf>(0.f, v); v += dpp_or<0x118, 0xf>(0.f, v);
    v += dpp_or<0x142, 0xa>(0.f, v); v += dpp_or<0x143, 0xc>(0.f, v);
    return v;
}
__device__ __forceinline__ float wave_incl_max(float v, int) {
    const float ninf = -INFINITY;
    v = fmaxf(v, dpp_or<0x111, 0xf>(ninf, v)); v = fmaxf(v, dpp_or<0x112, 0xf>(ninf, v)); v = fmaxf(v, dpp_or<0x114, 0xf>(ninf, v)); v = fmaxf(v, dpp_or<0x118, 0xf>(ninf, v));
    v = fmaxf(v, dpp_or<0x142, 0xa>(ninf, v)); v = fmaxf(v, dpp_or<0x143, 0xc>(ninf, v));
    return v;
}
__device__ __forceinline__ void conv2x8r(const u32x4 (&xr)[5], const float* cw, float (&y)[2][8]) {
#pragma unroll
    for (int hf = 0; hf < 2; ++hf) {
        f32x4 wj[4];
#pragma unroll
        for (int j = 0; j < 4; ++j) wj[j] = *(const f32x4*)(cw + j * 1024 + 4 * hf);
        f32x4 x[5];
#pragma unroll
        for (int i = 0; i < 5; ++i) { const unsigned a = xr[i][2 * hf], b = xr[i][2 * hf + 1]; x[i] = (f32x4){__uint_as_float(a << 16), __uint_as_float(a & 0xffff0000u), __uint_as_float(b << 16), __uint_as_float(b & 0xffff0000u)}; }
#pragma unroll
        for (int r = 0; r < 2; ++r) { const f32x4 z = wj[0] * x[r] + wj[1] * x[r + 1] + wj[2] * x[r + 2] + wj[3] * x[r + 3];
#pragma unroll
            for (int i = 0; i < 4; ++i) y[r][4 * hf + i] = siluf_(z[i]); }
    }
}
__device__ __forceinline__ void load5(const bf16_t* src, int c, int t, u32x4 (&xr)[5]) {
#pragma unroll
    for (int i = 0; i < 5; ++i) { const int tt = t - 3 + i; const bool ok = (c > 0) | (tt >= 0); const u32x4 w = *(const u32x4*)(src + (long)(ok ? tt : 0) * ZP); xr[i] = ok ? w : (u32x4){0u, 0u, 0u, 0u}; }
}
constexpr float KSCALE = 0.08838834764831845f;

struct M1Pre { u32x4 k[5], v[2]; float li, fp; };
__device__ __forceinline__ void m1_issue(const Params& p, int u, int tid, M1Pre& q) {
    const int lane = tid & 63, bh = u >> 6, c = u & 63, b = bh >> 2, h = bh & 3; const size_t row0 = (size_t)b * SEQ + c * 64;
    const bf16_t* Z = (const bf16_t*)(p.ws + WS_Z); const int d0 = (tid & 15) * 8, t = 2 * (tid >> 4);
    load5(Z + row0 * ZP + ZC_QKB + 512 + h * 128 + d0, c, t, q.k);
    const bf16_t* vs = Z + row0 * ZP + ZC_VB + h * 128 + d0; q.v[0] = *(const u32x4*)(vs + (long)t * ZP); q.v[1] = *(const u32x4*)(vs + (long)(t + 1) * ZP);
    const float* gp = (const float*)(p.ws + WS_GATES) + (row0 + lane) * 8; q.li = gp[h]; q.fp = gp[4 + h];
}
__device__ __forceinline__ void m1_compute(const Params& p, unsigned char* lds, int u, int tid_in, const M1Pre& q) {
    int tid = tid_in; asm volatile("" : "+v"(tid));
    const int lane = tid & 63, wid = tid >> 6;
    const int bh = u >> 6, h = bh & 3;
    bf16_t* KT = (bf16_t*)lds; bf16_t* VT = KT + 128 * 72; float* wS = (float*)(VT + 128 * 72); float* dnp = wS + 64;
    if (wid == 0) {
        const float li = q.li, lf = logsigmoidf_(q.fp);
        const float bcs = wave_incl_sum(lf, lane), btot = __shfl(bcs, 63);
        const float g = btot - bcs + li, gm = wave_max(g);
        wS[lane] = __expf(g - gm);
        if (lane == 0) { float* mst = (float*)(p.ws + WS_MST); mst[u * 2] = btot; mst[u * 2 + 1] = gm; }
    }
    const int d0 = (tid & 15) * 8, rg = tid >> 4, t = 2 * rg;
    float y[2][8];
    conv2x8r(q.k, (const float*)(lds + 65536) + 512 + h * 128 + d0, y);
    float vv[2][8]; unpack8(q.v[0], vv[0]); unpack8(q.v[1], vv[1]);
    __syncthreads();
    { const float w0 = KSCALE * wS[t], w1 = KSCALE * wS[t + 1];
#pragma unroll
      for (int i = 0; i < 8; ++i) { const float a = y[0][i] * w0, bq = y[1][i] * w1;
          *(unsigned*)(KT + (d0 + i) * 72 + t) = cvt_pk_bf16(a, bq); dnp[rg * 128 + d0 + i] = a + bq;
          *(unsigned*)(VT + (d0 + i) * 72 + t) = cvt_pk_bf16(vv[0][i], vv[1][i]); } }
    __syncthreads();
    if (tid < 128) { float s = 0.f;
#pragma unroll
        for (int r = 0; r < 32; ++r) s += dnp[r * 128 + tid];
        ((float*)(p.ws + WS_DN))[(size_t)u * 128 + tid] = s; }
    bf16_t* DT = (bf16_t*)(lds + 81920);
    { const int fr = lane & 15, fq = lane >> 4;
      const bf16x8 a0 = *(const bf16x8*)(KT + (16 * wid + fr) * 72 + fq * 8), a1 = *(const bf16x8*)(KT + (16 * wid + fr) * 72 + 32 + fq * 8);
#pragma unroll
      for (int et = 0; et < 8; ++et) {
          const bf16x8 b0 = *(const bf16x8*)(VT + (16 * et + fr) * 72 + fq * 8), b1 = *(const bf16x8*)(VT + (16 * et + fr) * 72 + 32 + fq * 8);
          f32x4 acc = (f32x4){0.f, 0.f, 0.f, 0.f};
          acc = __builtin_amdgcn_mfma_f32_16x16x32_bf16(a0, b0, acc, 0, 0, 0); acc = __builtin_amdgcn_mfma_f32_16x16x32_bf16(a1, b1, acc, 0, 0, 0);
          u32x2 w; w.x = cvtpk_safe(acc[0], acc[1]); w.y = cvtpk_safe(acc[2], acc[3]);
          *(u32x2*)(DT + (16 * et + fr) * 136 + 16 * wid + fq * 4) = w;
      } }
    __syncthreads();
    { bf16_t* DC = (bf16_t*)p.out + (size_t)u * 16384;
#pragma unroll
      for (int i = 0; i < 4; ++i) { const int ch = tid + NTHR * i, e = ch >> 4, part = ch & 15; *(u32x4*)(DC + e * 128 + part * 8) = *(const u32x4*)(DT + e * 136 + part * 8); } }
}
__device__ __forceinline__ void m1_phase(const Params& p, unsigned char* lds, int G) {
    int tid_ = threadIdx.x; asm volatile("" : "+v"(tid_)); const int tid = tid_;
    int u = blockIdx.x; if (u >= 2048) return;
    { float* cwS = (float*)(lds + 65536); for (int i = tid; i < 1024; i += NTHR) *(f32x4*)(cwS + 4 * i) = *(const f32x4*)(p.conv_w + 4 * i); }
    M1Pre cur; m1_issue(p, u, tid, cur);
    __syncthreads();
    for (;;) {
        const int un = u + G; const bool more = un < 2048; M1Pre nxt = cur;
        if (more) m1_issue(p, un, tid, nxt);
        __builtin_amdgcn_sched_barrier(0);
        m1_compute(p, lds, u, tid, cur);
        if (!more) break;
        cur = nxt; u = un;
    }
}
__device__ __forceinline__ void m2_scan(const Params& p, int G) {
    const int gt = blockIdx.x * NTHR + threadIdx.x, NGT = G * NTHR;
    const float* mst = (const float*)(p.ws + WS_MST); float* MC = (float*)(p.ws + WS_MC);
    const bf16_t* DC = (const bf16_t*)p.out; const float* DN = (const float*)(p.ws + WS_DN); float* NST = (float*)(p.ws + WS_NST); bf16_t* CST = (bf16_t*)(p.ws + WS_XB);
    for (int item = gt; item < 32 * 4096; item += NGT) {
        const int bh = item >> 12, vi = item & 4095; const bool hasn = (vi & 127) == 0; const int nv = vi >> 7;
        float m = 0.f; f32x4 S = (f32x4){0.f, 0.f, 0.f, 0.f}, Sn = (f32x4){0.f, 0.f, 0.f, 0.f};
        for (int c0 = 0; c0 < 64; c0 += 8) {
            f32x4 dv[8], dn[8]; float bt[8], gmv[8];
#pragma unroll
            for (int k = 0; k < 8; ++k) { const int u = bh * 64 + c0 + k;
                const u32x2 w = *(const u32x2*)(DC + (size_t)u * 16384 + vi * 4); dv[k] = (f32x4){__uint_as_float(w.x << 16), __uint_as_float(w.x & 0xffff0000u), __uint_as_float(w.y << 16), __uint_as_float(w.y & 0xffff0000u)};
                dn[k] = (f32x4){0.f, 0.f, 0.f, 0.f}; if (hasn) dn[k] = *(const f32x4*)(DN + (size_t)u * 128 + nv * 4);
                bt[k] = mst[u * 2]; gmv[k] = mst[u * 2 + 1]; }
#pragma unroll
            for (int k = 0; k < 8; ++k) { const int u = bh * 64 + c0 + k;
                { u32x2 w; w.x = cvt_pk_bf16(S[0], S[1]); w.y = cvt_pk_bf16(S[2], S[3]); *(u32x2*)(CST + (size_t)u * 16384 + vi * 4) = w; }
                if (hasn) *(f32x4*)(NST + (size_t)u * 128 + nv * 4) = Sn;
                if (vi == 0) MC[u] = m;
                const float mn = fmaxf(bt[k] + m, gmv[k]), a = __expf(bt[k] + m - mn), dd = __expf(gmv[k] - mn);
                S = S * a + dv[k] * dd; Sn = Sn * a + dn[k] * dd; m = mn; }
        }
    }
}
struct M3Pre { u32x4 q[5], k[5]; float li, fp, mc, nv; };
__device__ __forceinline__ void m3_issue(const Params& p, int u, int tid, M3Pre& q) {
    const int lane = tid & 63, bh = u >> 6, c = u & 63, b = bh >> 2, h = bh & 3; const size_t row0 = (size_t)b * SEQ + c * 64;
    const bf16_t* Z = (const bf16_t*)(p.ws + WS_Z); const int d0 = (tid & 15) * 8, t = 2 * (tid >> 4);
    load5(Z + row0 * ZP + ZC_QKB + h * 128 + d0, c, t, q.q);
    load5(Z + row0 * ZP + ZC_QKB + 512 + h * 128 + d0, c, t, q.k);
    const float* gp = (const float*)(p.ws + WS_GATES) + (row0 + lane) * 8; q.li = gp[h]; q.fp = gp[4 + h];
    q.mc = ((const float*)(p.ws + WS_MC))[u]; q.nv = ((const float*)(p.ws + WS_NST))[(size_t)u * 128 + (tid & 127)];
}
__device__ __forceinline__ void m3_compute(const Params& p, unsigned char* lds, int u, int tid_in, const M3Pre& pre, const u32x4 (&vin)[2], const u32x4 (&cin)[4], float gn) {
    int tid = tid_in; asm volatile("" : "+v"(tid));
    const int lane = tid & 63, wid = tid >> 6, fr = lane & 15, fq = lane >> 4;
    const int bh = u >> 6, c = u & 63, b = bh >> 2, h = bh & 3; const size_t row0 = (size_t)b * SEQ + c * 64;
    bf16_t* QS = (bf16_t*)lds; bf16_t* KS = (bf16_t*)(lds + 17408); bf16_t* VT = (bf16_t*)(lds + 34816); bf16_t* CT = (bf16_t*)(lds + 53248); bf16_t* SC = (bf16_t*)(lds + 88064);
    float* fb = (float*)(lds + 97280); float* bS = fb; float* aS = fb + 64; float* mT = fb + 128; float* wI = fb + 192; float* qn = fb + 256; float* denP = fb + 320; float* nS = fb + 576; float* hsq = fb + 704;
    if (wid == 0) {
        const float li = pre.li, lf = logsigmoidf_(pre.fp);
        const float bcs = wave_incl_sum(lf, lane); const float a = li - bcs; const float pm = wave_incl_max(a, lane);
        const float mc = pre.mc; const float mt = bcs + fmaxf(mc, pm);
        bS[lane] = bcs; aS[lane] = a; mT[lane] = mt; wI[lane] = __expf(bcs + mc - mt);
    }
    { const int d0 = (tid & 15) * 8, rg = tid >> 4, t = 2 * rg; float y[2][8];
      conv2x8r(pre.q, (const float*)(lds + 102400) + h * 128 + d0, y);
#pragma unroll
      for (int r = 0; r < 2; ++r) { u32x4 w; w.x = cvt_pk_bf16(y[r][0], y[r][1]); w.y = cvt_pk_bf16(y[r][2], y[r][3]); w.z = cvt_pk_bf16(y[r][4], y[r][5]); w.w = cvt_pk_bf16(y[r][6], y[r][7]); *(u32x4*)(QS + (t + r) * 136 + d0) = w; }
      conv2x8r(pre.k, (const float*)(lds + 102400) + 512 + h * 128 + d0, y);
#pragma unroll
      for (int r = 0; r < 2; ++r) { u32x4 w; w.x = cvt_pk_bf16(y[r][0] * KSCALE, y[r][1] * KSCALE); w.y = cvt_pk_bf16(y[r][2] * KSCALE, y[r][3] * KSCALE); w.z = cvt_pk_bf16(y[r][4] * KSCALE, y[r][5] * KSCALE); w.w = cvt_pk_bf16(y[r][6] * KSCALE, y[r][7] * KSCALE); *(u32x4*)(KS + (t + r) * 136 + d0) = w; }
      if (tid < 128) nS[tid] = pre.nv; }
    __syncthreads();
    { const int tr = wid >> 1;
#pragma unroll
      for (int tci = 0; tci < 2; ++tci) { const int tc = 2 * (wid & 1) + tci;
          f32x4 acc = (f32x4){0.f, 0.f, 0.f, 0.f};
          if (tc <= tr) {
#pragma unroll
              for (int ks = 0; ks < 4; ++ks) { const bf16x8 a = *(const bf16x8*)(QS + (16 * tr + fr) * 136 + ks * 32 + fq * 8), bb = *(const bf16x8*)(KS + (16 * tc + fr) * 136 + ks * 32 + fq * 8);
                  acc = __builtin_amdgcn_mfma_f32_16x16x32_bf16(a, bb, acc, 0, 0, 0); } }
          const int s = 16 * tc + fr; const float as = aS[s]; const int t0 = 16 * tr + fq * 4;
          const f32x4 bt4 = *(const f32x4*)(bS + t0), mt4 = *(const f32x4*)(mT + t0);
          float val[4];
#pragma unroll
          for (int j = 0; j < 4; ++j) { const float e = __expf(fminf(bt4[j] + as - mt4[j], 0.f)); const float x = acc[j] * e; val[j] = (tc <= tr && s <= t0 + j) ? x : 0.f; }
#pragma unroll
          for (int j = 0; j < 4; ++j) SC[(t0 + j) * 72 + s] = f2bf(val[j]);
#pragma unroll
          for (int j = 0; j < 4; ++j) val[j] = row_sum16(val[j]);
          if (fr == 0) {
#pragma unroll
              for (int j = 0; j < 4; ++j) denP[(t0 + j) * 4 + tc] = val[j]; } }
      { const int t = tid >> 3, part = tid & 7; float dot = 0.f;
#pragma unroll
        for (int i = 0; i < 16; ++i) dot += bf2f(QS[t * 136 + 16 * part + i]) * nS[16 * part + i];
        dot += __shfl_xor(dot, 1); dot += __shfl_xor(dot, 2); dot += __shfl_xor(dot, 4);
        if (part == 0) qn[t] = dot; }
      { const int d0 = (tid & 15) * 8, t = 2 * (tid >> 4); const u32x4 va = vin[0], vb = vin[1];
#pragma unroll
        for (int i = 0; i < 4; ++i) { *(unsigned*)(VT + (d0 + 2 * i) * 72 + t) = (va[i] & 0xffffu) | (vb[i] << 16); *(unsigned*)(VT + (d0 + 2 * i + 1) * 72 + t) = (va[i] >> 16) | (vb[i] & 0xffff0000u); }
 } }
    u32x4 sob[2];
    { const bf16_t* Zo = (const bf16_t*)(p.ws + WS_Z) + ZC_OB + h * 128;
#pragma unroll
      for (int i = 0; i < 2; ++i) { const int id = tid + NTHR * i; sob[i] = *(const u32x4*)(Zo + (row0 + (id >> 4)) * ZP + (id & 15) * 8); } }
    __syncthreads();
    f32x4 hv[4];
    { f32x4 acc1[4], acc2[4];
#pragma unroll
      for (int tt = 0; tt < 4; ++tt) { acc1[tt] = (f32x4){0.f, 0.f, 0.f, 0.f}; acc2[tt] = (f32x4){0.f, 0.f, 0.f, 0.f}; }
#pragma unroll
      for (int ks = 0; ks < 2; ++ks) { const bf16x8 bv = *(const bf16x8*)(VT + (16 * wid + fr) * 72 + ks * 32 + fq * 8);
#pragma unroll
          for (int tt = 0; tt < 4; ++tt) { const bf16x8 a = *(const bf16x8*)(SC + (16 * tt + fr) * 72 + ks * 32 + fq * 8); acc1[tt] = __builtin_amdgcn_mfma_f32_16x16x32_bf16(a, bv, acc1[tt], 0, 0, 0); } }
#pragma unroll
      for (int ks = 0; ks < 4; ++ks) { const bf16x8 bc = __builtin_bit_cast(bf16x8, cin[ks]);
#pragma unroll
          for (int tt = 0; tt < 4; ++tt) { const bf16x8 a = *(const bf16x8*)(QS + (16 * tt + fr) * 136 + ks * 32 + fq * 8); acc2[tt] = __builtin_amdgcn_mfma_f32_16x16x32_bf16(a, bc, acc2[tt], 0, 0, 0); } }
#pragma unroll
      for (int tt = 0; tt < 4; ++tt) { const int t0 = 16 * tt + fq * 4;
          const f32x4 wi4 = *(const f32x4*)(wI + t0), qn4 = *(const f32x4*)(qn + t0), mt4 = *(const f32x4*)(mT + t0);
          f32x4 sq4;
#pragma unroll
          for (int j = 0; j < 4; ++j) { const f32x4 d4 = *(const f32x4*)(denP + (t0 + j) * 4);
              const float num = acc1[tt][j] + wi4[j] * acc2[tt][j];
              const float den = (d4[0] + d4[1]) + (d4[2] + d4[3]) + wi4[j] * qn4[j];
              const float hval = num * __builtin_amdgcn_rcpf(fmaxf(fabsf(den), __expf(-mt4[j]))); hv[tt][j] = hval;
              sq4[j] = row_sum16(hval * hval); }
          if (fr == 0) {
#pragma unroll
              for (int j = 0; j < 4; ++j) hsq[(t0 + j) * 8 + wid] = sq4[j]; } } }
    __syncthreads();
    { float* OT = (float*)(lds + 53248);
#pragma unroll
      for (int tt = 0; tt < 4; ++tt)
#pragma unroll
          for (int j = 0; j < 4; ++j) { const int t = 16 * tt + fq * 4 + j; const f32x4* hp = (const f32x4*)(hsq + t * 8); const f32x4 s4 = hp[0] + hp[1];
              const float rstd = rsqrtf(((s4[0] + s4[1]) + (s4[2] + s4[3])) * (1.f / 128.f) + EPS);
              OT[t * 132 + 16 * wid + fr] = hv[tt][j] * rstd; } }
    __syncthreads();
    { const float* OT = (const float*)(lds + 53248); bf16_t* YB = (bf16_t*)(p.ws + WS_YA) + 512 + h * 128;
#pragma unroll
      for (int i = 0; i < 2; ++i) { const int id = tid + NTHR * i, t = id >> 4, e0 = (id & 15) * 8;
          const f32x4 h0 = *(const f32x4*)(OT + t * 132 + e0), h1 = *(const f32x4*)(OT + t * 132 + e0 + 4);
          const f32x4 g0 = *(const f32x4*)(p.g_ml + h * 128 + e0), g1 = *(const f32x4*)(p.g_ml + h * 128 + e0 + 4);
          float so[8]; unpack8(sob[i], so);
          u32x4 w; w.x = cvt_pk_bf16(h0[0] * g0[0] * so[0], h0[1] * g0[1] * so[1]); w.y = cvt_pk_bf16(h0[2] * g0[2] * so[2], h0[3] * g0[3] * so[3]);
          w.z = cvt_pk_bf16(h1[0] * g1[0] * so[4], h1[1] * g1[1] * so[5]); w.w = cvt_pk_bf16(h1[2] * g1[2] * so[6], h1[3] * g1[3] * so[7]);
          *(u32x4*)(YB + (row0 + t) * 1024 + e0) = w; } }
}
__device__ __forceinline__ void m3_phase(const Params& p, unsigned char* lds, int G) {
    int tid_ = threadIdx.x; asm volatile("" : "+v"(tid_)); const int tid = tid_;
    const int lane = tid & 63, wid = tid >> 6, fr = lane & 15, fq = lane >> 4;
    int u = blockIdx.x; if (u >= 2048) return;
    const bf16_t* Z = (const bf16_t*)(p.ws + WS_Z);
    { float* cwS = (float*)(lds + 102400); for (int i = tid; i < 1024; i += NTHR) *(f32x4*)(cwS + 4 * i) = *(const f32x4*)(p.conv_w + 4 * i); }
    M3Pre cur; m3_issue(p, u, tid, cur);
    __syncthreads();
    for (;;) {
        const int bh = u >> 6, c = u & 63, b = bh >> 2, h = bh & 3; const size_t row0 = (size_t)b * SEQ + c * 64;
        u32x4 vin[2], cin[4];
        { const int d0 = (tid & 15) * 8, t = 2 * (tid >> 4); const bf16_t* vs = Z + row0 * ZP + ZC_VB + h * 128 + d0; vin[0] = *(const u32x4*)(vs + (long)t * ZP); vin[1] = *(const u32x4*)(vs + (long)(t + 1) * ZP);
          const bf16_t* CST = (const bf16_t*)(p.ws + WS_XB) + (size_t)u * 16384;
#pragma unroll
          for (int i = 0; i < 4; ++i) cin[i] = *(const u32x4*)(CST + (16 * wid + fr) * 128 + i * 32 + fq * 8); }
        const float gn = p.g_ml[h * 128 + 16 * wid + fr];
        const int un = u + G; const bool more = un < 2048; M3Pre nxt = cur;
        if (more) m3_issue(p, un, tid, nxt);
        __builtin_amdgcn_sched_barrier(0);
        m3_compute(p, lds, u, tid, cur, vin, cin, gn);
        if (!more) break;
        cur = nxt; u = un;
    }
}
__device__ __forceinline__ void p7_final(const Params& p, int G) {
    const int lane = threadIdx.x & 63, gw = blockIdx.x * 8 + (threadIdx.x >> 6), NGW = G * 8;
    const bf16_t* H2B = (const bf16_t*)(p.ws + WS_XB);
    f32x4 g4[4];
#pragma unroll
    for (int j = 0; j < 2; ++j) { g4[2 * j] = *(const f32x4*)(p.g_fin + 512 * j + 8 * lane); g4[2 * j + 1] = *(const f32x4*)(p.g_fin + 512 * j + 8 * lane + 4); }
    for (int rb = gw * 16; rb < T; rb += NGW * 16)
        for (int r4 = 0; r4 < 16; r4 += 4) {
            u32x4 w[4][2];
#pragma unroll
            for (int r = 0; r < 4; ++r)
#pragma unroll
                for (int j = 0; j < 2; ++j) w[r][j] = *(const u32x4*)(H2B + (size_t)(rb + r4 + r) * 1024 + 512 * j + 8 * lane);
#pragma unroll
            for (int r = 0; r < 4; ++r) { float v[2][8]; unpack8(w[r][0], v[0]); unpack8(w[r][1], v[1]); float s = 0.f;
#pragma unroll
                for (int j = 0; j < 2; ++j)
#pragma unroll
                    for (int i = 0; i < 8; ++i) s += v[j][i] * v[j][i];
                const float rstd = rsqrtf(wave_sum(s) * (1.f / 1024.f) + EPS); float* xo = p.out + (size_t)(rb + r4 + r) * 1024 + 8 * lane;
#pragma unroll
                for (int j = 0; j < 2; ++j) { const f32x4 o0 = (f32x4){v[j][0], v[j][1], v[j][2], v[j][3]} * rstd * g4[2 * j], o1 = (f32x4){v[j][4], v[j][5], v[j][6], v[j][7]} * rstd * g4[2 * j + 1];
                    *(f32x4*)(xo + 512 * j) = o0; *(f32x4*)(xo + 512 * j + 4) = o1; } }
        }
}

#define XB_TMO      128
#define XB_XCNT(j)  (256  + 64 * (j))
#define XB_XSUB(j)  (1280 + 64 * (j))
#define XB_XGEN(j)  (2304 + 64 * (j))
#define XB_TOP      3328
#define XB_TOPGEN   3392
#define XCD_BAR_WORDS 3456
#define XB_SPIN_CAP (1u << 18)

__device__ __forceinline__ unsigned xb_ld(unsigned* p)              { return __hip_atomic_load(p, __ATOMIC_RELAXED, __HIP_MEMORY_SCOPE_AGENT); }
__device__ __forceinline__ unsigned xb_add(unsigned* p, unsigned v) { return __hip_atomic_fetch_add(p, v, __ATOMIC_RELAXED, __HIP_MEMORY_SCOPE_AGENT); }
__device__ __forceinline__ unsigned xb_xcc_id() { return (unsigned)__builtin_amdgcn_s_getreg((3 << 11) | 20) & 0xFu; }
#define XB_SPIN(cond, bar) do { unsigned _sp = 0; while (cond) { __builtin_amdgcn_s_sleep(1); \
    if ((++_sp & 255u) == 0u) { if (xb_ld(&(bar)[XB_TMO])) break; if (_sp > XB_SPIN_CAP) { atomicAdd(&(bar)[XB_TMO], 1u); break; } } } } while (0)

struct XcdBarrier {
    unsigned* bar; unsigned x;
    volatile LAS unsigned* st;
};

__device__ __forceinline__ XcdBarrier xcd_barrier_post(unsigned* bar, volatile LAS unsigned* st) {
    XcdBarrier b; b.bar = bar; b.x = xb_xcc_id(); b.st = st;
    if (threadIdx.x == 0) (void)xb_add(&bar[XB_XCNT(b.x)], 1u);
    return b;
}
__device__ __forceinline__ void xcd_barrier_complete(unsigned* bar, unsigned x, unsigned& nloc, unsigned& nx) {
    const unsigned G = gridDim.x * gridDim.y * gridDim.z;
    unsigned sum, cnt, mine, sp = 0u;
    for (;;) {
        sum = 0u; cnt = 0u; mine = 0u;
#pragma unroll
        for (unsigned j = 0; j < 16; ++j) { const unsigned c = xb_ld(&bar[XB_XCNT(j)]); sum += c; cnt += (c > 0u) ? 1u : 0u; mine = (j == x) ? c : mine; }
        if (sum == G) break;
        __builtin_amdgcn_s_sleep(1);
        if ((++sp & 255u) == 0u) { if (xb_ld(&bar[XB_TMO])) break; if (sp > XB_SPIN_CAP) { atomicAdd(&bar[XB_TMO], 1u); break; } }
    }
    nloc = mine > 0u ? mine : 1u; nx = cnt > 0u ? cnt : 1u;
}

__device__ __forceinline__ void xcd_barrier(const XcdBarrier& b) {
    asm volatile("s_waitcnt vmcnt(0)" ::: "memory");
    __syncthreads();
    if (threadIdx.x == 0) {
        unsigned* bar = b.bar;
        __builtin_amdgcn_s_waitcnt(0);
        unsigned nloc = b.st[0], nx = b.st[1];
        if (nloc == 0u) { xcd_barrier_complete(bar, b.x, nloc, nx); b.st[0] = nloc; b.st[1] = nx; }
        const unsigned old = xb_add(&bar[XB_XSUB(b.x)], 1u);
        const unsigned gen = old / nloc;
        if (old + 1u == (gen + 1u) * nloc) {
            __builtin_amdgcn_fence(__ATOMIC_RELEASE, "agent");
            asm volatile("s_waitcnt vmcnt(0)" ::: "memory");
            const unsigned og = xb_add(&bar[XB_TOP], 1u);
            const unsigned tg = og / nx;
            if (og + 1u == (tg + 1u) * nx) xb_add(&bar[XB_TOPGEN], 1u);
            else XB_SPIN(xb_ld(&bar[XB_TOPGEN]) == tg, bar);
            __builtin_amdgcn_fence(__ATOMIC_ACQUIRE, "agent");
            xb_add(&bar[XB_XGEN(b.x)], 1u);
            asm volatile("s_waitcnt vmcnt(0)" ::: "memory");
        } else {
            XB_SPIN(xb_ld(&bar[XB_XGEN(b.x)]) == gen, bar);
            __builtin_amdgcn_fence(__ATOMIC_ACQUIRE, "agent");
            asm volatile("s_waitcnt vmcnt(0)" ::: "memory");
        }
    }
    __syncthreads();
}

__global__ void __launch_bounds__(NTHR, 2) fwd_megakernel(Params p) {
    extern __shared__ __attribute__((aligned(16))) unsigned char lds[];
    cg::grid_group grid = cg::this_grid();
    const int G = gridDim.x;
    unsigned char* ws = p.ws;
    PG8_LAS unsigned char* ldsl = (PG8_LAS unsigned char*)lds;
    bf16_t* Z = (bf16_t*)(ws + WS_Z);

    volatile LAS unsigned* bst = (volatile LAS unsigned*)((LAS unsigned char*)lds + LDS_BYTES - 64);
    if (threadIdx.x == 0) { bst[0] = 0u; bst[1] = 0u; }
    __syncthreads();
    const XcdBarrier xb = xcd_barrier_post((unsigned*)(ws + WS_BAR) + 4096, bst);
    if (p.ws == nullptr) grid.sync();
    p0_prologue(p, lds, G);
    xcd_barrier(xb);
    {
        pg8::Gemm g{(const bf16_t*)(ws + WS_XB), (const bf16_t*)(ws + WS_WIN), T, NIN, 1024}; pg8::StaticOrder S; S.init(T, NIN, G, (int)blockIdx.x);
        EpiInProj E{Z, (const float*)(ws + WS_R1), (const float*)(ws + WS_ROPE), (float*)(ws + WS_KMEAN)};
        pg8::gemm_phase<EpiInProj, pg8::StaticOrder, true, true>(ldsl, g, S, E);
    }
    xcd_barrier(xb);
    m1_phase(p, lds, G);
    xcd_barrier(xb);
    m2_scan(p, G);
    {
        const attn_body::AttnTensors AT{(const attn_body::bf16*)(Z + ZC_Q), (const attn_body::bf16*)(Z + ZC_K), (const attn_body::bf16*)(Z + ZC_V), (attn_body::bf16*)(ws + WS_YA), (const float*)(ws + WS_KMEAN)};
        attn_body::attn_phase<8>((char*)lds, AT, G, (int)blockIdx.x);
    }
    xcd_barrier(xb);
    m3_phase(p, lds, G);
    xcd_barrier(xb);
    {
        pg8::StaticOrder S; S.init(T, 1024, G, (int)blockIdx.x);
        pg8::Gemm g{(const bf16_t*)(ws + WS_YA), (const bf16_t*)(ws + WS_WPA), T, 1024, 1024};
        EpiMerge E{Z + ZC_GA, (bf16_t*)(ws + WS_XB)};
        pg8::gemm_phase<EpiMerge, pg8::StaticOrder, true, true>(ldsl, g, S, E);
    }
    xcd_barrier(xb);
    {
        p4_weights(p, lds, G);
        pg8::Gemm g{(const bf16_t*)(ws + WS_XB), (const bf16_t*)(ws + WS_WOUT), T, 1024, 1024}; pg8::StaticOrder S; S.init(T, 1024, G, (int)blockIdx.x);
        EpiOut E{p.x, (bf16_t*)(ws + WS_YA), (float*)(ws + WS_R1)};
        pg8::gemm_phase<EpiOut, pg8::StaticOrder, true, true>(ldsl, g, S, E);
    }
    xcd_barrier(xb);
    {
        pg8::Gemm g{(const bf16_t*)(ws + WS_YA), (const bf16_t*)(ws + WS_WGU), T, NIN, 1024}; pg8::StaticOrder S; S.init(T, NIN, G, (int)blockIdx.x);
        EpiGateUp E{(const float*)(ws + WS_R1), Z};
        pg8::gemm_phase<EpiGateUp, pg8::StaticOrder, true, true>(ldsl, g, S, E);
    }
    xcd_barrier(xb);
    {
        pg8::Gemm g{(const bf16_t*)Z, (const bf16_t*)(ws + WS_WDN), T, 1024, FF}; pg8::StaticOrder S; S.init(T, 1024, G, (int)blockIdx.x);
        EpiDown E{(const bf16_t*)(ws + WS_YA), (bf16_t*)(ws + WS_XB)};
        pg8::gemm_phase<EpiDown, pg8::StaticOrder, true, true>(ldsl, g, S, E);
    }
    xcd_barrier(xb);
    p7_final(p, G);
}
}

extern "C" void kernel_launch(void* const* d_in, const int* in_sizes, int n_in, void* d_out, int out_size, void* d_ws, size_t ws_size, hipStream_t stream) {
    static int grid = 0;
    if (grid == 0) {
        if (n_in != 14 || in_sizes[0] != mk::T * 1024 || out_size != mk::T * 1024 || ws_size < mk::WS_END) { fprintf(stderr, "kernel_launch: unexpected shapes (n_in %d, in0 %d, out %d, ws %zu)\n", n_in, n_in > 0 ? in_sizes[0] : -1, out_size, ws_size); grid = -1; return; }
        int dev = 0, cus = 0, per_cu = 0;
        hipGetDevice(&dev); hipDeviceGetAttribute(&cus, hipDeviceAttributeMultiprocessorCount, dev);
        if (hipFuncSetAttribute((const void*)mk::fwd_megakernel, hipFuncAttributeMaxDynamicSharedMemorySize, mk::LDS_BYTES) != hipSuccess) { fprintf(stderr, "kernel_launch: hipFuncSetAttribute failed\n"); grid = -1; return; }
        if (hipOccupancyMaxActiveBlocksPerMultiprocessor(&per_cu, (const void*)mk::fwd_megakernel, mk::NTHR, mk::LDS_BYTES) != hipSuccess || per_cu < 1) { fprintf(stderr, "kernel_launch: occupancy query says %d blocks per CU\n", per_cu); per_cu = 1; }
        (void)hipGetLastError();
        grid = cus;
    }
    if (grid < 0) return;
    mk::Params p{};
    p.x = (const float*)d_in[0]; p.g_mix = (const float*)d_in[1]; p.w_in = (const float*)d_in[2]; p.conv_w = (const float*)d_in[3]; p.b_i = (const float*)d_in[4]; p.b_f = (const float*)d_in[5];
    p.g_ml = (const float*)d_in[6]; p.w_pa = (const float*)d_in[7]; p.w_pb = (const float*)d_in[8]; p.w_out = (const float*)d_in[9]; p.g_ffn = (const float*)d_in[10]; p.w_gu = (const float*)d_in[11];
    p.w_dn = (const float*)d_in[12]; p.g_fin = (const float*)d_in[13]; p.out = (float*)d_out; p.ws = (unsigned char*)d_ws;
    if (hipMemsetAsync((char*)d_ws + mk::WS_BAR, 0, 32768, stream) != hipSuccess) { fprintf(stderr, "kernel_launch: hipMemsetAsync of the barrier words failed\n"); return; }
    void* args[] = {&p};
    hipError_t e = hipLaunchCooperativeKernel((const void*)mk::fwd_megakernel, dim3(grid), dim3(mk::NTHR), args, mk::LDS_BYTES, stream);
    if (e != hipSuccess) fprintf(stderr, "kernel_launch: cooperative launch failed: %s (grid %d)\n", hipGetErrorString(e), grid);
}
```
